# Optimizing an MI355X kernel written in HIP

```python
import jax
import jax.numpy as jnp
from jax import lax
import numpy as np

D_MODEL = 1024
BATCH = 2
SEQ = 8192
DEPTH = 2

N_META = 16
NORM_EPS = 1e-6
SSM_D_INNER = 2 * D_MODEL
SSM_HEAD_DIM = 64
SSM_HEADS = SSM_D_INNER // SSM_HEAD_DIM
SSM_GROUPS = 4
SSM_HEADS_PER_GROUP = SSM_HEADS // SSM_GROUPS
SSM_STATE = 128
SSM_CONV = 4
SSM_CHUNK = 256
SSM_CONV_DIM = SSM_D_INNER + 2 * SSM_GROUPS * SSM_STATE
SSM_IN_DIM = SSM_D_INNER + SSM_CONV_DIM + SSM_HEADS
SB_HEAD_DIM = 64
SB_HEADS = D_MODEL // SB_HEAD_DIM
SB_WIDTH = SB_HEADS * SB_HEAD_DIM
SB_Q_BLOCK = 128
D_FF = 256 * ((8 * D_MODEL // 3 + 255) // 256)
FFN_CONV = 3

kernel_name = 'hybrid_ssd_stickbreaking_yoco'


def _rmsnorm(x, g):
    x32 = x.astype(jnp.float32)
    y = x32 * lax.rsqrt(jnp.mean(x32 * x32, axis=-1, keepdims=True) + NORM_EPS)
    return (y * g.astype(jnp.float32)).astype(x.dtype)


def _causal_dwconv(x, w, bias):
    width = w.shape[0]
    L = x.shape[1]
    xp = jnp.pad(x, ((0, 0), (width - 1, 0), (0, 0)))
    y = xp[:, 0:L] * w[0] + bias
    for k in range(1, width):
        y = y + xp[:, k:k + L] * w[k]
    return y


def _ssd_mixer(u, w_in, conv_w, conv_b, dt_bias, a_log, d_skip, gate_g, w_out):
    b, L, _ = u.shape
    G, E, P, N, Q = SSM_GROUPS, SSM_HEADS_PER_GROUP, SSM_HEAD_DIM, SSM_STATE, SSM_CHUNK
    f32 = jnp.float32
    z, xbc, dt_raw = jnp.split(u @ w_in, [SSM_D_INNER, SSM_D_INNER + SSM_CONV_DIM], axis=-1)
    xbc = jax.nn.silu(_causal_dwconv(xbc, conv_w, conv_b))
    xs, b_in, c_in = jnp.split(xbc, [SSM_D_INNER, SSM_D_INNER + G * N], axis=-1)
    dt = jax.nn.softplus(dt_raw.astype(f32) + dt_bias.astype(f32))
    a = -jnp.exp(a_log.astype(f32))
    pf = (-N_META) % Q
    pe = (-(pf + L)) % Q
    nc = (pf + L + pe) // Q

    def to_chunks(t, tail):
        return jnp.pad(t, ((0, 0), (pf, pe), (0, 0))).reshape((b, nc, Q) + tail)

    x_c = to_chunks(xs, (G, E, P)).astype(f32)
    b_c = to_chunks(b_in, (G, N)).astype(f32)
    c_c = to_chunks(c_in, (G, N)).astype(f32)
    dt_c = to_chunks(dt, (G, E))
    xdt = x_c * dt_c[..., None]
    a_cs = jnp.cumsum(jnp.transpose(dt_c * a.reshape(G, E), (0, 3, 4, 1, 2)), axis=-1)
    causal = jnp.tril(jnp.ones((Q, Q), dtype=bool))
    decay_in = jnp.exp(jnp.where(causal, a_cs[..., :, None] - a_cs[..., None, :], -jnp.inf))
    cb = jnp.einsum('bclgn,bcsgn->bgcls', c_c, b_c)
    y_diag = jnp.einsum('bgcls,bgecls,bcsgep->bclgep', cb, decay_in, xdt)
    decay_to_end = jnp.exp(a_cs[..., -1:] - a_cs)
    chunk_states = jnp.einsum('bclgn,bgecl,bclgep->cbgepn', b_c, decay_to_end, xdt)
    chunk_decay = jnp.moveaxis(jnp.exp(a_cs[..., -1]), -1, 0)

    def step(state, inp):
        s_new, d = inp
        return state * d[..., None, None] + s_new, state

    _, prev_states = lax.scan(step, jnp.zeros((b, G, E, P, N), f32), (chunk_states, chunk_decay))
    y_off = jnp.einsum('bclgn,cbgepn,bgecl->bclgep', c_c, prev_states, jnp.exp(a_cs))
    y = (y_diag + y_off).reshape(b, nc * Q, SSM_D_INNER)[:, pf:pf + L]
    y = y + (xs.reshape(b, L, SSM_HEADS, P).astype(f32) * d_skip.astype(f32)[:, None]).reshape(b, L, SSM_D_INNER)
    hg = (y * jax.nn.silu(z.astype(f32))).reshape(b, L, G, SSM_D_INNER // G)
    hg = hg * lax.rsqrt(jnp.mean(hg * hg, axis=-1, keepdims=True) + NORM_EPS)
    hg = hg.reshape(b, L, SSM_D_INNER) * gate_g.astype(f32)
    return hg.astype(u.dtype) @ w_out


def _stick_breaking_attention(q, k, v):
    b, L, H, Dh = q.shape
    lp = -(-L // SB_Q_BLOCK) * SB_Q_BLOCK
    pad = ((0, 0), (0, lp - L), (0, 0), (0, 0))
    q, k, v = jnp.pad(q, pad), jnp.pad(k, pad), jnp.pad(v, pad)
    scale = Dh ** -0.5
    outs = []
    for i in range(lp // SB_Q_BLOCK):
        t0, t1 = i * SB_Q_BLOCK, (i + 1) * SB_Q_BLOCK
        logits = jnp.einsum('bthd,bshd->bhts', q[:, t0:t1], k[:, :t1]).astype(jnp.float32) * scale
        t_idx = t0 + jnp.arange(SB_Q_BLOCK)[:, None]
        s_idx = jnp.arange(t1)[None, :]
        visible = s_idx < t_idx
        log_keep = jnp.where(visible, jax.nn.log_sigmoid(-logits), 0.0)
        later = lax.cumsum(log_keep, axis=3, reverse=True) - log_keep
        log_w = jnp.where(visible, jax.nn.log_sigmoid(logits) + later, -jnp.inf)
        w = jnp.exp(log_w).astype(v.dtype)
        outs.append(jnp.einsum('bhts,bshd->bthd', w, v[:, :t1]))
    return jnp.concatenate(outs, axis=1)[:, :L]


def _conv_ffn(u, w_up, conv_w, conv_b, w_down):
    h = _causal_dwconv(u @ w_up, conv_w, conv_b)
    g, val = jnp.split(h, 2, axis=-1)
    return (jax.nn.silu(g) * val) @ w_down


def setup_inputs(seed: int = 0) -> dict:
    key = jax.random.key(seed)
    ks = jax.random.split(key, 32)
    n_a = DEPTH // 2
    n_b = DEPTH - n_a
    f32 = jnp.float32

    def nrm(k, shape, scale):
        return jax.random.normal(k, shape, f32) * scale

    def gain(k, shape):
        return 1.0 + 0.02 * jax.random.normal(k, shape, f32)

    dt0 = jnp.exp(jax.random.uniform(ks[6], (n_a, SSM_HEADS), f32, np.log(1e-3), np.log(1e-1)))
    dt_bias = dt0 + jnp.log(-jnp.expm1(-dt0))
    return {
        'x': jax.random.normal(ks[0], (BATCH, SEQ, D_MODEL), f32),
        'meta_tokens': nrm(ks[1], (N_META, D_MODEL), 1.0),
        'ssd_norm': gain(ks[2], (n_a, D_MODEL)),
        'ssd_w_in': nrm(ks[3], (n_a, D_MODEL, SSM_IN_DIM), D_MODEL ** -0.5),
        'ssd_conv_w': nrm(ks[4], (n_a, SSM_CONV, SSM_CONV_DIM), SSM_CONV ** -0.5),
        'ssd_conv_b': nrm(ks[5], (n_a, SSM_CONV_DIM), 0.02),
        'ssd_dt_bias': dt_bias,
        'ssd_a_log': jnp.log(jax.random.uniform(ks[7], (n_a, SSM_HEADS), f32, 1.0, 16.0)),
        'ssd_d_skip': jax.random.uniform(ks[8], (n_a, SSM_HEADS), f32, 0.5, 1.5),
        'ssd_gate_norm': gain(ks[9], (n_a, SSM_D_INNER)),
        'ssd_w_out': nrm(ks[10], (n_a, SSM_D_INNER, D_MODEL), SSM_D_INNER ** -0.5),
        'kv_norm': gain(ks[11], (D_MODEL,)),
        'w_kv': nrm(ks[12], (D_MODEL, 2 * SB_WIDTH), D_MODEL ** -0.5),
        'sb_norm': gain(ks[13], (n_b, D_MODEL)),
        'sb_w_q': nrm(ks[14], (n_b, D_MODEL, SB_WIDTH), D_MODEL ** -0.5),
        'sb_w_o': nrm(ks[15], (n_b, SB_WIDTH, D_MODEL), SB_WIDTH ** -0.5),
        'ffn_norm': gain(ks[16], (DEPTH, D_MODEL)),
        'ffn_w_up': nrm(ks[17], (DEPTH, D_MODEL, 2 * D_FF), D_MODEL ** -0.5),
        'ffn_conv_w': nrm(ks[18], (DEPTH, FFN_CONV, 2 * D_FF), FFN_CONV ** -0.5),
        'ffn_conv_b': nrm(ks[19], (DEPTH, 2 * D_FF), 0.02),
        'ffn_w_down': nrm(ks[20], (DEPTH, D_FF, D_MODEL), D_FF ** -0.5),
        'final_norm': gain(ks[21], (D_MODEL,)),
    }


def reference(x, meta_tokens, ssd_norm, ssd_w_in, ssd_conv_w, ssd_conv_b, ssd_dt_bias, ssd_a_log,
              ssd_d_skip, ssd_gate_norm, ssd_w_out, kv_norm, w_kv, sb_norm, sb_w_q, sb_w_o,
              ffn_norm, ffn_w_up, ffn_conv_w, ffn_conv_b, ffn_w_down, final_norm):
    b = x.shape[0]
    n_a = DEPTH // 2
    h = jnp.concatenate([jnp.broadcast_to(meta_tokens[None], (b, N_META, D_MODEL)).astype(x.dtype), x], axis=1)
    L = h.shape[1]
    k_shared = None
    v_shared = None
    for layer in range(DEPTH):
        if layer < n_a:
            h = h + _ssd_mixer(_rmsnorm(h, ssd_norm[layer]), ssd_w_in[layer], ssd_conv_w[layer],
                               ssd_conv_b[layer], ssd_dt_bias[layer], ssd_a_log[layer],
                               ssd_d_skip[layer], ssd_gate_norm[layer], ssd_w_out[layer])
        else:
            if layer == n_a:
                kv = _rmsnorm(h, kv_norm) @ w_kv
                k_shared, v_shared = jnp.split(kv.reshape(b, L, 2, SB_HEADS, SB_HEAD_DIM), 2, axis=2)
                k_shared, v_shared = k_shared[:, :, 0], v_shared[:, :, 0]
            j = layer - n_a
            q = (_rmsnorm(h, sb_norm[j]) @ sb_w_q[j]).reshape(b, L, SB_HEADS, SB_HEAD_DIM)
            o = _stick_breaking_attention(q, k_shared, v_shared).reshape(b, L, SB_WIDTH)
            h = h + o @ sb_w_o[j]
        h = h + _conv_ffn(_rmsnorm(h, ffn_norm[layer]), ffn_w_up[layer], ffn_conv_w[layer],
                          ffn_conv_b[layer], ffn_w_down[layer])
    return _rmsnorm(h, final_norm)[:, N_META:]
```

```cpp
#include <hip/hip_runtime.h>
#include <hip/hip_cooperative_groups.h>
#include <cstdio>
#include <cstdint>
namespace cg = cooperative_groups;

constexpr int DM = 1024, NBATCH = 2, SEQ = 8192, NMETA = 16, LTOK = NMETA + SEQ;
constexpr int BS = 8224, OFF = 16;
constexpr int MR = 65 * 256;
constexpr int MRX = 66 * 256;
constexpr int TPB = 33;
constexpr int DI = 2048, NSTATE = 128, NHS = 32, CONVD = 3072, NIN = 5376, NIN_REAL = 5152;
constexpr int DFF = 2816, NUP = 5632;
constexpr float EPS = 1e-6f;

#ifndef MK_COOP
#define MK_COOP 1
#endif
namespace pg8 {
#define PG8_LAS __attribute__((address_space(3)))
typedef unsigned short bf16_t;
typedef short bf16x8 __attribute__((ext_vector_type(8)));
typedef float f32x4 __attribute__((ext_vector_type(4)));
typedef unsigned u32x4 __attribute__((ext_vector_type(4)));
constexpr int BM = 256, BK = 64, HALF = 128, HTB = HALF * BK * 2  , STAGE_BYTES = 8 * HTB, NXCD = 8, WGM = 8;

__host__ __device__ __forceinline__ int lds_byte(int r, int c) { const int st = (r >> 4) * 2 + (c >> 5), rr = r & 15, cc = c & 31, ob = rr * 64 + cc * 2; return st * 1024 + (ob ^ (((ob >> 9) & 1) << 5)); }
__host__ __device__ __forceinline__ void stage_rc(int b, int& R, int& C) { const int st = b / 1024, sb = b % 1024, swz = sb ^ (((sb >> 9) & 1) << 5); R = (st >> 1) * 16 + swz / 64; C = (st & 1) * 32 + (swz % 64) / 2; }
__host__ __device__ __forceinline__ int perm32(int rho) { const int n = rho >> 4, i = rho & 15; return 8 * (i >> 2) + 4 * n + (i & 3); }

struct Unit { int pm, pn; };
struct Gemm { const bf16_t* A; const bf16_t* Bt; int M, N, K; int halo;
    __device__ __forceinline__ size_t a_off(int pm) const { const int row = halo == 0 ? pm * 256 : (pm / TPB) * BS + OFF - halo + (256 - halo) * (pm % TPB); return (size_t)row * (size_t)K * 2; } };

struct StaticOrder {
    int nM, nN, nwg, G, c;
    __host__ __device__ void init(int M, int N, int G_, int c_) { nM = M / BM; nN = N / BM; nwg = nM * nN; G = G_; c = c_; }
    __host__ __device__ bool next(int i, Unit& u) const {
        const long L = (long)i * G + c; if (L >= nwg) return false;
        int wgid = (int)L; { const int q = nwg / NXCD, r = nwg % NXCD, xcd = wgid % NXCD, off = wgid / NXCD; wgid = (xcd < r ? xcd * (q + 1) : r * (q + 1) + (xcd - r) * q) + off; }
        const int nig = WGM * nN, gid = wgid / nig, fm = gid * WGM, gsz = (nM - fm) < WGM ? (nM - fm) : WGM;
        u.pm = fm + ((wgid % nig) % gsz); u.pn = (wgid % nig) / gsz; return true;
    }
    __device__ __forceinline__ void a_ready(const Unit&) const {}
    __device__ __forceinline__ void done(const Unit&) const {}
};

__device__ __forceinline__ unsigned cvt_pk_bf16(float lo, float hi) { unsigned r; asm volatile("v_cvt_pk_bf16_f32 %0, %1, %2" : "=v"(r) : "v"(lo), "v"(hi)); return r; }
typedef float f32x2 __attribute__((ext_vector_type(2)));
__device__ __forceinline__ float silu_f(float v) { return v * __builtin_amdgcn_rcpf(1.0f + __expf(-v)); }
__device__ __forceinline__ float softplus_f(float v) { return fmaxf(v, 0.f) + log1pf(__expf(-fabsf(v))); }
__device__ __forceinline__ float bflo(unsigned u) { return __uint_as_float(u << 16); }
__device__ __forceinline__ float bfhi(unsigned u) { return __uint_as_float(u & 0xffff0000u); }
typedef unsigned u32x2 __attribute__((ext_vector_type(2)));

struct EpiBf16 {
    static constexpr bool PERM = true, AFTER_DRAIN = false;
    bf16_t* O; int ldc; int split_cols; size_t split_stride;
    __device__ __forceinline__ void operator()(const f32x4 (&acc)[2][2][4][2], const Unit& u, int wr, int wc, int fr, int fq, PG8_LAS unsigned char*) const {
        asm volatile("" : "+v"(fr), "+v"(fq));
        const int row0 = u.pm * BM + wr * 64 + fr; int colt = u.pn * BM; bf16_t* base = O;
        if (split_cols) { const int t = colt / split_cols; base += (size_t)t * split_stride; colt -= t * split_cols; }
        const int col0 = colt + wc * 32 + 8 * fq;
#pragma unroll
        for (int ai = 0; ai < 2; ++ai)
#pragma unroll
            for (int m = 0; m < 4; ++m) { bf16_t* rowp = base + (size_t)(row0 + ai * HALF + m * 16) * ldc + col0;
#pragma unroll
                for (int bj = 0; bj < 2; ++bj) { const f32x4 v0 = acc[ai][bj][m][0], v1 = acc[ai][bj][m][1];
                    u32x4 w; w.x = cvt_pk_bf16(v0[0], v0[1]); w.y = cvt_pk_bf16(v0[2], v0[3]); w.z = cvt_pk_bf16(v1[0], v1[1]); w.w = cvt_pk_bf16(v1[2], v1[3]);
                    *(u32x4*)(rowp + bj * HALF) = w; } }
    }
};

template <int mode> struct EpiResid {
    static constexpr bool PERM = false, AFTER_DRAIN = false;
    float* H; const float* x; const float* meta;
    __device__ __forceinline__ void operator()(const f32x4 (&acc)[2][2][4][2], const Unit& u, int wr, int wc, int fr, int fq, PG8_LAS unsigned char*) const {
        asm volatile("" : "+v"(fr), "+v"(fq));
        const int col0 = u.pn * BM + wc * 32 + 4 * fq;
#pragma unroll
        for (int ai = 0; ai < 2; ++ai)
#pragma unroll
            for (int m = 0; m < 4; ++m) {
                const int r = u.pm * BM + ai * HALF + wr * 64 + m * 16 + fr;
                const int b = r >= BS ? 1 : 0, l = r - b * BS - OFF;
                if (l >= 0 && l < LTOK) {
                    float* hp = H + (size_t)r * DM + col0;
                    const float* bp = mode == 0 ? hp : (l < NMETA ? meta + (size_t)l * DM + col0 : x + ((size_t)b * SEQ + (l - NMETA)) * DM + col0);
#pragma unroll
                    for (int bj = 0; bj < 2; ++bj)
#pragma unroll
                        for (int n = 0; n < 2; ++n) { const f32x4 bs = *(const f32x4*)(bp + bj * HALF + n * 16); *(f32x4*)(hp + bj * HALF + n * 16) = bs + acc[ai][bj][m][n]; }
                }
                asm volatile("" ::: "memory");
            }
    }
};

__device__ __forceinline__ void halo_publish(const f32x4 (&acc)[2][2][4][2], PG8_LAS unsigned char* xl, int wr, int wc, int fr, int fq) {
    PG8_LAS f32x4* X = (PG8_LAS f32x4*)xl; const int wave = wr * 4 + wc;
    if (fr >= 12) {
#pragma unroll
        for (int ai = 0; ai < 2; ++ai)
#pragma unroll
            for (int bj = 0; bj < 2; ++bj)
#pragma unroll
                for (int n = 0; n < 2; ++n) X[(((wave * 2 + ai) * 4 + bj * 2 + n) * 16) + fq * 4 + (fr - 12)] = acc[ai][bj][3][n];
    }
    asm volatile("s_waitcnt lgkmcnt(0)" ::: "memory"); __builtin_amdgcn_s_barrier(); asm volatile("" ::: "memory");
}
__device__ __forceinline__ f32x4 halo_get(PG8_LAS unsigned char* xl, int ai, int bj, int n, int wr, int wc, int fr, int fq) {
    const PG8_LAS f32x4* X = (const PG8_LAS f32x4*)xl; const int pai = wr == 1 ? ai : ai - 1, pw = (wr ^ 1) * 4 + wc;
    f32x4 r = (f32x4){0.f, 0.f, 0.f, 0.f};
    if (fr >= 12 && pai >= 0) r = X[(((pw * 2 + pai) * 4 + bj * 2 + n) * 16) + fq * 4 + (fr - 12)];
    return r;
}

struct EpiInProj {
    static constexpr bool PERM = true, AFTER_DRAIN = false;
    bf16_t* Z; bf16_t* XBC; float* DT; const float* cw; const float* cb; const float* dtb;
    __device__ __forceinline__ void operator()(const f32x4 (&acc)[2][2][4][2], const Unit& u, int wr, int wc, int fr, int fq, PG8_LAS unsigned char* xl) const {
        asm volatile("" : "+v"(fr), "+v"(fq));
        const int pb = u.pm / TPB, pt = u.pm % TPB, l0 = 253 * pt - 3, rowbase = pb * BS + OFF + l0, lane = fq * 16 + fr;
        if (u.pn < 8) {
            const int col0 = u.pn * BM + wc * 32 + 8 * fq;
#pragma unroll
            for (int ai = 0; ai < 2; ++ai)
#pragma unroll
                for (int m = 0; m < 4; ++m) { const int i = ai * HALF + wr * 64 + m * 16 + fr, l = l0 + i;
                    if (i >= 3 && l < LTOK) { bf16_t* rowp = Z + (size_t)(rowbase + i) * DI + col0;
#pragma unroll
                        for (int bj = 0; bj < 2; ++bj) { const f32x4 v0 = acc[ai][bj][m][0], v1 = acc[ai][bj][m][1];
                            u32x4 w; w.x = cvt_pk_bf16(v0[0], v0[1]); w.y = cvt_pk_bf16(v0[2], v0[3]); w.z = cvt_pk_bf16(v1[0], v1[1]); w.w = cvt_pk_bf16(v1[2], v1[3]);
                            *(u32x4*)(rowp + bj * HALF) = w; } } }
        } else if (u.pn < 20) {
            halo_publish(acc, xl, wr, wc, fr, fq);
            const int s1 = (lane & 48) | ((fr - 1) & 15), s2 = (lane & 48) | ((fr - 2) & 15), s3 = (lane & 48) | ((fr - 3) & 15);
#pragma unroll
            for (int bj = 0; bj < 2; ++bj)
#pragma unroll
                for (int n = 0; n < 2; ++n) {
                    const int c0 = (u.pn - 8) * BM + bj * HALF + wc * 32 + 8 * fq + 4 * n;
                    const f32x4 w0 = *(const f32x4*)(cw + c0), w1 = *(const f32x4*)(cw + CONVD + c0), w2 = *(const f32x4*)(cw + 2 * CONVD + c0), w3 = *(const f32x4*)(cw + 3 * CONVD + c0), bb = *(const f32x4*)(cb + c0);
#pragma unroll
                    for (int ai = 0; ai < 2; ++ai)
#pragma unroll
                        for (int m = 0; m < 4; ++m) {
                            const f32x4 cur = acc[ai][bj][m][n];
                            f32x4 prv; if (m > 0) prv = acc[ai][bj][m > 0 ? m - 1 : 0][n]; else prv = halo_get(xl, ai, bj, n, wr, wc, fr, fq);
                            float o[4];
#pragma unroll
                            for (int j = 0; j < 4; ++j) {
                                const float v1 = __shfl(fr >= 15 ? prv[j] : cur[j], s1), v2 = __shfl(fr >= 14 ? prv[j] : cur[j], s2), v3 = __shfl(fr >= 13 ? prv[j] : cur[j], s3);
                                o[j] = silu_f(bb[j] + w3[j] * cur[j] + w2[j] * v1 + w1[j] * v2 + w0[j] * v3);
                            }
                            const int i = ai * HALF + wr * 64 + m * 16 + fr, l = l0 + i;
                            if (i >= 3 && l < LTOK) { u32x2 w; w.x = cvt_pk_bf16(o[0], o[1]); w.y = cvt_pk_bf16(o[2], o[3]); *(u32x2*)(XBC + (size_t)(rowbase + i) * CONVD + c0) = w; }
                        }
                    asm volatile("" ::: "memory");
                }
        } else {
            if (wc == 0) {
#pragma unroll
                for (int n = 0; n < 2; ++n) { const int c0 = 8 * fq + 4 * n; const f32x4 bb = *(const f32x4*)(dtb + c0);
#pragma unroll
                    for (int ai = 0; ai < 2; ++ai)
#pragma unroll
                        for (int m = 0; m < 4; ++m) { const int i = ai * HALF + wr * 64 + m * 16 + fr, l = l0 + i; const f32x4 v = acc[ai][0][m][n] + bb;
                            if (i >= 3 && l < LTOK) *(f32x4*)(DT + (size_t)(rowbase + i) * NHS + c0) = (f32x4){softplus_f(v[0]), softplus_f(v[1]), softplus_f(v[2]), softplus_f(v[3])}; } }
            }
        }
    }
};

struct EpiUp {
    static constexpr bool PERM = true, AFTER_DRAIN = false;
    bf16_t* ACT; const float* cw; const float* cb;
    __device__ __forceinline__ void operator()(const f32x4 (&acc)[2][2][4][2], const Unit& u, int wr, int wc, int fr, int fq, PG8_LAS unsigned char* xl) const {
        asm volatile("" : "+v"(fr), "+v"(fq));
        const int pb = u.pm / TPB, pt = u.pm % TPB, l0 = 254 * pt - 2, rowbase = pb * BS + OFF + l0, lane = fq * 16 + fr;
        halo_publish(acc, xl, wr, wc, fr, fq);
        const int s1 = (lane & 48) | ((fr - 1) & 15), s2 = (lane & 48) | ((fr - 2) & 15);
#pragma unroll
        for (int n = 0; n < 2; ++n) {
            const int c0 = u.pn * HALF + wc * 32 + 8 * fq + 4 * n;
            const f32x4 g0 = *(const f32x4*)(cw + c0), g1 = *(const f32x4*)(cw + NUP + c0), g2 = *(const f32x4*)(cw + 2 * NUP + c0), gb = *(const f32x4*)(cb + c0);
            const f32x4 h0 = *(const f32x4*)(cw + DFF + c0), h1 = *(const f32x4*)(cw + NUP + DFF + c0), h2 = *(const f32x4*)(cw + 2 * NUP + DFF + c0), hb = *(const f32x4*)(cb + DFF + c0);
#pragma unroll
            for (int ai = 0; ai < 2; ++ai)
#pragma unroll
                for (int m = 0; m < 4; ++m) {
                    const f32x4 cg = acc[ai][0][m][n], cv = acc[ai][1][m][n];
                    f32x4 pg, pv; if (m > 0) { pg = acc[ai][0][m > 0 ? m - 1 : 0][n]; pv = acc[ai][1][m > 0 ? m - 1 : 0][n]; } else { pg = halo_get(xl, ai, 0, n, wr, wc, fr, fq); pv = halo_get(xl, ai, 1, n, wr, wc, fr, fq); }
                    float o[4];
#pragma unroll
                    for (int j = 0; j < 4; ++j) {
                        const float a1 = __shfl(fr >= 15 ? pg[j] : cg[j], s1), a2 = __shfl(fr >= 14 ? pg[j] : cg[j], s2);
                        const float b1 = __shfl(fr >= 15 ? pv[j] : cv[j], s1), b2 = __shfl(fr >= 14 ? pv[j] : cv[j], s2);
                        const float gg = gb[j] + g2[j] * cg[j] + g1[j] * a1 + g0[j] * a2, vv = hb[j] + h2[j] * cv[j] + h1[j] * b1 + h0[j] * b2;
                        o[j] = silu_f(gg) * vv;
                    }
                    const int i = ai * HALF + wr * 64 + m * 16 + fr, l = l0 + i;
                    if (i >= 2 && l < LTOK) { u32x2 w; w.x = cvt_pk_bf16(o[0], o[1]); w.y = cvt_pk_bf16(o[2], o[3]); *(u32x2*)(ACT + (size_t)(rowbase + i) * DFF + c0) = w; }
                }
            asm volatile("" ::: "memory");
        }
    }
};

template <class Epi, class Sched, bool ALIGN_EPI = false, bool SP2 = false>
__device__ __forceinline__ void gemm_phase(PG8_LAS unsigned char* lds, const Gemm g, const Sched& S, const Epi& E) {
    const int tid = threadIdx.x, wid = __builtin_amdgcn_readfirstlane(tid >> 6), lane = tid & 63, wr = wid >> 2, wc = wid & 3, fr = lane & 15, fq = lane >> 4;
    const int K = g.K, nt = K / BK;
    unsigned voffA[2], voffB[2];
#pragma unroll
    for (int i = 0; i < 2; ++i) { int R, C; stage_rc(tid * 16 + i * 8192, R, C); const int Rb = Epi::PERM ? ((R & ~31) + perm32(R & 31)) : R;
        voffA[i] = (unsigned)(R * K + C) * 2u; voffB[i] = (unsigned)(Rb * K + C) * 2u; }
    const size_t kstep = (size_t)(BK * 2);
    const size_t hstep = (size_t)HALF * K * 2;
    const size_t tstep = 2 * hstep;
    const unsigned ldsw = (unsigned)wid * 1024u;
    const int aoff = lds_byte(wr * 64 + fr, fq * 8), boff = lds_byte(wc * 32 + fr, fq * 8);
#define PG8_SA(b, h) (((b) * 2 + (h)) * HTB)
#define PG8_SB(b, h) ((4 + (b) * 2 + (h)) * HTB)
#define PG8_STAGE(bufoff, gbase, voff) do { _Pragma("unroll") for (int _i = 0; _i < 2; ++_i) \
        __builtin_amdgcn_global_load_lds((const unsigned*)((const char*)(gbase) + (voff)[_i]), (PG8_LAS unsigned*)(lds + (bufoff) + ldsw + _i * 8192), 16, 0, 0); } while (0)
#define PG8_LDA(dst, b, h) do { _Pragma("unroll") for (int m = 0; m < 4; ++m) _Pragma("unroll") for (int k = 0; k < 2; ++k) dst[m][k] = *(const PG8_LAS bf16x8*)(lds + PG8_SA(b, h) + aoff + m * 2048 + k * 1024); } while (0)
#define PG8_LDB(dst, b, h) do { _Pragma("unroll") for (int n = 0; n < 2; ++n) _Pragma("unroll") for (int k = 0; k < 2; ++k) dst[n][k] = *(const PG8_LAS bf16x8*)(lds + PG8_SB(b, h) + boff + n * 2048 + k * 1024); } while (0)
#define PG8_MMA(ai, bj, At, Bt) do { __builtin_amdgcn_s_setprio(1); _Pragma("unroll") for (int m = 0; m < 4; ++m) _Pragma("unroll") for (int n = 0; n < 2; ++n) _Pragma("unroll") for (int k = 0; k < 2; ++k) \
        acc[ai][bj][m][n] = __builtin_amdgcn_mfma_f32_16x16x32_bf16(Bt[n][k], At[m][k], acc[ai][bj][m][n], 0, 0, 0); __builtin_amdgcn_s_setprio(0); } while (0)
#define PG8_WAIT_V(n) asm volatile("s_waitcnt vmcnt(" #n ")" ::: "memory")
#define PG8_WAIT_L(n) asm volatile("s_waitcnt lgkmcnt(" #n ")" ::: "memory")
#define PG8_BAR __builtin_amdgcn_s_barrier()
#define PG8_SCHED __builtin_amdgcn_sched_barrier(0)
    Unit cur, nxt; int ui = 0;
    if (!S.next(0, cur)) return;
    f32x4 acc[2][2][4][2];
#pragma unroll
    for (int a = 0; a < 2; ++a)
#pragma unroll
        for (int b = 0; b < 2; ++b)
#pragma unroll
            for (int m = 0; m < 4; ++m)
#pragma unroll
                for (int n = 0; n < 2; ++n) acc[a][b][m][n] = (f32x4){0.f, 0.f, 0.f, 0.f};
    bf16x8 At[4][2], B0[2][2], B1[2][2];
    const char* cA = (const char*)g.A + g.a_off(cur.pm); const char* cB = (const char*)g.Bt + (size_t)cur.pn * tstep;
    S.a_ready(cur);
    if constexpr (SP2) {
        PG8_STAGE(PG8_SB(0, 0), cB, voffB); PG8_STAGE(PG8_SB(0, 1), cB + hstep, voffB); PG8_STAGE(PG8_SA(0, 0), cA, voffA); PG8_STAGE(PG8_SA(0, 1), cA + hstep, voffA);
        if (wr == 1) PG8_BAR;
        PG8_WAIT_V(2); PG8_BAR;
        PG8_STAGE(PG8_SB(1, 0), cB + kstep, voffB); PG8_STAGE(PG8_SA(1, 0), cA + kstep, voffA); PG8_STAGE(PG8_SB(1, 1), cB + hstep + kstep, voffB);
        PG8_WAIT_V(6); PG8_BAR;
    } else {
        PG8_STAGE(PG8_SB(0, 0), cB, voffB); PG8_STAGE(PG8_SA(0, 0), cA, voffA); PG8_STAGE(PG8_SB(0, 1), cB + hstep, voffB); PG8_STAGE(PG8_SA(0, 1), cA + hstep, voffA);
        if (wr == 1) PG8_BAR;
        PG8_WAIT_V(4); PG8_BAR;
        PG8_STAGE(PG8_SB(1, 0), cB + kstep, voffB); PG8_STAGE(PG8_SA(1, 0), cA + kstep, voffA); PG8_STAGE(PG8_SB(1, 1), cB + hstep + kstep, voffB);
        PG8_WAIT_V(6); PG8_BAR;
    }
    for (;;) {
        const bool has_next = S.next(ui + 1, nxt);
        const char* nA = has_next ? (const char*)g.A + g.a_off(nxt.pm) : cA; const char* nB = has_next ? (const char*)g.Bt + (size_t)nxt.pn * tstep : cB;
        for (int t = 0; t < nt; t += 2) {
            const bool last = (t == nt - 2);
            const char* a1 = cA + (size_t)(t + 1) * kstep;
            const char* a2 = last ? nA : cA + (size_t)(t + 2) * kstep; const char* b2 = last ? nB : cB + (size_t)(t + 2) * kstep;
            const char* a3 = a2 + kstep; const char* b3 = b2 + kstep;
            if (last && has_next) S.a_ready(nxt);
            if constexpr (SP2) {
            PG8_LDB(B0, 0, 0); PG8_LDB(B1, 0, 1); PG8_SCHED; PG8_LDA(At, 0, 0); PG8_STAGE(PG8_SA(1, 1), a1 + hstep, voffA);
            PG8_WAIT_V(8); PG8_WAIT_L(0); PG8_BAR; PG8_MMA(0, 0, At, B0); PG8_MMA(0, 1, At, B1); PG8_BAR; PG8_SCHED;
            PG8_LDA(At, 0, 1); PG8_STAGE(PG8_SB(0, 0), b2, voffB); PG8_STAGE(PG8_SB(0, 1), b2 + hstep, voffB); PG8_STAGE(PG8_SA(0, 0), a2, voffA);
            PG8_WAIT_V(8); PG8_WAIT_L(0); PG8_BAR; PG8_MMA(1, 0, At, B0); PG8_MMA(1, 1, At, B1); PG8_BAR; PG8_SCHED;
            PG8_LDB(B0, 1, 0); PG8_LDB(B1, 1, 1); PG8_SCHED; PG8_LDA(At, 1, 0); PG8_STAGE(PG8_SA(0, 1), a2 + hstep, voffA);
            PG8_WAIT_V(8); PG8_WAIT_L(0); PG8_BAR; PG8_MMA(0, 0, At, B0); PG8_MMA(0, 1, At, B1); PG8_BAR; PG8_SCHED;
            PG8_LDA(At, 1, 1); PG8_STAGE(PG8_SB(1, 0), b3, voffB); PG8_STAGE(PG8_SB(1, 1), b3 + hstep, voffB); PG8_STAGE(PG8_SA(1, 0), a3, voffA);
            PG8_WAIT_V(8); PG8_WAIT_L(0); PG8_BAR; PG8_MMA(1, 0, At, B0); PG8_MMA(1, 1, At, B1); PG8_BAR; PG8_SCHED;
            } else {
            PG8_LDB(B0, 0, 0); PG8_SCHED; PG8_LDA(At, 0, 0); PG8_STAGE(PG8_SA(1, 1), a1 + hstep, voffA);
            PG8_WAIT_L(8); PG8_BAR; PG8_WAIT_L(0); PG8_MMA(0, 0, At, B0); PG8_BAR; PG8_SCHED;
            PG8_LDB(B1, 0, 1); PG8_STAGE(PG8_SB(0, 0), b2, voffB);
            PG8_BAR; PG8_WAIT_L(0); PG8_MMA(0, 1, At, B1); PG8_BAR;
            PG8_LDA(At, 0, 1); PG8_STAGE(PG8_SA(0, 0), a2, voffA);
            PG8_BAR; PG8_WAIT_L(0); PG8_MMA(1, 0, At, B0); PG8_BAR; PG8_SCHED;
            PG8_STAGE(PG8_SB(0, 1), b2 + hstep, voffB);
            PG8_WAIT_V(6); PG8_BAR; PG8_MMA(1, 1, At, B1); PG8_BAR;
            PG8_LDB(B0, 1, 0); PG8_SCHED; PG8_LDA(At, 1, 0); PG8_STAGE(PG8_SA(0, 1), a2 + hstep, voffA);
            PG8_WAIT_L(8); PG8_BAR; PG8_WAIT_L(0); PG8_MMA(0, 0, At, B0); PG8_BAR; PG8_SCHED;
            PG8_LDB(B1, 1, 1); PG8_STAGE(PG8_SB(1, 0), b3, voffB);
            PG8_BAR; PG8_WAIT_L(0); PG8_MMA(0, 1, At, B1); PG8_BAR;
            PG8_LDA(At, 1, 1); PG8_STAGE(PG8_SA(1, 0), a3, voffA);
            PG8_BAR; PG8_WAIT_L(0); PG8_MMA(1, 0, At, B0); PG8_BAR; PG8_SCHED;
            PG8_STAGE(PG8_SB(1, 1), b3 + hstep, voffB);
            PG8_WAIT_V(6); PG8_BAR; PG8_MMA(1, 1, At, B1); PG8_BAR;
            }
        }
        if constexpr (ALIGN_EPI) { if (wr == 0) PG8_BAR; }
        if constexpr (!Epi::AFTER_DRAIN) { E(acc, cur, wr, wc, fr, fq, lds + STAGE_BYTES); S.done(cur); }
        if (!has_next) break;
#pragma unroll
        for (int a = 0; a < 2; ++a)
#pragma unroll
            for (int b = 0; b < 2; ++b)
#pragma unroll
                for (int m = 0; m < 4; ++m)
#pragma unroll
                    for (int n = 0; n < 2; ++n) acc[a][b][m][n] = (f32x4){0.f, 0.f, 0.f, 0.f};
        cur = nxt; cA = nA; cB = nB; ++ui;
        if constexpr (ALIGN_EPI) { if (wr == 1) PG8_BAR; }
    }
    PG8_WAIT_V(0);
    if constexpr (!ALIGN_EPI) { if (wr == 0) PG8_BAR; }
    PG8_BAR;

#undef PG8_SA
#undef PG8_SB
#undef PG8_STAGE
#undef PG8_LDA
#undef PG8_LDB
#undef PG8_MMA
#undef PG8_WAIT_V
#undef PG8_WAIT_L
#undef PG8_BAR
#undef PG8_SCHED
}
}

#define LAS __attribute__((address_space(3)))
typedef unsigned short bf16;
typedef unsigned v4u __attribute__((ext_vector_type(4)));
typedef unsigned v2u __attribute__((ext_vector_type(2)));
typedef float f32x4 __attribute__((ext_vector_type(4)));
constexpr int NWAVES = 8, NTHR = 512;
constexpr int RING_BYTES = 131072, XCH_BYTES = 16384, LDS_BYTES = RING_BYTES + XCH_BYTES + 1024;

constexpr size_t MiB = 1u << 20;
constexpr size_t SZ_WIN = (size_t)NIN * DM * 2, SZ_WOUT = (size_t)DM * DI * 2, SZ_WKVQ = (size_t)3072 * DM * 2, SZ_WO = (size_t)DM * DM * 2, SZ_WUP = (size_t)NUP * DM * 2, SZ_WDN = (size_t)DM * DFF * 2;
constexpr size_t WS_WIN = 1 * MiB, WS_WOUT = WS_WIN + SZ_WIN, WS_WKVQ = WS_WOUT + SZ_WOUT, WS_WO = WS_WKVQ + SZ_WKVQ, WS_WUP0 = WS_WO + SZ_WO, WS_WUP1 = WS_WUP0 + SZ_WUP, WS_WDN0 = WS_WUP1 + SZ_WUP, WS_WDN1 = WS_WDN0 + SZ_WDN, WS_WEND = WS_WDN1 + SZ_WDN;
constexpr size_t WS_DT = 57 * MiB;
constexpr size_t WS_XBC = 60 * MiB;
constexpr size_t WS_H = WS_XBC;
constexpr size_t WS_Z = 158 * MiB;
constexpr size_t WS_ST = 223 * MiB;
constexpr size_t WS_ACT = 126 * MiB;
constexpr size_t WS_K = 126 * MiB, WS_V = 159 * MiB, WS_Q = 192 * MiB;
constexpr size_t WS_END = 256 * MiB;
static_assert(WS_WEND <= WS_DT && WS_DT + (size_t)MR * 32 * 4 <= WS_XBC && WS_XBC + (size_t)MR * CONVD * 2 <= WS_Z && WS_Z + (size_t)MR * DI * 2 <= WS_ST, "ws map 1");
static_assert(WS_H + (size_t)MR * DM * 4 <= WS_ACT && WS_ACT + (size_t)MR * DFF * 2 <= WS_END && WS_K + (size_t)MR * DM * 2 <= WS_V && WS_V + (size_t)MR * DM * 2 <= WS_Q && WS_Q + (size_t)MR * DM * 2 <= WS_END, "ws map 2");

__device__ __forceinline__ unsigned f2bf(float f) { unsigned u = __builtin_bit_cast(unsigned, f); return (u + 0x7fffu + ((u >> 16) & 1u)) >> 16; }
__device__ __forceinline__ unsigned pk2(float lo, float hi) { return f2bf(lo) | (f2bf(hi) << 16); }
__device__ __forceinline__ float wave_sum(float v) {
#pragma unroll
    for (int o = 1; o < 64; o <<= 1) v += __shfl_xor(v, o);
    return v;
}
__device__ __forceinline__ float bf_lo(unsigned u) { return __uint_as_float(u << 16); }
__device__ __forceinline__ float bf_hi(unsigned u) { return __uint_as_float(u & 0xffff0000u); }

__device__ __forceinline__ void transpose_item(const float* W, int pitch, int K, bf16* WT, int nrow0, int srccol0, int k0, const float* gain, LAS float* scr, int lane) {
#pragma unroll 8
    for (int i = 0; i < 32; ++i) { const int kk = 2 * i + (lane >> 5); float v = 0.f;
        if (srccol0 >= 0) { v = W[(size_t)(k0 + kk) * pitch + srccol0 + (lane & 31)]; if (gain) v *= gain[k0 + kk]; }
        scr[kk * 33 + (lane & 31)] = v; }
    asm volatile("s_waitcnt lgkmcnt(0)" ::: "memory");
    const int c = lane & 7;
#pragma unroll
    for (int j = 0; j < 4; ++j) { const int n = (lane >> 3) + 8 * j; const LAS float* s = scr + (8 * c) * 33 + n;
        v4u o; o.x = pk2(s[0 * 33], s[1 * 33]); o.y = pk2(s[2 * 33], s[3 * 33]); o.z = pk2(s[4 * 33], s[5 * 33]); o.w = pk2(s[6 * 33], s[7 * 33]);
        *(v4u*)(WT + (size_t)(nrow0 + n) * K + k0 + 8 * c) = o; }
    asm volatile("s_waitcnt lgkmcnt(0)" ::: "memory");
}

struct Args {
    const float* in[22]; float* outp; unsigned char* wsp; int ph_lo, ph_hi, coop, pad;
};

__device__ __forceinline__ void norm_row(const float* src, bf16* dst, int lane) {
    v2u* o8 = (v2u*)dst + lane;
    if (!src) {
#pragma unroll
        for (int j = 0; j < 4; ++j) o8[64 * j] = (v2u){0u, 0u};
        return; }
    const f32x4* xr = (const f32x4*)src + lane;
    f32x4 v[4]; float s = 0.f;
#pragma unroll
    for (int j = 0; j < 4; ++j) { v[j] = xr[64 * j]; s += (v[j].x * v[j].x + v[j].y * v[j].y) + (v[j].z * v[j].z + v[j].w * v[j].w); }
    const float rstd = 1.0f / sqrtf(wave_sum(s) * (1.f / DM) + EPS);
#pragma unroll
    for (int j = 0; j < 4; ++j) o8[64 * j] = (v2u){pk2(v[j].x * rstd, v[j].y * rstd), pk2(v[j].z * rstd, v[j].w * rstd)};
}
__device__ __forceinline__ const float* stream_row(int r, int mode, const float* H, const float* x, const float* meta) {
    if (r >= 2 * BS) return nullptr;
    const int b = r >= BS ? 1 : 0, l = r - b * BS - OFF;
    if (l < 0 || l >= LTOK) return nullptr;
    if (mode == 0) return H + (size_t)r * DM;
    return l < NMETA ? meta + (size_t)l * DM : x + ((size_t)b * SEQ + (l - NMETA)) * DM;
}

__device__ __forceinline__ const void* ptab(volatile LAS unsigned* PT, int k) {
    const unsigned lo_ = PT[2 * k], hi_ = PT[2 * k + 1];
    return (const void*)(const __attribute__((address_space(1))) void*)(((unsigned long long)(unsigned)__builtin_amdgcn_readfirstlane((int)hi_) << 32) | (unsigned long long)(unsigned)__builtin_amdgcn_readfirstlane((int)lo_));
}
#define xin ((const float*)ptab(PT, 0))
#define metain ((const float*)ptab(PT, 1))
#define ssd_norm ((const float*)ptab(PT, 2))
#define ssd_w_in ((const float*)ptab(PT, 3))
#define ssd_conv_w ((const float*)ptab(PT, 4))
#define ssd_conv_b ((const float*)ptab(PT, 5))
#define ssd_dt_bias ((const float*)ptab(PT, 6))
#define ssd_a_log ((const float*)ptab(PT, 7))
#define ssd_d_skip ((const float*)ptab(PT, 8))
#define ssd_gate_norm ((const float*)ptab(PT, 9))
#define ssd_w_out ((const float*)ptab(PT, 10))
#define kv_norm ((const float*)ptab(PT, 11))
#define w_kv ((const float*)ptab(PT, 12))
#define sb_norm ((const float*)ptab(PT, 13))
#define sb_w_q ((const float*)ptab(PT, 14))
#define sb_w_o ((const float*)ptab(PT, 15))
#define ffn_norm ((const float*)ptab(PT, 16))
#define ffn_w_up ((const float*)ptab(PT, 17))
#define ffn_conv_w ((const float*)ptab(PT, 18))
#define ffn_conv_b ((const float*)ptab(PT, 19))
#define ffn_w_down ((const float*)ptab(PT, 20))
#define final_norm ((const float*)ptab(PT, 21))
#define ws ((unsigned char*)ptab(PT, 22))
#define Win ((bf16*)(ws + WS_WIN))
#define Wout ((bf16*)(ws + WS_WOUT))
#define Wkvq ((bf16*)(ws + WS_WKVQ))
#define Wo ((bf16*)(ws + WS_WO))
#define Wup0 ((bf16*)(ws + WS_WUP0))
#define Wup1 ((bf16*)(ws + WS_WUP1))
#define Wdn0 ((bf16*)(ws + WS_WDN0))
#define Wdn1 ((bf16*)(ws + WS_WDN1))
#define DT ((float*)(ws + WS_DT))
#define XBC ((bf16*)(ws + WS_XBC))
#define H ((float*)(ws + WS_H))
#define Z ((bf16*)(ws + WS_Z))
#define ACT ((bf16*)(ws + WS_ACT))
#define KB ((bf16*)(ws + WS_K))
#define VB ((bf16*)(ws + WS_V))
#define QB ((bf16*)(ws + WS_Q))
#define XN ((bf16*)ptab(PT, 23))
#define OUTP ((float*)ptab(PT, 23))
__global__ void __launch_bounds__(NTHR, 2) mega(const Args args) {
    extern __shared__ __attribute__((aligned(16))) unsigned char lds_raw[];
    LAS unsigned char* lds = (LAS unsigned char*)lds_raw;
    const int tid = threadIdx.x, lane = tid & 63, wave = __builtin_amdgcn_readfirstlane(tid >> 6);
    const int G = gridDim.x, bx = blockIdx.x;
    const int gw = bx * NWAVES + wave, NGW = G * NWAVES;
    volatile LAS unsigned* PT = (volatile LAS unsigned*)(lds + RING_BYTES + XCH_BYTES);
    if (tid < 24) { const unsigned long long pv = tid < 22 ? (unsigned long long)args.in[tid] : (tid == 22 ? (unsigned long long)args.wsp : (unsigned long long)args.outp); PT[2 * tid] = (unsigned)pv; PT[2 * tid + 1] = (unsigned)(pv >> 32); }
    __syncthreads();
    const int lo = args.ph_lo, hi = args.ph_hi;
#define IN(k) (lo <= (k) && (k) < hi)
#define SEAM(k) do { if (args.coop && IN(k) && IN((k) + 1)) { cg::this_grid().sync(); } } while (0)

    if (IN(0)) {
        LAS float* scr = (LAS float*)(lds + wave * 16384);
        constexpr int I_IN = 16 * (NIN / 32), I_OUT = 32 * 32, I_KVQ = 16 * 96, I_O = 16 * 32, I_UP = 16 * (NUP / 32), I_DN = 44 * 32;
        constexpr int NITEMS = I_IN + I_OUT + I_KVQ + I_O + 2 * I_UP + 2 * I_DN;
        for (int it = gw; it < NITEMS; it += NGW) {
            int r = it;
            if (r < I_IN) { const int nb = r % (NIN / 32), kb = r / (NIN / 32), n0 = nb * 32; transpose_item(ssd_w_in, NIN_REAL, DM, Win, n0, n0 < NIN_REAL ? n0 : -1, kb * 64, ssd_norm, scr, lane); continue; } r -= I_IN;
            if (r < I_OUT) { const int nb = r % 32, kb = r / 32; transpose_item(ssd_w_out, DM, DI, Wout, nb * 32, nb * 32, kb * 64, ssd_gate_norm, scr, lane); continue; } r -= I_OUT;
            if (r < I_KVQ) { const int nb = r % 96, kb = r / 96, n0 = nb * 32;
                if (n0 < 2048) transpose_item(w_kv, 2048, DM, Wkvq, n0, n0, kb * 64, kv_norm, scr, lane); else transpose_item(sb_w_q, DM, DM, Wkvq, n0, n0 - 2048, kb * 64, sb_norm, scr, lane);
                continue; } r -= I_KVQ;
            if (r < I_O) { const int nb = r % 32, kb = r / 32; transpose_item(sb_w_o, DM, DM, Wo, nb * 32, nb * 32, kb * 64, nullptr, scr, lane); continue; } r -= I_O;
            if (r < 2 * I_UP) { const int ly = r / I_UP; r -= ly * I_UP; const int nb = r % (NUP / 32), kb = r / (NUP / 32), n0 = nb * 32;
                const int src = ((n0 >> 7) & 1) * DFF + (n0 >> 8) * 128 + (n0 & 127);
                transpose_item(ffn_w_up + (size_t)ly * DM * NUP, NUP, DM, ly ? Wup1 : Wup0, n0, src, kb * 64, ffn_norm + ly * DM, scr, lane); continue; } r -= 2 * I_UP;
            { const int ly = r / I_DN; r -= ly * I_DN; const int nb = r % 32, kb = r / 32;
              transpose_item(ffn_w_down + (size_t)ly * DFF * DM, DM, DFF, ly ? Wdn1 : Wdn0, nb * 32, nb * 32, kb * 64, nullptr, scr, lane); }
        }
        for (int r = gw; r < MRX; r += NGW) norm_row(stream_row(r, 1, H, xin, metain), XN + (size_t)r * DM, lane);
    }
    SEAM(0);
    if (IN(1)) {
        pg8::Gemm g{XN, Win, 2 * TPB * 256, NIN, DM, 3}; pg8::StaticOrder S; S.init(2 * TPB * 256, NIN, G, bx);
        pg8::EpiInProj E{Z, XBC, DT, ssd_conv_w, ssd_conv_b, ssd_dt_bias};
        pg8::gemm_phase<pg8::EpiInProj, pg8::StaticOrder, true, true>(lds, g, S, E);
    }
    SEAM(1);
    if (IN(2)) {
        LAS v4u* BC = (LAS v4u*)lds;
        LAS unsigned short* XS = (LAS unsigned short*)(lds + 8192);
        LAS float* DTS = (LAS float*)(lds + 8192 + 2048);
        LAS float* YP = (LAS float*)(lds + 16384);
        bf16* xbc = XBC; const float* dtp = DT;
        for (int task = bx; task < NBATCH * NHS; task += G) {
            const int b = task / NHS, h = task % NHS, g = h >> 3;
            const float a = -__expf(ssd_a_log[h]), dsk = ssd_d_skip[h];
            float st[16];
#pragma unroll
            for (int n = 0; n < 16; ++n) st[n] = 0.f;
            for (int blk = 0; blk < LTOK / 16; ++blk) {
                const int row0 = b * BS + OFF + blk * 16;
                { const int idx = tid, rr = idx >> 5, w = idx & 31, seg = w >> 4, ch = w & 15;
                  BC[idx] = *(const v4u*)(xbc + (size_t)(row0 + rr) * CONVD + DI + seg * 512 + g * 128 + ch * 8); }
                if (tid < 128) { const int rr = tid >> 3, ch = tid & 7; ((LAS v4u*)XS)[tid] = *(const v4u*)(xbc + (size_t)(row0 + rr) * CONVD + h * 64 + ch * 8); }
                if (tid < 16) DTS[tid] = dtp[(size_t)(row0 + tid) * NHS + h];
                __syncthreads();
#pragma unroll 4
                for (int s = 0; s < 16; ++s) {
                    const float dt = DTS[s], xv = __uint_as_float((unsigned)XS[s * 64 + lane] << 16);
                    const float dA = __expf(dt * a), dtx = dt * xv; float y = 0.f;
#pragma unroll
                    for (int c = 0; c < 2; ++c) { const v4u bq = BC[s * 32 + wave * 2 + c], cq = BC[s * 32 + 16 + wave * 2 + c];
#pragma unroll
                        for (int e = 0; e < 4; ++e) { const unsigned bw = bq[e], cw2 = cq[e];
                            st[c * 8 + 2 * e] = st[c * 8 + 2 * e] * dA + dtx * bf_lo(bw); y += bf_lo(cw2) * st[c * 8 + 2 * e];
                            st[c * 8 + 2 * e + 1] = st[c * 8 + 2 * e + 1] * dA + dtx * bf_hi(bw); y += bf_hi(cw2) * st[c * 8 + 2 * e + 1]; } }
                    YP[(wave * 16 + s) * 64 + lane] = y;
                }
                __syncthreads();
#pragma unroll
                for (int ss = 0; ss < 2; ++ss) { const int s = wave * 2 + ss; float y = dsk * __uint_as_float((unsigned)XS[s * 64 + lane] << 16);
#pragma unroll
                    for (int w = 0; w < 8; ++w) y += YP[(w * 16 + s) * 64 + lane];
                    xbc[(size_t)(row0 + s) * CONVD + h * 64 + lane] = (bf16)f2bf(y); }
                __syncthreads();
            }
        }
    }
    SEAM(2);
    if (IN(3)) {
        for (int r = gw; r < 2 * BS; r += NGW) {
            const int b = r >= BS ? 1 : 0, l = r - b * BS - OFF; if (l < 0 || l >= LTOK) continue;
#pragma unroll
            for (int g = 0; g < 4; ++g) {
                const v4u yq = *(const v4u*)(XBC + (size_t)r * CONVD + g * 512 + lane * 8); v4u* zp = (v4u*)(Z + (size_t)r * DI + g * 512 + lane * 8); const v4u zq = *zp;
                float hv[8]; float ss = 0.f;
#pragma unroll
                for (int e = 0; e < 4; ++e) { const float y0 = bf_lo(yq[e]), y1 = bf_hi(yq[e]), z0 = bf_lo(zq[e]), z1 = bf_hi(zq[e]);
                    hv[2 * e] = y0 * pg8::silu_f(z0); hv[2 * e + 1] = y1 * pg8::silu_f(z1); ss += hv[2 * e] * hv[2 * e] + hv[2 * e + 1] * hv[2 * e + 1]; }
                const float rs = 1.0f / sqrtf(wave_sum(ss) * (1.f / 512.f) + EPS);
                *zp = (v4u){pk2(hv[0] * rs, hv[1] * rs), pk2(hv[2] * rs, hv[3] * rs), pk2(hv[4] * rs, hv[5] * rs), pk2(hv[6] * rs, hv[7] * rs)};
            }
        }
    }
    SEAM(3);
    if (IN(4)) {
        pg8::Gemm g{Z, Wout, MR, DM, DI, 0}; pg8::StaticOrder S; S.init(MR, DM, G, bx);
        pg8::EpiResid<1> E{H, xin, metain};
        pg8::gemm_phase<pg8::EpiResid<1>, pg8::StaticOrder, true, true>(lds, g, S, E);
    }
    SEAM(4);
#pragma unroll 1
    for (int ly = 0; ly < 2; ++ly) {
        const int pb = ly == 0 ? 5 : 12;
        if (ly == 1) {
            if (IN(8)) { for (int r = gw; r < MRX; r += NGW) norm_row(stream_row(r, 0, H, xin, metain), XN + (size_t)r * DM, lane); }
            SEAM(8);
            if (IN(9)) {
                pg8::Gemm g{XN, Wkvq, MR, 3072, DM, 0}; pg8::StaticOrder S; S.init(MR, 3072, G, bx);
                pg8::EpiBf16 E{KB, DM, DM, (size_t)(WS_V - WS_K) / 2};
                pg8::gemm_phase<pg8::EpiBf16, pg8::StaticOrder, true, true>(lds, g, S, E);
            }
            SEAM(9);
            if (IN(10)) {
                constexpr int NTB = (LTOK + 63) / 64;
                for (int task = gw; task < NBATCH * 16 * NTB; task += NGW) {
                    const int tb = task % NTB, bh = task / NTB, b = bh >> 4, h = bh & 15;
                    const int t = tb * 64 + lane; const bool tv = t < LTOK;
                    const size_t rq = (size_t)(b * BS + OFF + (tv ? t : 0));
                    float q[64], o[64];
                    { const v4u* qp = (const v4u*)(QB + rq * DM + h * 64);
#pragma unroll
                      for (int c = 0; c < 8; ++c) { const v4u w = qp[c];
#pragma unroll
                          for (int e = 0; e < 4; ++e) { q[c * 8 + 2 * e] = bf_lo(w[e]) * 0.125f; q[c * 8 + 2 * e + 1] = bf_hi(w[e]) * 0.125f; } } }
#pragma unroll
                    for (int d = 0; d < 64; ++d) o[d] = 0.f;
                    float later = 0.f;
                    for (int j = 1; ; ++j) {
                        const int s = t - j; const bool act = tv && s >= 0 && later > -110.f;
                        if (!__any(act)) break;
                        if (act) {
                            const size_t rk = (size_t)(b * BS + OFF + s);
                            const v4u* kp = (const v4u*)(KB + rk * DM + h * 64); const v4u* vp = (const v4u*)(VB + rk * DM + h * 64);
                            float lg = 0.f;
#pragma unroll
                            for (int c = 0; c < 8; ++c) { const v4u w = kp[c];
#pragma unroll
                                for (int e = 0; e < 4; ++e) { lg += q[c * 8 + 2 * e] * bf_lo(w[e]); lg += q[c * 8 + 2 * e + 1] * bf_hi(w[e]); } }
                            const float lsp = fminf(lg, 0.f) - log1pf(__expf(-fabsf(lg)));
                            const float wgt = __expf(lsp + later);
                            later += lsp - lg;
#pragma unroll
                            for (int c = 0; c < 8; ++c) { const v4u w = vp[c];
#pragma unroll
                                for (int e = 0; e < 4; ++e) { o[c * 8 + 2 * e] += wgt * bf_lo(w[e]); o[c * 8 + 2 * e + 1] += wgt * bf_hi(w[e]); } }
                        }
                    }
                    if (tv) { v4u* op = (v4u*)(QB + rq * DM + h * 64);
#pragma unroll
                        for (int c = 0; c < 8; ++c) op[c] = (v4u){pk2(o[c * 8], o[c * 8 + 1]), pk2(o[c * 8 + 2], o[c * 8 + 3]), pk2(o[c * 8 + 4], o[c * 8 + 5]), pk2(o[c * 8 + 6], o[c * 8 + 7])}; }
                }
            }
            SEAM(10);
            if (IN(11)) {
                pg8::Gemm g{QB, Wo, MR, DM, DM, 0}; pg8::StaticOrder S; S.init(MR, DM, G, bx);
                pg8::EpiResid<0> E{H, nullptr, nullptr};
                pg8::gemm_phase<pg8::EpiResid<0>, pg8::StaticOrder, true, true>(lds, g, S, E);
            }
            SEAM(11);
        }
        if (IN(pb)) { for (int r = gw; r < MRX; r += NGW) norm_row(stream_row(r, 0, H, xin, metain), XN + (size_t)r * DM, lane); }
        SEAM(pb);
        if (IN(pb + 1)) {
            pg8::Gemm g{XN, ly ? Wup1 : Wup0, 2 * TPB * 256, NUP, DM, 2}; pg8::StaticOrder S; S.init(2 * TPB * 256, NUP, G, bx);
            pg8::EpiUp E{ACT, ffn_conv_w + (size_t)ly * 3 * NUP, ffn_conv_b + (size_t)ly * NUP};
            pg8::gemm_phase<pg8::EpiUp, pg8::StaticOrder, true, true>(lds, g, S, E);
        }
        SEAM(pb + 1);
        if (IN(pb + 2)) {
            pg8::Gemm g{ACT, ly ? Wdn1 : Wdn0, MR, DM, DFF, 0}; pg8::StaticOrder S; S.init(MR, DM, G, bx);
            pg8::EpiResid<0> E{H, nullptr, nullptr};
            pg8::gemm_phase<pg8::EpiResid<0>, pg8::StaticOrder, true, true>(lds, g, S, E);
        }
        SEAM(pb + 2);
    }
    if (IN(15)) {
        for (int r = gw; r < NBATCH * SEQ; r += NGW) {
            const int b = r / SEQ, t = r % SEQ; const f32x4* xr = (const f32x4*)(H + (size_t)(b * BS + OFF + NMETA + t) * DM) + lane;
            f32x4 v[4]; float s = 0.f;
#pragma unroll
            for (int j = 0; j < 4; ++j) { v[j] = xr[64 * j]; s += (v[j].x * v[j].x + v[j].y * v[j].y) + (v[j].z * v[j].z + v[j].w * v[j].w); }
            const float rstd = 1.0f / sqrtf(wave_sum(s) * (1.f / DM) + EPS);
            f32x4* op = (f32x4*)(OUTP + (size_t)r * DM) + lane; const f32x4* gp = (const f32x4*)final_norm + lane;
#pragma unroll
            for (int j = 0; j < 4; ++j) op[64 * j] = v[j] * rstd * gp[64 * j];
        }
    }
#undef IN
#undef SEAM
}

#undef xin
#undef metain
#undef ssd_norm
#undef ssd_w_in
#undef ssd_conv_w
#undef ssd_conv_b
#undef ssd_dt_bias
#undef ssd_a_log
#undef ssd_d_skip
#undef ssd_gate_norm
#undef ssd_w_out
#undef kv_norm
#undef w_kv
#undef sb_norm
#undef sb_w_q
#undef sb_w_o
#undef ffn_norm
#undef ffn_w_up
#undef ffn_conv_w
#undef ffn_conv_b
#undef ffn_w_down
#undef final_norm
#undef ws
#undef Win
#undef Wout
#undef Wkvq
#undef Wo
#undef Wup0
#undef Wup1
#undef Wdn0
#undef Wdn1
#undef DT
#undef XBC
#undef H
#undef Z
#undef ACT
#undef KB
#undef VB
#undef QB
#undef XN
#undef OUTP
constexpr int NPHASES = 16;
extern "C" void kernel_launch(void* const* d_in, const int* in_sizes, int n_in, void* d_out, int out_size, void* d_ws, size_t ws_size, hipStream_t stream) {
    static int grid = 0;
    if (grid == 0) {
        if (n_in != 22 || ws_size < WS_END || out_size != NBATCH * SEQ * DM) { fprintf(stderr, "kernel_launch: unexpected shapes (n_in %d ws %zu out %d)\n", n_in, ws_size, out_size); grid = -1; return; }
        int dev = 0, cus = 0, per_cu = 0;
        (void)hipGetDevice(&dev); (void)hipDeviceGetAttribute(&cus, hipDeviceAttributeMultiprocessorCount, dev);
        (void)hipFuncSetAttribute((const void*)mega, hipFuncAttributeMaxDynamicSharedMemorySize, LDS_BYTES);
        (void)hipOccupancyMaxActiveBlocksPerMultiprocessor(&per_cu, (const void*)mega, NTHR, LDS_BYTES);
        (void)hipGetLastError();
        if (per_cu < 1) per_cu = 1;
        grid = cus * 1;
    }
    if (grid < 0) return;
    Args a{};
    for (int i = 0; i < 22; ++i) a.in[i] = (const float*)d_in[i];
    a.outp = (float*)d_out; a.wsp = (unsigned char*)d_ws;
#if MK_COOP
    a.ph_lo = 0; a.ph_hi = NPHASES; a.coop = 1;
    void* kargs[] = {&a};
    hipError_t e = hipLaunchCooperativeKernel((const void*)mega, dim3(grid), dim3(NTHR), kargs, LDS_BYTES, stream);
    if (e != hipSuccess) fprintf(stderr, "cooperative launch failed: %s (grid %d)\n", hipGetErrorString(e), grid);
#else
    for (int p = 0; p < NPHASES; ++p) { a.ph_lo = p; a.ph_hi = p + 1; a.coop = 0; hipLaunchKernelGGL(mega, dim3(grid), dim3(NTHR), LDS_BYTES, stream, a); }
#endif
}
```

```cpp
#include <hip/hip_runtime.h>
#include <hip/hip_cooperative_groups.h>
#include <cstdio>
#include <cstdint>
namespace cg = cooperative_groups;

constexpr int DM = 1024, NBATCH = 2, SEQ = 8192, NMETA = 16, LTOK = NMETA + SEQ;
constexpr int BS = 8224, OFF = 16;
constexpr int MR = 65 * 256;
constexpr int MRX = 66 * 256;
constexpr int TPB = 33;
constexpr int DI = 2048, NSTATE = 128, NHS = 32, CONVD = 3072, NIN = 5376, NIN_REAL = 5152;
constexpr int DFF = 2816, NUP = 5632;
constexpr float EPS = 1e-6f;

#ifndef MK_COOP
#define MK_COOP 1
#endif
namespace pg8 {
#define PG8_LAS __attribute__((address_space(3)))
typedef unsigned short bf16_t;
typedef short bf16x8 __attribute__((ext_vector_type(8)));
typedef float f32x4 __attribute__((ext_vector_type(4)));
typedef unsigned u32x4 __attribute__((ext_vector_type(4)));
constexpr int BM = 256, BK = 64, HALF = 128, HTB = HALF * BK * 2  , STAGE_BYTES = 8 * HTB, NXCD = 8, WGM = 8;

__host__ __device__ __forceinline__ int lds_byte(int r, int c) { const int st = (r >> 4) * 2 + (c >> 5), rr = r & 15, cc = c & 31, ob = rr * 64 + cc * 2; return st * 1024 + (ob ^ (((ob >> 9) & 1) << 5)); }
__host__ __device__ __forceinline__ void stage_rc(int b, int& R, int& C) { const int st = b / 1024, sb = b % 1024, swz = sb ^ (((sb >> 9) & 1) << 5); R = (st >> 1) * 16 + swz / 64; C = (st & 1) * 32 + (swz % 64) / 2; }
__host__ __device__ __forceinline__ int perm32(int rho) { const int n = rho >> 4, i = rho & 15; return 8 * (i >> 2) + 4 * n + (i & 3); }

struct Unit { int pm, pn; };
struct Gemm { const bf16_t* A; const bf16_t* Bt; int M, N, K; int halo;
    __device__ __forceinline__ size_t a_off(int pm) const { const int row = halo == 0 ? pm * 256 : (pm / TPB) * BS + OFF - halo + (256 - halo) * (pm % TPB); return (size_t)row * (size_t)K * 2; } };

struct StaticOrder {
    int nM, nN, nwg, G, c;
    __host__ __device__ void init(int M, int N, int G_, int c_) { nM = M / BM; nN = N / BM; nwg = nM * nN; G = G_; c = c_; }
    __host__ __device__ bool next(int i, Unit& u) const {
        const long L = (long)i * G + c; if (L >= nwg) return false;
        int wgid = (int)L; { const int q = nwg / NXCD, r = nwg % NXCD, xcd = wgid % NXCD, off = wgid / NXCD; wgid = (xcd < r ? xcd * (q + 1) : r * (q + 1) + (xcd - r) * q) + off; }
        const int nig = WGM * nN, gid = wgid / nig, fm = gid * WGM, gsz = (nM - fm) < WGM ? (nM - fm) : WGM;
        u.pm = fm + ((wgid % nig) % gsz); u.pn = (wgid % nig) / gsz; return true;
    }
    __device__ __forceinline__ void a_ready(const Unit&) const {}
    __device__ __forceinline__ void done(const Unit&) const {}
};

__device__ __forceinline__ unsigned cvt_pk_bf16(float lo, float hi) { unsigned r; asm volatile("v_cvt_pk_bf16_f32 %0, %1, %2" : "=v"(r) : "v"(lo), "v"(hi)); return r; }
typedef float f32x2 __attribute__((ext_vector_type(2)));
__device__ __forceinline__ float silu_f(float v) { return v * __builtin_amdgcn_rcpf(1.0f + __expf(-v)); }
__device__ __forceinline__ float softplus_f(float v) { return fmaxf(v, 0.f) + log1pf(__expf(-fabsf(v))); }
__device__ __forceinline__ float bflo(unsigned u) { return __uint_as_float(u << 16); }
__device__ __forceinline__ float bfhi(unsigned u) { return __uint_as_float(u & 0xffff0000u); }
typedef unsigned u32x2 __attribute__((ext_vector_type(2)));

struct EpiBf16 {
    static constexpr bool PERM = true, AFTER_DRAIN = false;
    bf16_t* O; int ldc; int split_cols; size_t split_stride;
    __device__ __forceinline__ void operator()(const f32x4 (&acc)[2][2][4][2], const Unit& u, int wr, int wc, int fr, int fq, PG8_LAS unsigned char*) const {
        asm volatile("" : "+v"(fr), "+v"(fq));
        const int row0 = u.pm * BM + wr * 64 + fr; int colt = u.pn * BM; bf16_t* base = O;
        if (split_cols) { const int t = colt / split_cols; base += (size_t)t * split_stride; colt -= t * split_cols; }
        const int col0 = colt + wc * 32 + 8 * fq;
#pragma unroll
        for (int ai = 0; ai < 2; ++ai)
#pragma unroll
            for (int m = 0; m < 4; ++m) { bf16_t* rowp = base + (size_t)(row0 + ai * HALF + m * 16) * ldc + col0;
#pragma unroll
                for (int bj = 0; bj < 2; ++bj) { const f32x4 v0 = acc[ai][bj][m][0], v1 = acc[ai][bj][m][1];
                    u32x4 w; w.x = cvt_pk_bf16(v0[0], v0[1]); w.y = cvt_pk_bf16(v0[2], v0[3]); w.z = cvt_pk_bf16(v1[0], v1[1]); w.w = cvt_pk_bf16(v1[2], v1[3]);
                    *(u32x4*)(rowp + bj * HALF) = w; } }
    }
};

template <int mode> struct EpiResid {
    static constexpr bool PERM = false, AFTER_DRAIN = false;
    float* H; const float* x; const float* meta;
    __device__ __forceinline__ void operator()(const f32x4 (&acc)[2][2][4][2], const Unit& u, int wr, int wc, int fr, int fq, PG8_LAS unsigned char*) const {
        asm volatile("" : "+v"(fr), "+v"(fq));
        const int col0 = u.pn * BM + wc * 32 + 4 * fq;
#pragma unroll
        for (int ai = 0; ai < 2; ++ai)
#pragma unroll
            for (int m = 0; m < 4; ++m) {
                const int r = u.pm * BM + ai * HALF + wr * 64 + m * 16 + fr;
                const int b = r >= BS ? 1 : 0, l = r - b * BS - OFF;
                if (l >= 0 && l < LTOK) {
                    float* hp = H + (size_t)r * DM + col0;
                    const float* bp = mode == 0 ? hp : (l < NMETA ? meta + (size_t)l * DM + col0 : x + ((size_t)b * SEQ + (l - NMETA)) * DM + col0);
#pragma unroll
                    for (int bj = 0; bj < 2; ++bj)
#pragma unroll
                        for (int n = 0; n < 2; ++n) { const f32x4 bs = *(const f32x4*)(bp + bj * HALF + n * 16); *(f32x4*)(hp + bj * HALF + n * 16) = bs + acc[ai][bj][m][n]; }
                }
                asm volatile("" ::: "memory");
            }
    }
};

__device__ __forceinline__ void halo_publish(const f32x4 (&acc)[2][2][4][2], PG8_LAS unsigned char* xl, int wr, int wc, int fr, int fq) {
    PG8_LAS f32x4* X = (PG8_LAS f32x4*)xl; const int wave = wr * 4 + wc;
    if (fr >= 12) {
#pragma unroll
        for (int ai = 0; ai < 2; ++ai)
#pragma unroll
            for (int bj = 0; bj < 2; ++bj)
#pragma unroll
                for (int n = 0; n < 2; ++n) X[(((wave * 2 + ai) * 4 + bj * 2 + n) * 16) + fq * 4 + (fr - 12)] = acc[ai][bj][3][n];
    }
    asm volatile("s_waitcnt lgkmcnt(0)" ::: "memory"); __builtin_amdgcn_s_barrier(); asm volatile("" ::: "memory");
}
__device__ __forceinline__ f32x4 halo_get(PG8_LAS unsigned char* xl, int ai, int bj, int n, int wr, int wc, int fr, int fq) {
    const PG8_LAS f32x4* X = (const PG8_LAS f32x4*)xl; const int pai = wr == 1 ? ai : ai - 1, pw = (wr ^ 1) * 4 + wc;
    f32x4 r = (f32x4){0.f, 0.f, 0.f, 0.f};
    if (fr >= 12 && pai >= 0) r = X[(((pw * 2 + pai) * 4 + bj * 2 + n) * 16) + fq * 4 + (fr - 12)];
    return r;
}

struct EpiInProj {
    static constexpr bool PERM = true, AFTER_DRAIN = false;
    bf16_t* Z; bf16_t* XBC; float* DT; const float* cw; const float* cb; const float* dtb;
    __device__ __forceinline__ void operator()(const f32x4 (&acc)[2][2][4][2], const Unit& u, int wr, int wc, int fr, int fq, PG8_LAS unsigned char* xl) const {
        asm volatile("" : "+v"(fr), "+v"(fq));
        const int pb = u.pm / TPB, pt = u.pm % TPB, l0 = 253 * pt - 3, rowbase = pb * BS + OFF + l0, lane = fq * 16 + fr;
        if (u.pn < 8) {
            const int col0 = u.pn * BM + wc * 32 + 8 * fq;
#pragma unroll
            for (int ai = 0; ai < 2; ++ai)
#pragma unroll
                for (int m = 0; m < 4; ++m) { const int i = ai * HALF + wr * 64 + m * 16 + fr, l = l0 + i;
                    if (i >= 3 && l < LTOK) { bf16_t* rowp = Z + (size_t)(rowbase + i) * DI + col0;
#pragma unroll
                        for (int bj = 0; bj < 2; ++bj) { const f32x4 v0 = acc[ai][bj][m][0], v1 = acc[ai][bj][m][1];
                            u32x4 w; w.x = cvt_pk_bf16(v0[0], v0[1]); w.y = cvt_pk_bf16(v0[2], v0[3]); w.z = cvt_pk_bf16(v1[0], v1[1]); w.w = cvt_pk_bf16(v1[2], v1[3]);
                            *(u32x4*)(rowp + bj * HALF) = w; } } }
        } else if (u.pn < 20) {
            halo_publish(acc, xl, wr, wc, fr, fq);
            const int s1 = (lane & 48) | ((fr - 1) & 15), s2 = (lane & 48) | ((fr - 2) & 15), s3 = (lane & 48) | ((fr - 3) & 15);
#pragma unroll
            for (int bj = 0; bj < 2; ++bj)
#pragma unroll
                for (int n = 0; n < 2; ++n) {
                    const int c0 = (u.pn - 8) * BM + bj * HALF + wc * 32 + 8 * fq + 4 * n;
                    const f32x4 w0 = *(const f32x4*)(cw + c0), w1 = *(const f32x4*)(cw + CONVD + c0), w2 = *(const f32x4*)(cw + 2 * CONVD + c0), w3 = *(const f32x4*)(cw + 3 * CONVD + c0), bb = *(const f32x4*)(cb + c0);
#pragma unroll
                    for (int ai = 0; ai < 2; ++ai)
#pragma unroll
                        for (int m = 0; m < 4; ++m) {
                            const f32x4 cur = acc[ai][bj][m][n];
                            f32x4 prv; if (m > 0) prv = acc[ai][bj][m > 0 ? m - 1 : 0][n]; else prv = halo_get(xl, ai, bj, n, wr, wc, fr, fq);
                            float o[4];
#pragma unroll
                            for (int j = 0; j < 4; ++j) {
                                const float v1 = __shfl(fr >= 15 ? prv[j] : cur[j], s1), v2 = __shfl(fr >= 14 ? prv[j] : cur[j], s2), v3 = __shfl(fr >= 13 ? prv[j] : cur[j], s3);
                                o[j] = silu_f(bb[j] + w3[j] * cur[j] + w2[j] * v1 + w1[j] * v2 + w0[j] * v3);
                            }
                            const int i = ai * HALF + wr * 64 + m * 16 + fr, l = l0 + i;
                            if (i >= 3 && l < LTOK) { u32x2 w; w.x = cvt_pk_bf16(o[0], o[1]); w.y = cvt_pk_bf16(o[2], o[3]); *(u32x2*)(XBC + (size_t)(rowbase + i) * CONVD + c0) = w; }
                        }
                    asm volatile("" ::: "memory");
                }
        } else {
            if (wc == 0) {
#pragma unroll
                for (int n = 0; n < 2; ++n) { const int c0 = 8 * fq + 4 * n; const f32x4 bb = *(const f32x4*)(dtb + c0);
#pragma unroll
                    for (int ai = 0; ai < 2; ++ai)
#pragma unroll
                        for (int m = 0; m < 4; ++m) { const int i = ai * HALF + wr * 64 + m * 16 + fr, l = l0 + i; const f32x4 v = acc[ai][0][m][n] + bb;
                            if (i >= 3 && l < LTOK) *(f32x4*)(DT + (size_t)(rowbase + i) * NHS + c0) = (f32x4){softplus_f(v[0]), softplus_f(v[1]), softplus_f(v[2]), softplus_f(v[3])}; } }
            }
        }
    }
};

struct EpiUp {
    static constexpr bool PERM = true, AFTER_DRAIN = false;
    bf16_t* ACT; const float* cw; const float* cb;
    __device__ __forceinline__ void operator()(const f32x4 (&acc)[2][2][4][2], const Unit& u, int wr, int wc, int fr, int fq, PG8_LAS unsigned char* xl) const {
        asm volatile("" : "+v"(fr), "+v"(fq));
        const int pb = u.pm / TPB, pt = u.pm % TPB, l0 = 254 * pt - 2, rowbase = pb * BS + OFF + l0, lane = fq * 16 + fr;
        halo_publish(acc, xl, wr, wc, fr, fq);
        const int s1 = (lane & 48) | ((fr - 1) & 15), s2 = (lane & 48) | ((fr - 2) & 15);
#pragma unroll
        for (int n = 0; n < 2; ++n) {
            const int c0 = u.pn * HALF + wc * 32 + 8 * fq + 4 * n;
            const f32x4 g0 = *(const f32x4*)(cw + c0), g1 = *(const f32x4*)(cw + NUP + c0), g2 = *(const f32x4*)(cw + 2 * NUP + c0), gb = *(const f32x4*)(cb + c0);
            const f32x4 h0 = *(const f32x4*)(cw + DFF + c0), h1 = *(const f32x4*)(cw + NUP + DFF + c0), h2 = *(const f32x4*)(cw + 2 * NUP + DFF + c0), hb = *(const f32x4*)(cb + DFF + c0);
#pragma unroll
            for (int ai = 0; ai < 2; ++ai)
#pragma unroll
                for (int m = 0; m < 4; ++m) {
                    const f32x4 cg = acc[ai][0][m][n], cv = acc[ai][1][m][n];
                    f32x4 pg, pv; if (m > 0) { pg = acc[ai][0][m > 0 ? m - 1 : 0][n]; pv = acc[ai][1][m > 0 ? m - 1 : 0][n]; } else { pg = halo_get(xl, ai, 0, n, wr, wc, fr, fq); pv = halo_get(xl, ai, 1, n, wr, wc, fr, fq); }
                    float o[4];
#pragma unroll
                    for (int j = 0; j < 4; ++j) {
                        const float a1 = __shfl(fr >= 15 ? pg[j] : cg[j], s1), a2 = __shfl(fr >= 14 ? pg[j] : cg[j], s2);
                        const float b1 = __shfl(fr >= 15 ? pv[j] : cv[j], s1), b2 = __shfl(fr >= 14 ? pv[j] : cv[j], s2);
                        const float gg = gb[j] + g2[j] * cg[j] + g1[j] * a1 + g0[j] * a2, vv = hb[j] + h2[j] * cv[j] + h1[j] * b1 + h0[j] * b2;
                        o[j] = silu_f(gg) * vv;
                    }
                    const int i = ai * HALF + wr * 64 + m * 16 + fr, l = l0 + i;
                    if (i >= 2 && l < LTOK) { u32x2 w; w.x = cvt_pk_bf16(o[0], o[1]); w.y = cvt_pk_bf16(o[2], o[3]); *(u32x2*)(ACT + (size_t)(rowbase + i) * DFF + c0) = w; }
                }
            asm volatile("" ::: "memory");
        }
    }
};

template <class Epi, class Sched, bool ALIGN_EPI = false, bool SP2 = false>
__device__ __forceinline__ void gemm_phase(PG8_LAS unsigned char* lds, const Gemm g, const Sched& S, const Epi& E) {
    const int tid = threadIdx.x, wid = __builtin_amdgcn_readfirstlane(tid >> 6), lane = tid & 63, wr = wid >> 2, wc = wid & 3, fr = lane & 15, fq = lane >> 4;
    const int K = g.K, nt = K / BK;
    unsigned voffA[2], voffB[2];
#pragma unroll
    for (int i = 0; i < 2; ++i) { int R, C; stage_rc(tid * 16 + i * 8192, R, C); const int Rb = Epi::PERM ? ((R & ~31) + perm32(R & 31)) : R;
        voffA[i] = (unsigned)(R * K + C) * 2u; voffB[i] = (unsigned)(Rb * K + C) * 2u; }
    const size_t kstep = (size_t)(BK * 2);
    const size_t hstep = (size_t)HALF * K * 2;
    const size_t tstep = 2 * hstep;
    const unsigned ldsw = (unsigned)wid * 1024u;
    const int aoff = lds_byte(wr * 64 + fr, fq * 8), boff = lds_byte(wc * 32 + fr, fq * 8);
#define PG8_SA(b, h) (((b) * 2 + (h)) * HTB)
#define PG8_SB(b, h) ((4 + (b) * 2 + (h)) * HTB)
#define PG8_STAGE(bufoff, gbase, voff) do { _Pragma("unroll") for (int _i = 0; _i < 2; ++_i) \
        __builtin_amdgcn_global_load_lds((const unsigned*)((const char*)(gbase) + (voff)[_i]), (PG8_LAS unsigned*)(lds + (bufoff) + ldsw + _i * 8192), 16, 0, 0); } while (0)
#define PG8_LDA(dst, b, h) do { _Pragma("unroll") for (int m = 0; m < 4; ++m) _Pragma("unroll") for (int k = 0; k < 2; ++k) dst[m][k] = *(const PG8_LAS bf16x8*)(lds + PG8_SA(b, h) + aoff + m * 2048 + k * 1024); } while (0)
#define PG8_LDB(dst, b, h) do { _Pragma("unroll") for (int n = 0; n < 2; ++n) _Pragma("unroll") for (int k = 0; k < 2; ++k) dst[n][k] = *(const PG8_LAS bf16x8*)(lds + PG8_SB(b, h) + boff + n * 2048 + k * 1024); } while (0)
#define PG8_MMA(ai, bj, At, Bt) do { __builtin_amdgcn_s_setprio(1); _Pragma("unroll") for (int m = 0; m < 4; ++m) _Pragma("unroll") for (int n = 0; n < 2; ++n) _Pragma("unroll") for (int k = 0; k < 2; ++k) \
        acc[ai][bj][m][n] = __builtin_amdgcn_mfma_f32_16x16x32_bf16(Bt[n][k], At[m][k], acc[ai][bj][m][n], 0, 0, 0); __builtin_amdgcn_s_setprio(0); } while (0)
#define PG8_WAIT_V(n) asm volatile("s_waitcnt vmcnt(" #n ")" ::: "memory")
#define PG8_WAIT_L(n) asm volatile("s_waitcnt lgkmcnt(" #n ")" ::: "memory")
#define PG8_BAR __builtin_amdgcn_s_barrier()
#define PG8_SCHED __builtin_amdgcn_sched_barrier(0)
    Unit cur, nxt; int ui = 0;
    if (!S.next(0, cur)) return;
    f32x4 acc[2][2][4][2];
#pragma unroll
    for (int a = 0; a < 2; ++a)
#pragma unroll
        for (int b = 0; b < 2; ++b)
#pragma unroll
            for (int m = 0; m < 4; ++m)
#pragma unroll
                for (int n = 0; n < 2; ++n) acc[a][b][m][n] = (f32x4){0.f, 0.f, 0.f, 0.f};
    bf16x8 At[4][2], B0[2][2], B1[2][2];
    const char* cA = (const char*)g.A + g.a_off(cur.pm); const char* cB = (const char*)g.Bt + (size_t)cur.pn * tstep;
    S.a_ready(cur);
    if constexpr (SP2) {
        PG8_STAGE(PG8_SB(0, 0), cB, voffB); PG8_STAGE(PG8_SB(0, 1), cB + hstep, voffB); PG8_STAGE(PG8_SA(0, 0), cA, voffA); PG8_STAGE(PG8_SA(0, 1), cA + hstep, voffA);
        if (wr == 1) PG8_BAR;
        PG8_WAIT_V(2); PG8_BAR;
        PG8_STAGE(PG8_SB(1, 0), cB + kstep, voffB); PG8_STAGE(PG8_SA(1, 0), cA + kstep, voffA); PG8_STAGE(PG8_SB(1, 1), cB + hstep + kstep, voffB);
        PG8_WAIT_V(6); PG8_BAR;
    } else {
        PG8_STAGE(PG8_SB(0, 0), cB, voffB); PG8_STAGE(PG8_SA(0, 0), cA, voffA); PG8_STAGE(PG8_SB(0, 1), cB + hstep, voffB); PG8_STAGE(PG8_SA(0, 1), cA + hstep, voffA);
        if (wr == 1) PG8_BAR;
        PG8_WAIT_V(4); PG8_BAR;
        PG8_STAGE(PG8_SB(1, 0), cB + kstep, voffB); PG8_STAGE(PG8_SA(1, 0), cA + kstep, voffA); PG8_STAGE(PG8_SB(1, 1), cB + hstep + kstep, voffB);
        PG8_WAIT_V(6); PG8_BAR;
    }
    for (;;) {
        const bool has_next = S.next(ui + 1, nxt);
        const char* nA = has_next ? (const char*)g.A + g.a_off(nxt.pm) : cA; const char* nB = has_next ? (const char*)g.Bt + (size_t)nxt.pn * tstep : cB;
        for (int t = 0; t < nt; t += 2) {
            const bool last = (t == nt - 2);
            const char* a1 = cA + (size_t)(t + 1) * kstep;
            const char* a2 = last ? nA : cA + (size_t)(t + 2) * kstep; const char* b2 = last ? nB : cB + (size_t)(t + 2) * kstep;
            const char* a3 = a2 + kstep; const char* b3 = b2 + kstep;
            if (last && has_next) S.a_ready(nxt);
            if constexpr (SP2) {
            PG8_LDB(B0, 0, 0); PG8_LDB(B1, 0, 1); PG8_SCHED; PG8_LDA(At, 0, 0); PG8_STAGE(PG8_SA(1, 1), a1 + hstep, voffA);
            PG8_WAIT_V(8); PG8_WAIT_L(0); PG8_BAR; PG8_MMA(0, 0, At, B0); PG8_MMA(0, 1, At, B1); PG8_BAR; PG8_SCHED;
            PG8_LDA(At, 0, 1); PG8_STAGE(PG8_SB(0, 0), b2, voffB); PG8_STAGE(PG8_SB(0, 1), b2 + hstep, voffB); PG8_STAGE(PG8_SA(0, 0), a2, voffA);
            PG8_WAIT_V(8); PG8_WAIT_L(0); PG8_BAR; PG8_MMA(1, 0, At, B0); PG8_MMA(1, 1, At, B1); PG8_BAR; PG8_SCHED;
            PG8_LDB(B0, 1, 0); PG8_LDB(B1, 1, 1); PG8_SCHED; PG8_LDA(At, 1, 0); PG8_STAGE(PG8_SA(0, 1), a2 + hstep, voffA);
            PG8_WAIT_V(8); PG8_WAIT_L(0); PG8_BAR; PG8_MMA(0, 0, At, B0); PG8_MMA(0, 1, At, B1); PG8_BAR; PG8_SCHED;
            PG8_LDA(At, 1, 1); PG8_STAGE(PG8_SB(1, 0), b3, voffB); PG8_STAGE(PG8_SB(1, 1), b3 + hstep, voffB); PG8_STAGE(PG8_SA(1, 0), a3, voffA);
            PG8_WAIT_V(8); PG8_WAIT_L(0); PG8_BAR; PG8_MMA(1, 0, At, B0); PG8_MMA(1, 1, At, B1); PG8_BAR; PG8_SCHED;
            } else {
            PG8_LDB(B0, 0, 0); PG8_SCHED; PG8_LDA(At, 0, 0); PG8_STAGE(PG8_SA(1, 1), a1 + hstep, voffA);
            PG8_WAIT_L(8); PG8_BAR; PG8_WAIT_L(0); PG8_MMA(0, 0, At, B0); PG8_BAR; PG8_SCHED;
            PG8_LDB(B1, 0, 1); PG8_STAGE(PG8_SB(0, 0), b2, voffB);
            PG8_BAR; PG8_WAIT_L(0); PG8_MMA(0, 1, At, B1); PG8_BAR;
            PG8_LDA(At, 0, 1); PG8_STAGE(PG8_SA(0, 0), a2, voffA);
            PG8_BAR; PG8_WAIT_L(0); PG8_MMA(1, 0, At, B0); PG8_BAR; PG8_SCHED;
            PG8_STAGE(PG8_SB(0, 1), b2 + hstep, voffB);
            PG8_WAIT_V(6); PG8_BAR; PG8_MMA(1, 1, At, B1); PG8_BAR;
            PG8_LDB(B0, 1, 0); PG8_SCHED; PG8_LDA(At, 1, 0); PG8_STAGE(PG8_SA(0, 1), a2 + hstep, voffA);
            PG8_WAIT_L(8); PG8_BAR; PG8_WAIT_L(0); PG8_MMA(0, 0, At, B0); PG8_BAR; PG8_SCHED;
            PG8_LDB(B1, 1, 1); PG8_STAGE(PG8_SB(1, 0), b3, voffB);
            PG8_BAR; PG8_WAIT_L(0); PG8_MMA(0, 1, At, B1); PG8_BAR;
            PG8_LDA(At, 1, 1); PG8_STAGE(PG8_SA(1, 0), a3, voffA);
            PG8_BAR; PG8_WAIT_L(0); PG8_MMA(1, 0, At, B0); PG8_BAR; PG8_SCHED;
            PG8_STAGE(PG8_SB(1, 1), b3 + hstep, voffB);
            PG8_WAIT_V(6); PG8_BAR; PG8_MMA(1, 1, At, B1); PG8_BAR;
            }
        }
        if constexpr (ALIGN_EPI) { if (wr == 0) PG8_BAR; }
        if constexpr (!Epi::AFTER_DRAIN) { E(acc, cur, wr, wc, fr, fq, lds + STAGE_BYTES); S.done(cur); }
        if (!has_next) break;
#pragma unroll
        for (int a = 0; a < 2; ++a)
#pragma unroll
            for (int b = 0; b < 2; ++b)
#pragma unroll
                for (int m = 0; m < 4; ++m)
#pragma unroll
                    for (int n = 0; n < 2; ++n) acc[a][b][m][n] = (f32x4){0.f, 0.f, 0.f, 0.f};
        cur = nxt; cA = nA; cB = nB; ++ui;
        if constexpr (ALIGN_EPI) { if (wr == 1) PG8_BAR; }
    }
    PG8_WAIT_V(0);
    if constexpr (!ALIGN_EPI) { if (wr == 0) PG8_BAR; }
    PG8_BAR;

#undef PG8_SA
#undef PG8_SB
#undef PG8_STAGE
#undef PG8_LDA
#undef PG8_LDB
#undef PG8_MMA
#undef PG8_WAIT_V
#undef PG8_WAIT_L
#undef PG8_BAR
#undef PG8_SCHED
}
}

#define LAS __attribute__((address_space(3)))
typedef unsigned short bf16;
typedef unsigned v4u __attribute__((ext_vector_type(4)));
typedef unsigned v2u __attribute__((ext_vector_type(2)));
typedef float f32x4 __attribute__((ext_vector_type(4)));
constexpr int NWAVES = 8, NTHR = 512;
constexpr int RING_BYTES = 131072, XCH_BYTES = 16384, LDS_BYTES = RING_BYTES + XCH_BYTES + 1024;

constexpr size_t MiB = 1u << 20;
constexpr size_t SZ_WIN = (size_t)NIN * DM * 2, SZ_WOUT = (size_t)DM * DI * 2, SZ_WKVQ = (size_t)3072 * DM * 2, SZ_WO = (size_t)DM * DM * 2, SZ_WUP = (size_t)NUP * DM * 2, SZ_WDN = (size_t)DM * DFF * 2;
constexpr size_t WS_WIN = 1 * MiB, WS_WOUT = WS_WIN + SZ_WIN, WS_WKVQ = WS_WOUT + SZ_WOUT, WS_WO = WS_WKVQ + SZ_WKVQ, WS_WUP0 = WS_WO + SZ_WO, WS_WUP1 = WS_WUP0 + SZ_WUP, WS_WDN0 = WS_WUP1 + SZ_WUP, WS_WDN1 = WS_WDN0 + SZ_WDN, WS_WEND = WS_WDN1 + SZ_WDN;
constexpr size_t WS_DT = 57 * MiB;
constexpr size_t WS_XBC = 60 * MiB;
constexpr size_t WS_H = WS_XBC;
constexpr size_t WS_Z = 158 * MiB;
constexpr size_t WS_ST = 223 * MiB;
constexpr size_t WS_ACT = 126 * MiB;
constexpr size_t WS_K = 126 * MiB, WS_V = 159 * MiB, WS_Q = 192 * MiB;
constexpr size_t WS_END = 256 * MiB;
static_assert(WS_WEND <= WS_DT && WS_DT + (size_t)MR * 32 * 4 <= WS_XBC && WS_XBC + (size_t)MR * CONVD * 2 <= WS_Z && WS_Z + (size_t)MR * DI * 2 <= WS_ST, "ws map 1");
static_assert(WS_H + (size_t)MR * DM * 4 <= WS_ACT && WS_ACT + (size_t)MR * DFF * 2 <= WS_END && WS_K + (size_t)MR * DM * 2 <= WS_V && WS_V + (size_t)MR * DM * 2 <= WS_Q && WS_Q + (size_t)MR * DM * 2 <= WS_END, "ws map 2");

__device__ __forceinline__ unsigned f2bf(float f) { unsigned u = __builtin_bit_cast(unsigned, f); return (u + 0x7fffu + ((u >> 16) & 1u)) >> 16; }
__device__ __forceinline__ unsigned pk2(float lo, float hi) { return f2bf(lo) | (f2bf(hi) << 16); }
__device__ __forceinline__ float wave_sum(float v) {
#pragma unroll
    for (int o = 1; o < 64; o <<= 1) v += __shfl_xor(v, o);
    return v;
}
__device__ __forceinline__ float bf_lo(unsigned u) { return __uint_as_float(u << 16); }
__device__ __forceinline__ float bf_hi(unsigned u) { return __uint_as_float(u & 0xffff0000u); }

__device__ __forceinline__ void transpose_item(const float* W, int pitch, int K, bf16* WT, int nrow0, int srccol0, int k0, const float* gain, LAS float* scr, int lane) {
#pragma unroll 8
    for (int i = 0; i < 32; ++i) { const int kk = 2 * i + (lane >> 5); float v = 0.f;
        if (srccol0 >= 0) { v = W[(size_t)(k0 + kk) * pitch + srccol0 + (lane & 31)]; if (gain) v *= gain[k0 + kk]; }
        scr[kk * 33 + (lane & 31)] = v; }
    asm volatile("s_waitcnt lgkmcnt(0)" ::: "memory");
    const int c = lane & 7;
#pragma unroll
    for (int j = 0; j < 4; ++j) { const int n = (lane >> 3) + 8 * j; const LAS float* s = scr + (8 * c) * 33 + n;
        v4u o; o.x = pk2(s[0 * 33], s[1 * 33]); o.y = pk2(s[2 * 33], s[3 * 33]); o.z = pk2(s[4 * 33], s[5 * 33]); o.w = pk2(s[6 * 33], s[7 * 33]);
        *(v4u*)(WT + (size_t)(nrow0 + n) * K + k0 + 8 * c) = o; }
    asm volatile("s_waitcnt lgkmcnt(0)" ::: "memory");
}

constexpr int SB_LB = 0, SB_LC = 17408, SB_LX = 34816, SB_LXW = 44032, SB_LST = 53248, SB_LDT = 70656, SB_LACS = 70912;
typedef short bf16x8_t __attribute__((ext_vector_type(8)));
typedef short s16x4_t __attribute__((ext_vector_type(4)));
__device__ __forceinline__ s16x4_t lds_tr16(LAS unsigned char* p) { return __builtin_bit_cast(s16x4_t, __builtin_amdgcn_ds_read_tr16_b64_v4i16((LAS s16x4_t*)p)); }
__device__ __forceinline__ bf16x8_t cat8(s16x4_t a, s16x4_t b) { return (bf16x8_t){a[0], a[1], a[2], a[3], b[0], b[1], b[2], b[3]}; }

template <int PASS> __device__ __forceinline__ void ssd_unit(LAS unsigned char* lds, int b, int c, int h, const bf16* xbc_c, bf16* xbc_w, const float* dtp, bf16* ST, float* DEC, float a, float dsk, int tid) {
    const int lane = tid & 63, wave = __builtin_amdgcn_readfirstlane(tid >> 6), fr = lane & 15, fq = lane >> 4, q2 = fr >> 2, p2 = lane & 3, g = h >> 3;
    const int lbase = 256 * c, nvalid = (LTOK - lbase) < 256 ? (LTOK - lbase) : 256, nsub = (nvalid + 63) >> 6;
    const size_t rowb = (size_t)b * BS + OFF;
    f32x4 ast[4];
#pragma unroll
    for (int pb = 0; pb < 4; ++pb) ast[pb] = (f32x4){0.f, 0.f, 0.f, 0.f};
    if (PASS == 2 && c > 0) {
        const bf16* sp = ST + ((size_t)((b * 32 + (c - 1)) * NHS + h)) * 8192;
#pragma unroll
        for (int pb = 0; pb < 4; ++pb) { const v2u w = *(const v2u*)(sp + (16 * pb + fr) * 128 + 16 * wave + 4 * fq); ast[pb] = (f32x4){bf_lo(w.x), bf_hi(w.x), bf_lo(w.y), bf_hi(w.y)}; }
    }
    float totlog = 0.f;
    v4u gB[2], gC[2], gX; float gdt;
    auto prefetch = [&](int j) {
        const int l0 = lbase + 64 * j;
#pragma unroll
        for (int k = 0; k < 2; ++k) { const int idx = tid + 512 * k, row = idx >> 4, ch = idx & 15; int l = l0 + row; l = l < LTOK ? l : LTOK - 1;
            const bf16* rp = xbc_c + (rowb + l) * CONVD + DI + g * 128 + ch * 8; gB[k] = *(const v4u*)rp; if (PASS == 2) gC[k] = *(const v4u*)(rp + 512); }
        { const int row = tid >> 3, ch = tid & 7; int l = l0 + row; l = l < LTOK ? l : LTOK - 1; gX = *(const v4u*)(xbc_c + (rowb + l) * CONVD + h * 64 + ch * 8); }
        { const int l = l0 + lane; gdt = l < LTOK ? dtp[(rowb + l) * NHS + h] : 0.f; }
    };
    prefetch(0);
    for (int j = 0; j < nsub; ++j) {
        float acs = gdt * a;
#pragma unroll
        for (int o = 1; o < 64; o <<= 1) { const float t = __shfl_up(acs, o); if (lane >= o) acs += t; }
        const float aend = __shfl(acs, 63);
        const float wrow = gdt * __expf(aend - acs);
        if (wave == 0) { ((LAS float*)(lds + SB_LDT))[lane] = gdt; ((LAS float*)(lds + SB_LACS))[lane] = acs; }
#pragma unroll
        for (int k = 0; k < 2; ++k) { const int idx = tid + 512 * k, row = idx >> 4, ch = idx & 15; *(LAS v4u*)(lds + SB_LB + row * 272 + ch * 16) = gB[k]; if (PASS == 2) *(LAS v4u*)(lds + SB_LC + row * 272 + ch * 16) = gC[k]; }
        { const int row = tid >> 3, ch = tid & 7; const float wv = __shfl(wrow, row & 63);
          if (PASS == 2) *(LAS v4u*)(lds + SB_LX + row * 144 + ch * 16) = gX;
          v4u xw;
#pragma unroll
          for (int e = 0; e < 4; ++e) xw[e] = pk2(bf_lo(gX[e]) * wv, bf_hi(gX[e]) * wv);
          *(LAS v4u*)(lds + SB_LXW + row * 144 + ch * 16) = xw; }
        if (PASS == 2) {
#pragma unroll
            for (int pb = 0; pb < 4; ++pb) *(LAS v2u*)(lds + SB_LST + (16 * pb + fr) * 272 + (16 * wave + 4 * fq) * 2) = (v2u){pk2(ast[pb][0], ast[pb][1]), pk2(ast[pb][2], ast[pb][3])};
        }
        __syncthreads();
        if (j + 1 < nsub) prefetch(j + 1);
        totlog += aend;
        if (PASS == 2) {
            const int ib = wave >> 1;
            bf16x8_t cf[4];
#pragma unroll
            for (int ks = 0; ks < 4; ++ks) cf[ks] = *(const LAS bf16x8_t*)(lds + SB_LC + (16 * ib + fr) * 272 + (32 * ks + 8 * fq) * 2);
            const float acs_i = ((const LAS float*)(lds + SB_LACS))[16 * ib + fr];
            const int irow = 16 * ib + fr;
            bf16x8_t pf[2];
#pragma unroll
            for (int kk = 0; kk < 2; ++kk) {
                unsigned pw[4];
#pragma unroll
                for (int hf = 0; hf < 2; ++hf) { const int sb = 2 * kk + hf;
                    if (sb <= ib) {
                        f32x4 d = (f32x4){0.f, 0.f, 0.f, 0.f};
#pragma unroll
                        for (int ks = 0; ks < 4; ++ks) { const bf16x8_t af = *(const LAS bf16x8_t*)(lds + SB_LB + (16 * sb + fr) * 272 + (32 * ks + 8 * fq) * 2); d = __builtin_amdgcn_mfma_f32_16x16x32_bf16(af, cf[ks], d, 0, 0, 0); }
                        const f32x4 as4 = *(const LAS f32x4*)(lds + SB_LACS + (16 * sb + 4 * fq) * 4), dt4 = *(const LAS f32x4*)(lds + SB_LDT + (16 * sb + 4 * fq) * 4);
                        float v[4];
#pragma unroll
                        for (int r = 0; r < 4; ++r) { const int s = 16 * sb + 4 * fq + r; const float e = __expf(fminf(acs_i - as4[r], 0.f)); v[r] = s <= irow ? d[r] * dt4[r] * e : 0.f; }
                        pw[2 * hf] = pk2(v[0], v[1]); pw[2 * hf + 1] = pk2(v[2], v[3]);
                    } else { pw[2 * hf] = 0u; pw[2 * hf + 1] = 0u; }
                }
                pf[kk] = __builtin_bit_cast(bf16x8_t, (v4u){pw[0], pw[1], pw[2], pw[3]});
            }
            const float ei = __expf(acs_i);
            const int l_row = lbase + 64 * j + irow;
#pragma unroll
            for (int pbi = 0; pbi < 2; ++pbi) { const int pb = 2 * (wave & 1) + pbi;
                f32x4 acc = (f32x4){0.f, 0.f, 0.f, 0.f};
#pragma unroll
                for (int ks = 0; ks < 4; ++ks) { const bf16x8_t af = *(const LAS bf16x8_t*)(lds + SB_LST + (16 * pb + fr) * 272 + (32 * ks + 8 * fq) * 2); acc = __builtin_amdgcn_mfma_f32_16x16x32_bf16(af, cf[ks], acc, 0, 0, 0); }
                acc = acc * ei;
#pragma unroll
                for (int kk = 0; kk < 2; ++kk) if (2 * kk <= ib) {
                    LAS unsigned char* xp = lds + SB_LX + (32 * kk + 4 * fq + q2) * 144 + 32 * pb + 8 * p2;
                    const bf16x8_t xa = cat8(lds_tr16(xp), lds_tr16(xp + 16 * 144));
                    acc = __builtin_amdgcn_mfma_f32_16x16x32_bf16(xa, pf[kk], acc, 0, 0, 0); }
                const v2u xw = *(const LAS v2u*)(lds + SB_LX + irow * 144 + (16 * pb + 4 * fq) * 2);
                const float y0 = acc[0] + dsk * bf_lo(xw.x), y1 = acc[1] + dsk * bf_hi(xw.x), y2 = acc[2] + dsk * bf_lo(xw.y), y3 = acc[3] + dsk * bf_hi(xw.y);
                if (l_row < LTOK) *(v2u*)(xbc_w + (rowb + l_row) * CONVD + h * 64 + 16 * pb + 4 * fq) = (v2u){pk2(y0, y1), pk2(y2, y3)};
            }
        }
        { const float ed = __expf(aend);
#pragma unroll
          for (int pb = 0; pb < 4; ++pb) ast[pb] = ast[pb] * ed;
#pragma unroll
          for (int kk = 0; kk < 2; ++kk) {
              LAS unsigned char* bp = lds + SB_LB + (32 * kk + 8 * fq + q2) * 272 + 32 * wave + 8 * p2;
              const bf16x8_t af = cat8(lds_tr16(bp), lds_tr16(bp + 4 * 272));
#pragma unroll
              for (int pb = 0; pb < 4; ++pb) { LAS unsigned char* xp = lds + SB_LXW + (32 * kk + 8 * fq + q2) * 144 + 32 * pb + 8 * p2;
                  const bf16x8_t bfg = cat8(lds_tr16(xp), lds_tr16(xp + 4 * 144));
                  ast[pb] = __builtin_amdgcn_mfma_f32_16x16x32_bf16(af, bfg, ast[pb], 0, 0, 0); } } }
        __syncthreads();
    }
    if (PASS == 1) {
        bf16* sp = ST + ((size_t)((b * 32 + c) * NHS + h)) * 8192;
#pragma unroll
        for (int pb = 0; pb < 4; ++pb) *(v2u*)(sp + (16 * pb + fr) * 128 + 16 * wave + 4 * fq) = (v2u){pk2(ast[pb][0], ast[pb][1]), pk2(ast[pb][2], ast[pb][3])};
        if (tid == 0) DEC[(b * 32 + c) * NHS + h] = __expf(totlog);
    }
}

struct Args {
    const float* in[22]; float* outp; unsigned char* wsp; int ph_lo, ph_hi, coop, pad;
};

__device__ __forceinline__ void norm_row(const float* src, bf16* dst, int lane) {
    v2u* o8 = (v2u*)dst + lane;
    if (!src) {
#pragma unroll
        for (int j = 0; j < 4; ++j) o8[64 * j] = (v2u){0u, 0u};
        return; }
    const f32x4* xr = (const f32x4*)src + lane;
    f32x4 v[4]; float s = 0.f;
#pragma unroll
    for (int j = 0; j < 4; ++j) { v[j] = xr[64 * j]; s += (v[j].x * v[j].x + v[j].y * v[j].y) + (v[j].z * v[j].z + v[j].w * v[j].w); }
    const float rstd = 1.0f / sqrtf(wave_sum(s) * (1.f / DM) + EPS);
#pragma unroll
    for (int j = 0; j < 4; ++j) o8[64 * j] = (v2u){pk2(v[j].x * rstd, v[j].y * rstd), pk2(v[j].z * rstd, v[j].w * rstd)};
}
__device__ __forceinline__ const float* stream_row(int r, int mode, const float* H, const float* x, const float* meta) {
    if (r >= 2 * BS) return nullptr;
    const int b = r >= BS ? 1 : 0, l = r - b * BS - OFF;
    if (l < 0 || l >= LTOK) return nullptr;
    if (mode == 0) return H + (size_t)r * DM;
    return l < NMETA ? meta + (size_t)l * DM : x + ((size_t)b * SEQ + (l - NMETA)) * DM;
}

__device__ __forceinline__ const void* ptab(volatile LAS unsigned* PT, int k) {
    const unsigned lo_ = PT[2 * k], hi_ = PT[2 * k + 1];
    return (const void*)(const __attribute__((address_space(1))) void*)(((unsigned long long)(unsigned)__builtin_amdgcn_readfirstlane((int)hi_) << 32) | (unsigned long long)(unsigned)__builtin_amdgcn_readfirstlane((int)lo_));
}
#define xin ((const float*)ptab(PT, 0))
#define metain ((const float*)ptab(PT, 1))
#define ssd_norm ((const float*)ptab(PT, 2))
#define ssd_w_in ((const float*)ptab(PT, 3))
#define ssd_conv_w ((const float*)ptab(PT, 4))
#define ssd_conv_b ((const float*)ptab(PT, 5))
#define ssd_dt_bias ((const float*)ptab(PT, 6))
#define ssd_a_log ((const float*)ptab(PT, 7))
#define ssd_d_skip ((const float*)ptab(PT, 8))
#define ssd_gate_norm ((const float*)ptab(PT, 9))
#define ssd_w_out ((const float*)ptab(PT, 10))
#define kv_norm ((const float*)ptab(PT, 11))
#define w_kv ((const float*)ptab(PT, 12))
#define sb_norm ((const float*)ptab(PT, 13))
#define sb_w_q ((const float*)ptab(PT, 14))
#define sb_w_o ((const float*)ptab(PT, 15))
#define ffn_norm ((const float*)ptab(PT, 16))
#define ffn_w_up ((const float*)ptab(PT, 17))
#define ffn_conv_w ((const float*)ptab(PT, 18))
#define ffn_conv_b ((const float*)ptab(PT, 19))
#define ffn_w_down ((const float*)ptab(PT, 20))
#define final_norm ((const float*)ptab(PT, 21))
#define ws ((unsigned char*)ptab(PT, 22))
#define Win ((bf16*)(ws + WS_WIN))
#define Wout ((bf16*)(ws + WS_WOUT))
#define Wkvq ((bf16*)(ws + WS_WKVQ))
#define Wo ((bf16*)(ws + WS_WO))
#define Wup0 ((bf16*)(ws + WS_WUP0))
#define Wup1 ((bf16*)(ws + WS_WUP1))
#define Wdn0 ((bf16*)(ws + WS_WDN0))
#define Wdn1 ((bf16*)(ws + WS_WDN1))
#define DT ((float*)(ws + WS_DT))
#define XBC ((bf16*)(ws + WS_XBC))
#define H ((float*)(ws + WS_H))
#define Z ((bf16*)(ws + WS_Z))
#define ACT ((bf16*)(ws + WS_ACT))
#define KB ((bf16*)(ws + WS_K))
#define VB ((bf16*)(ws + WS_V))
#define QB ((bf16*)(ws + WS_Q))
#define XN ((bf16*)ptab(PT, 23))
#define OUTP ((float*)ptab(PT, 23))
__global__ void __launch_bounds__(NTHR, 2) mega(const Args args) {
    extern __shared__ __attribute__((aligned(16))) unsigned char lds_raw[];
    LAS unsigned char* lds = (LAS unsigned char*)lds_raw;
    const int tid = threadIdx.x, lane = tid & 63, wave = __builtin_amdgcn_readfirstlane(tid >> 6);
    const int G = gridDim.x, bx = blockIdx.x;
    const int gw = bx * NWAVES + wave, NGW = G * NWAVES;
    volatile LAS unsigned* PT = (volatile LAS unsigned*)(lds + RING_BYTES + XCH_BYTES);
    if (tid < 24) { const unsigned long long pv = tid < 22 ? (unsigned long long)args.in[tid] : (tid == 22 ? (unsigned long long)args.wsp : (unsigned long long)args.outp); PT[2 * tid] = (unsigned)pv; PT[2 * tid + 1] = (unsigned)(pv >> 32); }
    __syncthreads();
    const int lo = args.ph_lo, hi = args.ph_hi;
#define IN(k) (lo <= (k) && (k) < hi)
#define SEAM(k) do { if (args.coop && IN(k) && IN((k) + 1)) { cg::this_grid().sync(); } } while (0)

    if (IN(0)) {
        LAS float* scr = (LAS float*)(lds + wave * 16384);
        constexpr int I_IN = 16 * (NIN / 32), I_OUT = 32 * 32, I_KVQ = 16 * 96, I_O = 16 * 32, I_UP = 16 * (NUP / 32), I_DN = 44 * 32;
        constexpr int NITEMS = I_IN + I_OUT + I_KVQ + I_O + 2 * I_UP + 2 * I_DN;
        for (int it = gw; it < NITEMS; it += NGW) {
            int r = it;
            if (r < I_IN) { const int nb = r % (NIN / 32), kb = r / (NIN / 32), n0 = nb * 32; transpose_item(ssd_w_in, NIN_REAL, DM, Win, n0, n0 < NIN_REAL ? n0 : -1, kb * 64, ssd_norm, scr, lane); continue; } r -= I_IN;
            if (r < I_OUT) { const int nb = r % 32, kb = r / 32; transpose_item(ssd_w_out, DM, DI, Wout, nb * 32, nb * 32, kb * 64, ssd_gate_norm, scr, lane); continue; } r -= I_OUT;
            if (r < I_KVQ) { const int nb = r % 96, kb = r / 96, n0 = nb * 32;
                if (n0 < 2048) transpose_item(w_kv, 2048, DM, Wkvq, n0, n0, kb * 64, kv_norm, scr, lane); else transpose_item(sb_w_q, DM, DM, Wkvq, n0, n0 - 2048, kb * 64, sb_norm, scr, lane);
                continue; } r -= I_KVQ;
            if (r < I_O) { const int nb = r % 32, kb = r / 32; transpose_item(sb_w_o, DM, DM, Wo, nb * 32, nb * 32, kb * 64, nullptr, scr, lane); continue; } r -= I_O;
            if (r < 2 * I_UP) { const int ly = r / I_UP; r -= ly * I_UP; const int nb = r % (NUP / 32), kb = r / (NUP / 32), n0 = nb * 32;
                const int src = ((n0 >> 7) & 1) * DFF + (n0 >> 8) * 128 + (n0 & 127);
                transpose_item(ffn_w_up + (size_t)ly * DM * NUP, NUP, DM, ly ? Wup1 : Wup0, n0, src, kb * 64, ffn_norm + ly * DM, scr, lane); continue; } r -= 2 * I_UP;
            { const int ly = r / I_DN; r -= ly * I_DN; const int nb = r % 32, kb = r / 32;
              transpose_item(ffn_w_down + (size_t)ly * DFF * DM, DM, DFF, ly ? Wdn1 : Wdn0, nb * 32, nb * 32, kb * 64, nullptr, scr, lane); }
        }
        for (int r = gw; r < MRX; r += NGW) norm_row(stream_row(r, 1, H, xin, metain), XN + (size_t)r * DM, lane);
    }
    SEAM(0);
    if (IN(1)) {
        pg8::Gemm g{XN, Win, 2 * TPB * 256, NIN, DM, 3}; pg8::StaticOrder S; S.init(2 * TPB * 256, NIN, G, bx);
        pg8::EpiInProj E{Z, XBC, DT, ssd_conv_w, ssd_conv_b, ssd_dt_bias};
        pg8::gemm_phase<pg8::EpiInProj, pg8::StaticOrder, true, true>(lds, g, S, E);
    }
    SEAM(1);
    if (IN(2)) {
        bf16* xbc = XBC; const float* dtp = DT; bf16* ST = (bf16*)(ws + WS_ST); float* DEC = (float*)(ws + 4096);
        for (int u = bx; u < NBATCH * 32 * NHS; u += G) { const int h = u % NHS, c = (u / NHS) % 32, b = u / (NHS * 32);
            ssd_unit<1>(lds, b, c, h, xbc, xbc, dtp, ST, DEC, -__expf(ssd_a_log[h]), 0.f, tid); }
        if (args.coop) cg::this_grid().sync();
        { const int gt = bx * NTHR + tid;
          if (gt < NBATCH * NHS * 1024) { const int bh = gt >> 10, e = gt & 1023, b = bh / NHS, h = bh % NHS; float run[8];
#pragma unroll
              for (int k = 0; k < 8; ++k) run[k] = 0.f;
              for (int c = 0; c < 32; ++c) { v4u* sp = (v4u*)(ST + ((size_t)((b * 32 + c) * NHS + h)) * 8192 + e * 8); const v4u w = *sp; const float d = DEC[(b * 32 + c) * NHS + h];
#pragma unroll
                  for (int k = 0; k < 4; ++k) { run[2 * k] = run[2 * k] * d + bf_lo(w[k]); run[2 * k + 1] = run[2 * k + 1] * d + bf_hi(w[k]); }
                  *sp = (v4u){pk2(run[0], run[1]), pk2(run[2], run[3]), pk2(run[4], run[5]), pk2(run[6], run[7])}; } } }
        if (args.coop) cg::this_grid().sync();
        for (int u = bx; u < NBATCH * 33 * NHS; u += G) { const int h = u % NHS, c = (u / NHS) % 33, b = u / (NHS * 33);
            ssd_unit<2>(lds, b, c, h, xbc, xbc, dtp, ST, DEC, -__expf(ssd_a_log[h]), ssd_d_skip[h], tid); }
    }
    SEAM(2);
    if (IN(3)) {
        for (int r = gw; r < 2 * BS; r += NGW) {
            const int b = r >= BS ? 1 : 0, l = r - b * BS - OFF; if (l < 0 || l >= LTOK) continue;
#pragma unroll
            for (int g = 0; g < 4; ++g) {
                const v4u yq = *(const v4u*)(XBC + (size_t)r * CONVD + g * 512 + lane * 8); v4u* zp = (v4u*)(Z + (size_t)r * DI + g * 512 + lane * 8); const v4u zq = *zp;
                float hv[8]; float ss = 0.f;
#pragma unroll
                for (int e = 0; e < 4; ++e) { const float y0 = bf_lo(yq[e]), y1 = bf_hi(yq[e]), z0 = bf_lo(zq[e]), z1 = bf_hi(zq[e]);
                    hv[2 * e] = y0 * pg8::silu_f(z0); hv[2 * e + 1] = y1 * pg8::silu_f(z1); ss += hv[2 * e] * hv[2 * e] + hv[2 * e + 1] * hv[2 * e + 1]; }
                const float rs = 1.0f / sqrtf(wave_sum(ss) * (1.f / 512.f) + EPS);
                *zp = (v4u){pk2(hv[0] * rs, hv[1] * rs), pk2(hv[2] * rs, hv[3] * rs), pk2(hv[4] * rs, hv[5] * rs), pk2(hv[6] * rs, hv[7] * rs)};
            }
        }
    }
    SEAM(3);
    if (IN(4)) {
        pg8::Gemm g{Z, Wout, MR, DM, DI, 0}; pg8::StaticOrder S; S.init(MR, DM, G, bx);
        pg8::EpiResid<1> E{H, xin, metain};
        pg8::gemm_phase<pg8::EpiResid<1>, pg8::StaticOrder, true, true>(lds, g, S, E);
    }
    SEAM(4);
#pragma unroll 1
    for (int ly = 0; ly < 2; ++ly) {
        const int pb = ly == 0 ? 5 : 12;
        if (ly == 1) {
            if (IN(8)) { for (int r = gw; r < MRX; r += NGW) norm_row(stream_row(r, 0, H, xin, metain), XN + (size_t)r * DM, lane); }
            SEAM(8);
            if (IN(9)) {
                pg8::Gemm g{XN, Wkvq, MR, 3072, DM, 0}; pg8::StaticOrder S; S.init(MR, 3072, G, bx);
                pg8::EpiBf16 E{KB, DM, DM, (size_t)(WS_V - WS_K) / 2};
                pg8::gemm_phase<pg8::EpiBf16, pg8::StaticOrder, true, true>(lds, g, S, E);
            }
            SEAM(9);
            if (IN(10)) {
                constexpr int NTB = (LTOK + 63) / 64;
                for (int task = gw; task < NBATCH * 16 * NTB; task += NGW) {
                    const int tb = task % NTB, bh = task / NTB, b = bh >> 4, h = bh & 15;
                    const int t = tb * 64 + lane; const bool tv = t < LTOK;
                    const size_t rq = (size_t)(b * BS + OFF + (tv ? t : 0));
                    float q[64], o[64];
                    { const v4u* qp = (const v4u*)(QB + rq * DM + h * 64);
#pragma unroll
                      for (int c = 0; c < 8; ++c) { const v4u w = qp[c];
#pragma unroll
                          for (int e = 0; e < 4; ++e) { q[c * 8 + 2 * e] = bf_lo(w[e]) * 0.125f; q[c * 8 + 2 * e + 1] = bf_hi(w[e]) * 0.125f; } } }
#pragma unroll
                    for (int d = 0; d < 64; ++d) o[d] = 0.f;
                    float later = 0.f;
                    for (int j = 1; ; ++j) {
                        const int s = t - j; const bool act = tv && s >= 0 && later > -110.f;
                        if (!__any(act)) break;
                        if (act) {
                            const size_t rk = (size_t)(b * BS + OFF + s);
                            const v4u* kp = (const v4u*)(KB + rk * DM + h * 64); const v4u* vp = (const v4u*)(VB + rk * DM + h * 64);
                            float lg = 0.f;
#pragma unroll
                            for (int c = 0; c < 8; ++c) { const v4u w = kp[c];
#pragma unroll
                                for (int e = 0; e < 4; ++e) { lg += q[c * 8 + 2 * e] * bf_lo(w[e]); lg += q[c * 8 + 2 * e + 1] * bf_hi(w[e]); } }
                            const float lsp = fminf(lg, 0.f) - log1pf(__expf(-fabsf(lg)));
                            const float wgt = __expf(lsp + later);
                            later += lsp - lg;
#pragma unroll
                            for (int c = 0; c < 8; ++c) { const v4u w = vp[c];
#pragma unroll
                                for (int e = 0; e < 4; ++e) { o[c * 8 + 2 * e] += wgt * bf_lo(w[e]); o[c * 8 + 2 * e + 1] += wgt * bf_hi(w[e]); } }
                        }
                    }
                    if (tv) { v4u* op = (v4u*)(QB + rq * DM + h * 64);
#pragma unroll
                        for (int c = 0; c < 8; ++c) op[c] = (v4u){pk2(o[c * 8], o[c * 8 + 1]), pk2(o[c * 8 + 2], o[c * 8 + 3]), pk2(o[c * 8 + 4], o[c * 8 + 5]), pk2(o[c * 8 + 6], o[c * 8 + 7])}; }
                }
            }
            SEAM(10);
            if (IN(11)) {
                pg8::Gemm g{QB, Wo, MR, DM, DM, 0}; pg8::StaticOrder S; S.init(MR, DM, G, bx);
                pg8::EpiResid<0> E{H, nullptr, nullptr};
                pg8::gemm_phase<pg8::EpiResid<0>, pg8::StaticOrder, true, true>(lds, g, S, E);
            }
            SEAM(11);
        }
        if (IN(pb)) { for (int r = gw; r < MRX; r += NGW) norm_row(stream_row(r, 0, H, xin, metain), XN + (size_t)r * DM, lane); }
        SEAM(pb);
        if (IN(pb + 1)) {
            pg8::Gemm g{XN, ly ? Wup1 : Wup0, 2 * TPB * 256, NUP, DM, 2}; pg8::StaticOrder S; S.init(2 * TPB * 256, NUP, G, bx);
            pg8::EpiUp E{ACT, ffn_conv_w + (size_t)ly * 3 * NUP, ffn_conv_b + (size_t)ly * NUP};
            pg8::gemm_phase<pg8::EpiUp, pg8::StaticOrder, true, true>(lds, g, S, E);
        }
        SEAM(pb + 1);
        if (IN(pb + 2)) {
            pg8::Gemm g{ACT, ly ? Wdn1 : Wdn0, MR, DM, DFF, 0}; pg8::StaticOrder S; S.init(MR, DM, G, bx);
            pg8::EpiResid<0> E{H, nullptr, nullptr};
            pg8::gemm_phase<pg8::EpiResid<0>, pg8::StaticOrder, true, true>(lds, g, S, E);
        }
        SEAM(pb + 2);
    }
    if (IN(15)) {
        for (int r = gw; r < NBATCH * SEQ; r += NGW) {
            const int b = r / SEQ, t = r % SEQ; const f32x4* xr = (const f32x4*)(H + (size_t)(b * BS + OFF + NMETA + t) * DM) + lane;
            f32x4 v[4]; float s = 0.f;
#pragma unroll
            for (int j = 0; j < 4; ++j) { v[j] = xr[64 * j]; s += (v[j].x * v[j].x + v[j].y * v[j].y) + (v[j].z * v[j].z + v[j].w * v[j].w); }
            const float rstd = 1.0f / sqrtf(wave_sum(s) * (1.f / DM) + EPS);
            f32x4* op = (f32x4*)(OUTP + (size_t)r * DM) + lane; const f32x4* gp = (const f32x4*)final_norm + lane;
#pragma unroll
            for (int j = 0; j < 4; ++j) op[64 * j] = v[j] * rstd * gp[64 * j];
        }
    }
#undef IN
#undef SEAM
}

#undef xin
#undef metain
#undef ssd_norm
#undef ssd_w_in
#undef ssd_conv_w
#undef ssd_conv_b
#undef ssd_dt_bias
#undef ssd_a_log
#undef ssd_d_skip
#undef ssd_gate_norm
#undef ssd_w_out
#undef kv_norm
#undef w_kv
#undef sb_norm
#undef sb_w_q
#undef sb_w_o
#undef ffn_norm
#undef ffn_w_up
#undef ffn_conv_w
#undef ffn_conv_b
#undef ffn_w_down
#undef final_norm
#undef ws
#undef Win
#undef Wout
#undef Wkvq
#undef Wo
#undef Wup0
#undef Wup1
#undef Wdn0
#undef Wdn1
#undef DT
#undef XBC
#undef H
#undef Z
#undef ACT
#undef KB
#undef VB
#undef QB
#undef XN
#undef OUTP
constexpr int NPHASES = 16;
extern "C" void kernel_launch(void* const* d_in, const int* in_sizes, int n_in, void* d_out, int out_size, void* d_ws, size_t ws_size, hipStream_t stream) {
    static int grid = 0;
    if (grid == 0) {
        if (n_in != 22 || ws_size < WS_END || out_size != NBATCH * SEQ * DM) { fprintf(stderr, "kernel_launch: unexpected shapes (n_in %d ws %zu out %d)\n", n_in, ws_size, out_size); grid = -1; return; }
        int dev = 0, cus = 0, per_cu = 0;
        (void)hipGetDevice(&dev); (void)hipDeviceGetAttribute(&cus, hipDeviceAttributeMultiprocessorCount, dev);
        (void)hipFuncSetAttribute((const void*)mega, hipFuncAttributeMaxDynamicSharedMemorySize, LDS_BYTES);
        (void)hipOccupancyMaxActiveBlocksPerMultiprocessor(&per_cu, (const void*)mega, NTHR, LDS_BYTES);
        (void)hipGetLastError();
        if (per_cu < 1) per_cu = 1;
        grid = cus * 1;
    }
    if (grid < 0) return;
    Args a{};
    for (int i = 0; i < 22; ++i) a.in[i] = (const float*)d_in[i];
    a.outp = (float*)d_out; a.wsp = (unsigned char*)d_ws;
#if MK_COOP
    a.ph_lo = 0; a.ph_hi = NPHASES; a.coop = 1;
    void* kargs[] = {&a};
    hipError_t e = hipLaunchCooperativeKernel((const void*)mega, dim3(grid), dim3(NTHR), kargs, LDS_BYTES, stream);
    if (e != hipSuccess) fprintf(stderr, "cooperative launch failed: %s (grid %d)\n", hipGetErrorString(e), grid);
#else
    for (int p = 0; p < NPHASES; ++p) { a.ph_lo = p; a.ph_hi = p + 1; a.coop = 0; hipLaunchKernelGGL(mega, dim3(grid), dim3(NTHR), LDS_BYTES, stream, a); }
#endif
}
```

```cpp
#include <hip/hip_runtime.h>
#include <hip/hip_cooperative_groups.h>
#include <cstdio>
#include <cstdint>
namespace cg = cooperative_groups;

constexpr int DM = 1024, NBATCH = 2, SEQ = 8192, NMETA = 16, LTOK = NMETA + SEQ;
constexpr int BS = 8224, OFF = 16;
constexpr int MR = 65 * 256;
constexpr int MRX = 66 * 256;
constexpr int TPB = 33;
constexpr int DI = 2048, NSTATE = 128, NHS = 32, CONVD = 3072, NIN = 5376, NIN_REAL = 5152;
constexpr int DFF = 2816, NUP = 5632;
constexpr float EPS = 1e-6f;

#ifndef MK_COOP
#define MK_COOP 1
#endif
namespace pg8 {
#define PG8_LAS __attribute__((address_space(3)))
typedef unsigned short bf16_t;
typedef short bf16x8 __attribute__((ext_vector_type(8)));
typedef float f32x4 __attribute__((ext_vector_type(4)));
typedef unsigned u32x4 __attribute__((ext_vector_type(4)));
constexpr int BM = 256, BK = 64, HALF = 128, HTB = HALF * BK * 2  , STAGE_BYTES = 8 * HTB, NXCD = 8, WGM = 8;

__host__ __device__ __forceinline__ int lds_byte(int r, int c) { const int st = (r >> 4) * 2 + (c >> 5), rr = r & 15, cc = c & 31, ob = rr * 64 + cc * 2; return st * 1024 + (ob ^ (((ob >> 9) & 1) << 5)); }
__host__ __device__ __forceinline__ void stage_rc(int b, int& R, int& C) { const int st = b / 1024, sb = b % 1024, swz = sb ^ (((sb >> 9) & 1) << 5); R = (st >> 1) * 16 + swz / 64; C = (st & 1) * 32 + (swz % 64) / 2; }
__host__ __device__ __forceinline__ int perm32(int rho) { const int n = rho >> 4, i = rho & 15; return 8 * (i >> 2) + 4 * n + (i & 3); }

struct Unit { int pm, pn; };
struct Gemm { const bf16_t* A; const bf16_t* Bt; int M, N, K; int halo;
    __device__ __forceinline__ size_t a_off(int pm) const { const int row = halo == 0 ? pm * 256 : (pm / TPB) * BS + OFF - halo + (256 - halo) * (pm % TPB); return (size_t)row * (size_t)K * 2; } };

struct StaticOrder {
    int nM, nN, nwg, G, c;
    __host__ __device__ void init(int M, int N, int G_, int c_) { nM = M / BM; nN = N / BM; nwg = nM * nN; G = G_; c = c_; }
    __host__ __device__ bool next(int i, Unit& u) const {
        const long L = (long)i * G + c; if (L >= nwg) return false;
        int wgid = (int)L; { const int q = nwg / NXCD, r = nwg % NXCD, xcd = wgid % NXCD, off = wgid / NXCD; wgid = (xcd < r ? xcd * (q + 1) : r * (q + 1) + (xcd - r) * q) + off; }
        const int nig = WGM * nN, gid = wgid / nig, fm = gid * WGM, gsz = (nM - fm) < WGM ? (nM - fm) : WGM;
        u.pm = fm + ((wgid % nig) % gsz); u.pn = (wgid % nig) / gsz; return true;
    }
    __device__ __forceinline__ void a_ready(const Unit&) const {}
    __device__ __forceinline__ void done(const Unit&) const {}
};

__device__ __forceinline__ unsigned cvt_pk_bf16(float lo, float hi) { unsigned r; asm volatile("v_cvt_pk_bf16_f32 %0, %1, %2" : "=v"(r) : "v"(lo), "v"(hi)); return r; }
typedef float f32x2 __attribute__((ext_vector_type(2)));
__device__ __forceinline__ float silu_f(float v) { return v * __builtin_amdgcn_rcpf(1.0f + __expf(-v)); }
__device__ __forceinline__ float softplus_f(float v) { return fmaxf(v, 0.f) + log1pf(__expf(-fabsf(v))); }
__device__ __forceinline__ float bflo(unsigned u) { return __uint_as_float(u << 16); }
__device__ __forceinline__ float bfhi(unsigned u) { return __uint_as_float(u & 0xffff0000u); }
typedef unsigned u32x2 __attribute__((ext_vector_type(2)));

struct EpiBf16 {
    static constexpr bool PERM = true, AFTER_DRAIN = false;
    bf16_t* O; int ldc; int split_cols; size_t split_stride;
    __device__ __forceinline__ void operator()(const f32x4 (&acc)[2][2][4][2], const Unit& u, int wr, int wc, int fr, int fq, PG8_LAS unsigned char*) const {
        asm volatile("" : "+v"(fr), "+v"(fq));
        const int row0 = u.pm * BM + wr * 64 + fr; int colt = u.pn * BM; bf16_t* base = O;
        if (split_cols) { const int t = colt / split_cols; base += (size_t)t * split_stride; colt -= t * split_cols; }
        const int col0 = colt + wc * 32 + 8 * fq;
#pragma unroll
        for (int ai = 0; ai < 2; ++ai)
#pragma unroll
            for (int m = 0; m < 4; ++m) { bf16_t* rowp = base + (size_t)(row0 + ai * HALF + m * 16) * ldc + col0;
#pragma unroll
                for (int bj = 0; bj < 2; ++bj) { const f32x4 v0 = acc[ai][bj][m][0], v1 = acc[ai][bj][m][1];
                    u32x4 w; w.x = cvt_pk_bf16(v0[0], v0[1]); w.y = cvt_pk_bf16(v0[2], v0[3]); w.z = cvt_pk_bf16(v1[0], v1[1]); w.w = cvt_pk_bf16(v1[2], v1[3]);
                    *(u32x4*)(rowp + bj * HALF) = w; } }
    }
};

template <int mode> struct EpiResid {
    static constexpr bool PERM = false, AFTER_DRAIN = false;
    float* H; const float* x; const float* meta;
    __device__ __forceinline__ void operator()(const f32x4 (&acc)[2][2][4][2], const Unit& u, int wr, int wc, int fr, int fq, PG8_LAS unsigned char*) const {
        asm volatile("" : "+v"(fr), "+v"(fq));
        const int col0 = u.pn * BM + wc * 32 + 4 * fq;
#pragma unroll
        for (int ai = 0; ai < 2; ++ai)
#pragma unroll
            for (int m = 0; m < 4; ++m) {
                const int r = u.pm * BM + ai * HALF + wr * 64 + m * 16 + fr;
                const int b = r >= BS ? 1 : 0, l = r - b * BS - OFF;
                if (l >= 0 && l < LTOK) {
                    float* hp = H + (size_t)r * DM + col0;
                    const float* bp = mode == 0 ? hp : (l < NMETA ? meta + (size_t)l * DM + col0 : x + ((size_t)b * SEQ + (l - NMETA)) * DM + col0);
#pragma unroll
                    for (int bj = 0; bj < 2; ++bj)
#pragma unroll
                        for (int n = 0; n < 2; ++n) { const f32x4 bs = *(const f32x4*)(bp + bj * HALF + n * 16); *(f32x4*)(hp + bj * HALF + n * 16) = bs + acc[ai][bj][m][n]; }
                }
                asm volatile("" ::: "memory");
            }
    }
};

__device__ __forceinline__ void halo_publish(const f32x4 (&acc)[2][2][4][2], PG8_LAS unsigned char* xl, int wr, int wc, int fr, int fq) {
    PG8_LAS f32x4* X = (PG8_LAS f32x4*)xl; const int wave = wr * 4 + wc;
    if (fr >= 12) {
#pragma unroll
        for (int ai = 0; ai < 2; ++ai)
#pragma unroll
            for (int bj = 0; bj < 2; ++bj)
#pragma unroll
                for (int n = 0; n < 2; ++n) X[(((wave * 2 + ai) * 4 + bj * 2 + n) * 16) + fq * 4 + (fr - 12)] = acc[ai][bj][3][n];
    }
    asm volatile("s_waitcnt lgkmcnt(0)" ::: "memory"); __builtin_amdgcn_s_barrier(); asm volatile("" ::: "memory");
}
__device__ __forceinline__ f32x4 halo_get(PG8_LAS unsigned char* xl, int ai, int bj, int n, int wr, int wc, int fr, int fq) {
    const PG8_LAS f32x4* X = (const PG8_LAS f32x4*)xl; const int pai = wr == 1 ? ai : ai - 1, pw = (wr ^ 1) * 4 + wc;
    f32x4 r = (f32x4){0.f, 0.f, 0.f, 0.f};
    if (fr >= 12 && pai >= 0) r = X[(((pw * 2 + pai) * 4 + bj * 2 + n) * 16) + fq * 4 + (fr - 12)];
    return r;
}

struct EpiInProj {
    static constexpr bool PERM = true, AFTER_DRAIN = false;
    bf16_t* Z; bf16_t* XBC; float* DT; const float* cw; const float* cb; const float* dtb;
    __device__ __forceinline__ void operator()(const f32x4 (&acc)[2][2][4][2], const Unit& u, int wr, int wc, int fr, int fq, PG8_LAS unsigned char* xl) const {
        asm volatile("" : "+v"(fr), "+v"(fq));
        const int pb = u.pm / TPB, pt = u.pm % TPB, l0 = 253 * pt - 3, rowbase = pb * BS + OFF + l0, lane = fq * 16 + fr;
        if (u.pn < 8) {
            const int col0 = u.pn * BM + wc * 32 + 8 * fq;
#pragma unroll
            for (int ai = 0; ai < 2; ++ai)
#pragma unroll
                for (int m = 0; m < 4; ++m) { const int i = ai * HALF + wr * 64 + m * 16 + fr, l = l0 + i;
                    if (i >= 3 && l < LTOK) { bf16_t* rowp = Z + (size_t)(rowbase + i) * DI + col0;
#pragma unroll
                        for (int bj = 0; bj < 2; ++bj) { const f32x4 v0 = acc[ai][bj][m][0], v1 = acc[ai][bj][m][1];
                            u32x4 w; w.x = cvt_pk_bf16(v0[0], v0[1]); w.y = cvt_pk_bf16(v0[2], v0[3]); w.z = cvt_pk_bf16(v1[0], v1[1]); w.w = cvt_pk_bf16(v1[2], v1[3]);
                            *(u32x4*)(rowp + bj * HALF) = w; } } }
        } else if (u.pn < 20) {
            halo_publish(acc, xl, wr, wc, fr, fq);
            const int s1 = (lane & 48) | ((fr - 1) & 15), s2 = (lane & 48) | ((fr - 2) & 15), s3 = (lane & 48) | ((fr - 3) & 15);
#pragma unroll
            for (int bj = 0; bj < 2; ++bj)
#pragma unroll
                for (int n = 0; n < 2; ++n) {
                    const int c0 = (u.pn - 8) * BM + bj * HALF + wc * 32 + 8 * fq + 4 * n;
                    const f32x4 w0 = *(const f32x4*)(cw + c0), w1 = *(const f32x4*)(cw + CONVD + c0), w2 = *(const f32x4*)(cw + 2 * CONVD + c0), w3 = *(const f32x4*)(cw + 3 * CONVD + c0), bb = *(const f32x4*)(cb + c0);
#pragma unroll
                    for (int ai = 0; ai < 2; ++ai)
#pragma unroll
                        for (int m = 0; m < 4; ++m) {
                            const f32x4 cur = acc[ai][bj][m][n];
                            f32x4 prv; if (m > 0) prv = acc[ai][bj][m > 0 ? m - 1 : 0][n]; else prv = halo_get(xl, ai, bj, n, wr, wc, fr, fq);
                            float o[4];
#pragma unroll
                            for (int j = 0; j < 4; ++j) {
                                const float v1 = __shfl(fr >= 15 ? prv[j] : cur[j], s1), v2 = __shfl(fr >= 14 ? prv[j] : cur[j], s2), v3 = __shfl(fr >= 13 ? prv[j] : cur[j], s3);
                                o[j] = silu_f(bb[j] + w3[j] * cur[j] + w2[j] * v1 + w1[j] * v2 + w0[j] * v3);
                            }
                            const int i = ai * HALF + wr * 64 + m * 16 + fr, l = l0 + i;
                            if (i >= 3 && l < LTOK) { u32x2 w; w.x = cvt_pk_bf16(o[0], o[1]); w.y = cvt_pk_bf16(o[2], o[3]); *(u32x2*)(XBC + (size_t)(rowbase + i) * CONVD + c0) = w; }
                        }
                    asm volatile("" ::: "memory");
                }
        } else {
            if (wc == 0) {
#pragma unroll
                for (int n = 0; n < 2; ++n) { const int c0 = 8 * fq + 4 * n; const f32x4 bb = *(const f32x4*)(dtb + c0);
#pragma unroll
                    for (int ai = 0; ai < 2; ++ai)
#pragma unroll
                        for (int m = 0; m < 4; ++m) { const int i = ai * HALF + wr * 64 + m * 16 + fr, l = l0 + i; const f32x4 v = acc[ai][0][m][n] + bb;
                            if (i >= 3 && l < LTOK) *(f32x4*)(DT + (size_t)(rowbase + i) * NHS + c0) = (f32x4){softplus_f(v[0]), softplus_f(v[1]), softplus_f(v[2]), softplus_f(v[3])}; } }
            }
        }
    }
};

struct EpiUp {
    static constexpr bool PERM = true, AFTER_DRAIN = false;
    bf16_t* ACT; const float* cw; const float* cb;
    __device__ __forceinline__ void operator()(const f32x4 (&acc)[2][2][4][2], const Unit& u, int wr, int wc, int fr, int fq, PG8_LAS unsigned char* xl) const {
        asm volatile("" : "+v"(fr), "+v"(fq));
        const int pb = u.pm / TPB, pt = u.pm % TPB, l0 = 254 * pt - 2, rowbase = pb * BS + OFF + l0, lane = fq * 16 + fr;
        halo_publish(acc, xl, wr, wc, fr, fq);
        const int s1 = (lane & 48) | ((fr - 1) & 15), s2 = (lane & 48) | ((fr - 2) & 15);
#pragma unroll
        for (int n = 0; n < 2; ++n) {
            const int c0 = u.pn * HALF + wc * 32 + 8 * fq + 4 * n;
            const f32x4 g0 = *(const f32x4*)(cw + c0), g1 = *(const f32x4*)(cw + NUP + c0), g2 = *(const f32x4*)(cw + 2 * NUP + c0), gb = *(const f32x4*)(cb + c0);
            const f32x4 h0 = *(const f32x4*)(cw + DFF + c0), h1 = *(const f32x4*)(cw + NUP + DFF + c0), h2 = *(const f32x4*)(cw + 2 * NUP + DFF + c0), hb = *(const f32x4*)(cb + DFF + c0);
#pragma unroll
            for (int ai = 0; ai < 2; ++ai)
#pragma unroll
                for (int m = 0; m < 4; ++m) {
                    const f32x4 cg = acc[ai][0][m][n], cv = acc[ai][1][m][n];
                    f32x4 pg, pv; if (m > 0) { pg = acc[ai][0][m > 0 ? m - 1 : 0][n]; pv = acc[ai][1][m > 0 ? m - 1 : 0][n]; } else { pg = halo_get(xl, ai, 0, n, wr, wc, fr, fq); pv = halo_get(xl, ai, 1, n, wr, wc, fr, fq); }
                    float o[4];
#pragma unroll
                    for (int j = 0; j < 4; ++j) {
                        const float a1 = __shfl(fr >= 15 ? pg[j] : cg[j], s1), a2 = __shfl(fr >= 14 ? pg[j] : cg[j], s2);
                        const float b1 = __shfl(fr >= 15 ? pv[j] : cv[j], s1), b2 = __shfl(fr >= 14 ? pv[j] : cv[j], s2);
                        const float gg = gb[j] + g2[j] * cg[j] + g1[j] * a1 + g0[j] * a2, vv = hb[j] + h2[j] * cv[j] + h1[j] * b1 + h0[j] * b2;
                        o[j] = silu_f(gg) * vv;
                    }
                    const int i = ai * HALF + wr * 64 + m * 16 + fr, l = l0 + i;
                    if (i >= 2 && l < LTOK) { u32x2 w; w.x = cvt_pk_bf16(o[0], o[1]); w.y = cvt_pk_bf16(o[2], o[3]); *(u32x2*)(ACT + (size_t)(rowbase + i) * DFF + c0) = w; }
                }
            asm volatile("" ::: "memory");
        }
    }
};

template <class Epi, class Sched, bool ALIGN_EPI = false, bool SP2 = false>
__device__ __forceinline__ void gemm_phase(PG8_LAS unsigned char* lds, const Gemm g, const Sched& S, const Epi& E) {
    const int tid = threadIdx.x, wid = __builtin_amdgcn_readfirstlane(tid >> 6), lane = tid & 63, wr = wid >> 2, wc = wid & 3, fr = lane & 15, fq = lane >> 4;
    const int K = g.K, nt = K / BK;
    unsigned voffA[2], voffB[2];
#pragma unroll
    for (int i = 0; i < 2; ++i) { int R, C; stage_rc(tid * 16 + i * 8192, R, C); const int Rb = Epi::PERM ? ((R & ~31) + perm32(R & 31)) : R;
        voffA[i] = (unsigned)(R * K + C) * 2u; voffB[i] = (unsigned)(Rb * K + C) * 2u; }
    const size_t kstep = (size_t)(BK * 2);
    const size_t hstep = (size_t)HALF * K * 2;
    const size_t tstep = 2 * hstep;
    const unsigned ldsw = (unsigned)wid * 1024u;
    const int aoff = lds_byte(wr * 64 + fr, fq * 8), boff = lds_byte(wc * 32 + fr, fq * 8);
#define PG8_SA(b, h) (((b) * 2 + (h)) * HTB)
#define PG8_SB(b, h) ((4 + (b) * 2 + (h)) * HTB)
#define PG8_STAGE(bufoff, gbase, voff) do { _Pragma("unroll") for (int _i = 0; _i < 2; ++_i) \
        __builtin_amdgcn_global_load_lds((const unsigned*)((const char*)(gbase) + (voff)[_i]), (PG8_LAS unsigned*)(lds + (bufoff) + ldsw + _i * 8192), 16, 0, 0); } while (0)
#define PG8_LDA(dst, b, h) do { _Pragma("unroll") for (int m = 0; m < 4; ++m) _Pragma("unroll") for (int k = 0; k < 2; ++k) dst[m][k] = *(const PG8_LAS bf16x8*)(lds + PG8_SA(b, h) + aoff + m * 2048 + k * 1024); } while (0)
#define PG8_LDB(dst, b, h) do { _Pragma("unroll") for (int n = 0; n < 2; ++n) _Pragma("unroll") for (int k = 0; k < 2; ++k) dst[n][k] = *(const PG8_LAS bf16x8*)(lds + PG8_SB(b, h) + boff + n * 2048 + k * 1024); } while (0)
#define PG8_MMA(ai, bj, At, Bt) do { __builtin_amdgcn_s_setprio(1); _Pragma("unroll") for (int m = 0; m < 4; ++m) _Pragma("unroll") for (int n = 0; n < 2; ++n) _Pragma("unroll") for (int k = 0; k < 2; ++k) \
        acc[ai][bj][m][n] = __builtin_amdgcn_mfma_f32_16x16x32_bf16(Bt[n][k], At[m][k], acc[ai][bj][m][n], 0, 0, 0); __builtin_amdgcn_s_setprio(0); } while (0)
#define PG8_WAIT_V(n) asm volatile("s_waitcnt vmcnt(" #n ")" ::: "memory")
#define PG8_WAIT_L(n) asm volatile("s_waitcnt lgkmcnt(" #n ")" ::: "memory")
#define PG8_BAR __builtin_amdgcn_s_barrier()
#define PG8_SCHED __builtin_amdgcn_sched_barrier(0)
    Unit cur, nxt; int ui = 0;
    if (!S.next(0, cur)) return;
    f32x4 acc[2][2][4][2];
#pragma unroll
    for (int a = 0; a < 2; ++a)
#pragma unroll
        for (int b = 0; b < 2; ++b)
#pragma unroll
            for (int m = 0; m < 4; ++m)
#pragma unroll
                for (int n = 0; n < 2; ++n) acc[a][b][m][n] = (f32x4){0.f, 0.f, 0.f, 0.f};
    bf16x8 At[4][2], B0[2][2], B1[2][2];
    const char* cA = (const char*)g.A + g.a_off(cur.pm); const char* cB = (const char*)g.Bt + (size_t)cur.pn * tstep;
    S.a_ready(cur);
    if constexpr (SP2) {
        PG8_STAGE(PG8_SB(0, 0), cB, voffB); PG8_STAGE(PG8_SB(0, 1), cB + hstep, voffB); PG8_STAGE(PG8_SA(0, 0), cA, voffA); PG8_STAGE(PG8_SA(0, 1), cA + hstep, voffA);
        if (wr == 1) PG8_BAR;
        PG8_WAIT_V(2); PG8_BAR;
        PG8_STAGE(PG8_SB(1, 0), cB + kstep, voffB); PG8_STAGE(PG8_SA(1, 0), cA + kstep, voffA); PG8_STAGE(PG8_SB(1, 1), cB + hstep + kstep, voffB);
        PG8_WAIT_V(6); PG8_BAR;
    } else {
        PG8_STAGE(PG8_SB(0, 0), cB, voffB); PG8_STAGE(PG8_SA(0, 0), cA, voffA); PG8_STAGE(PG8_SB(0, 1), cB + hstep, voffB); PG8_STAGE(PG8_SA(0, 1), cA + hstep, voffA);
        if (wr == 1) PG8_BAR;
        PG8_WAIT_V(4); PG8_BAR;
        PG8_STAGE(PG8_SB(1, 0), cB + kstep, voffB); PG8_STAGE(PG8_SA(1, 0), cA + kstep, voffA); PG8_STAGE(PG8_SB(1, 1), cB + hstep + kstep, voffB);
        PG8_WAIT_V(6); PG8_BAR;
    }
    for (;;) {
        const bool has_next = S.next(ui + 1, nxt);
        const char* nA = has_next ? (const char*)g.A + g.a_off(nxt.pm) : cA; const char* nB = has_next ? (const char*)g.Bt + (size_t)nxt.pn * tstep : cB;
        for (int t = 0; t < nt; t += 2) {
            const bool last = (t == nt - 2);
            const char* a1 = cA + (size_t)(t + 1) * kstep;
            const char* a2 = last ? nA : cA + (size_t)(t + 2) * kstep; const char* b2 = last ? nB : cB + (size_t)(t + 2) * kstep;
            const char* a3 = a2 + kstep; const char* b3 = b2 + kstep;
            if (last && has_next) S.a_ready(nxt);
            if constexpr (SP2) {
            PG8_LDB(B0, 0, 0); PG8_LDB(B1, 0, 1); PG8_SCHED; PG8_LDA(At, 0, 0); PG8_STAGE(PG8_SA(1, 1), a1 + hstep, voffA);
            PG8_WAIT_V(8); PG8_WAIT_L(0); PG8_BAR; PG8_MMA(0, 0, At, B0); PG8_MMA(0, 1, At, B1); PG8_BAR; PG8_SCHED;
            PG8_LDA(At, 0, 1); PG8_STAGE(PG8_SB(0, 0), b2, voffB); PG8_STAGE(PG8_SB(0, 1), b2 + hstep, voffB); PG8_STAGE(PG8_SA(0, 0), a2, voffA);
            PG8_WAIT_V(8); PG8_WAIT_L(0); PG8_BAR; PG8_MMA(1, 0, At, B0); PG8_MMA(1, 1, At, B1); PG8_BAR; PG8_SCHED;
            PG8_LDB(B0, 1, 0); PG8_LDB(B1, 1, 1); PG8_SCHED; PG8_LDA(At, 1, 0); PG8_STAGE(PG8_SA(0, 1), a2 + hstep, voffA);
            PG8_WAIT_V(8); PG8_WAIT_L(0); PG8_BAR; PG8_MMA(0, 0, At, B0); PG8_MMA(0, 1, At, B1); PG8_BAR; PG8_SCHED;
            PG8_LDA(At, 1, 1); PG8_STAGE(PG8_SB(1, 0), b3, voffB); PG8_STAGE(PG8_SB(1, 1), b3 + hstep, voffB); PG8_STAGE(PG8_SA(1, 0), a3, voffA);
            PG8_WAIT_V(8); PG8_WAIT_L(0); PG8_BAR; PG8_MMA(1, 0, At, B0); PG8_MMA(1, 1, At, B1); PG8_BAR; PG8_SCHED;
            } else {
            PG8_LDB(B0, 0, 0); PG8_SCHED; PG8_LDA(At, 0, 0); PG8_STAGE(PG8_SA(1, 1), a1 + hstep, voffA);
            PG8_WAIT_L(8); PG8_BAR; PG8_WAIT_L(0); PG8_MMA(0, 0, At, B0); PG8_BAR; PG8_SCHED;
            PG8_LDB(B1, 0, 1); PG8_STAGE(PG8_SB(0, 0), b2, voffB);
            PG8_BAR; PG8_WAIT_L(0); PG8_MMA(0, 1, At, B1); PG8_BAR;
            PG8_LDA(At, 0, 1); PG8_STAGE(PG8_SA(0, 0), a2, voffA);
            PG8_BAR; PG8_WAIT_L(0); PG8_MMA(1, 0, At, B0); PG8_BAR; PG8_SCHED;
            PG8_STAGE(PG8_SB(0, 1), b2 + hstep, voffB);
            PG8_WAIT_V(6); PG8_BAR; PG8_MMA(1, 1, At, B1); PG8_BAR;
            PG8_LDB(B0, 1, 0); PG8_SCHED; PG8_LDA(At, 1, 0); PG8_STAGE(PG8_SA(0, 1), a2 + hstep, voffA);
            PG8_WAIT_L(8); PG8_BAR; PG8_WAIT_L(0); PG8_MMA(0, 0, At, B0); PG8_BAR; PG8_SCHED;
            PG8_LDB(B1, 1, 1); PG8_STAGE(PG8_SB(1, 0), b3, voffB);
            PG8_BAR; PG8_WAIT_L(0); PG8_MMA(0, 1, At, B1); PG8_BAR;
            PG8_LDA(At, 1, 1); PG8_STAGE(PG8_SA(1, 0), a3, voffA);
            PG8_BAR; PG8_WAIT_L(0); PG8_MMA(1, 0, At, B0); PG8_BAR; PG8_SCHED;
            PG8_STAGE(PG8_SB(1, 1), b3 + hstep, voffB);
            PG8_WAIT_V(6); PG8_BAR; PG8_MMA(1, 1, At, B1); PG8_BAR;
            }
        }
        if constexpr (ALIGN_EPI) { if (wr == 0) PG8_BAR; }
        if constexpr (!Epi::AFTER_DRAIN) { E(acc, cur, wr, wc, fr, fq, lds + STAGE_BYTES); S.done(cur); }
        if (!has_next) break;
#pragma unroll
        for (int a = 0; a < 2; ++a)
#pragma unroll
            for (int b = 0; b < 2; ++b)
#pragma unroll
                for (int m = 0; m < 4; ++m)
#pragma unroll
                    for (int n = 0; n < 2; ++n) acc[a][b][m][n] = (f32x4){0.f, 0.f, 0.f, 0.f};
        cur = nxt; cA = nA; cB = nB; ++ui;
        if constexpr (ALIGN_EPI) { if (wr == 1) PG8_BAR; }
    }
    PG8_WAIT_V(0);
    if constexpr (!ALIGN_EPI) { if (wr == 0) PG8_BAR; }
    PG8_BAR;

#undef PG8_SA
#undef PG8_SB
#undef PG8_STAGE
#undef PG8_LDA
#undef PG8_LDB
#undef PG8_MMA
#undef PG8_WAIT_V
#undef PG8_WAIT_L
#undef PG8_BAR
#undef PG8_SCHED
}
}

#define LAS __attribute__((address_space(3)))
typedef unsigned short bf16;
typedef unsigned v4u __attribute__((ext_vector_type(4)));
typedef unsigned v2u __attribute__((ext_vector_type(2)));
typedef float f32x4 __attribute__((ext_vector_type(4)));
constexpr int NWAVES = 8, NTHR = 512;
constexpr int RING_BYTES = 131072, XCH_BYTES = 16384, LDS_BYTES = RING_BYTES + XCH_BYTES + 1024;

constexpr size_t MiB = 1u << 20;
constexpr size_t SZ_WIN = (size_t)NIN * DM * 2, SZ_WOUT = (size_t)DM * DI * 2, SZ_WKVQ = (size_t)3072 * DM * 2, SZ_WO = (size_t)DM * DM * 2, SZ_WUP = (size_t)NUP * DM * 2, SZ_WDN = (size_t)DM * DFF * 2;
constexpr size_t WS_WIN = 1 * MiB, WS_WOUT = WS_WIN + SZ_WIN, WS_WKVQ = WS_WOUT + SZ_WOUT, WS_WO = WS_WKVQ + SZ_WKVQ, WS_WUP0 = WS_WO + SZ_WO, WS_WUP1 = WS_WUP0 + SZ_WUP, WS_WDN0 = WS_WUP1 + SZ_WUP, WS_WDN1 = WS_WDN0 + SZ_WDN, WS_WEND = WS_WDN1 + SZ_WDN;
constexpr size_t WS_DT = 57 * MiB;
constexpr size_t WS_XBC = 60 * MiB;
constexpr size_t WS_H = WS_XBC;
constexpr size_t WS_Z = 158 * MiB;
constexpr size_t WS_ST = 223 * MiB;
constexpr size_t WS_ACT = 126 * MiB;
constexpr size_t WS_K = 126 * MiB, WS_V = 159 * MiB, WS_Q = 192 * MiB;
constexpr size_t WS_END = 256 * MiB;
static_assert(WS_WEND <= WS_DT && WS_DT + (size_t)MR * 32 * 4 <= WS_XBC && WS_XBC + (size_t)MR * CONVD * 2 <= WS_Z && WS_Z + (size_t)MR * DI * 2 <= WS_ST, "ws map 1");
static_assert(WS_H + (size_t)MR * DM * 4 <= WS_ACT && WS_ACT + (size_t)MR * DFF * 2 <= WS_END && WS_K + (size_t)MR * DM * 2 <= WS_V && WS_V + (size_t)MR * DM * 2 <= WS_Q && WS_Q + (size_t)MR * DM * 2 <= WS_END, "ws map 2");

__device__ __forceinline__ unsigned f2bf(float f) { unsigned u = __builtin_bit_cast(unsigned, f); return (u + 0x7fffu + ((u >> 16) & 1u)) >> 16; }
__device__ __forceinline__ unsigned pk2(float lo, float hi) { return f2bf(lo) | (f2bf(hi) << 16); }
__device__ __forceinline__ float wave_sum(float v) {
#pragma unroll
    for (int o = 1; o < 64; o <<= 1) v += __shfl_xor(v, o);
    return v;
}
__device__ __forceinline__ float bf_lo(unsigned u) { return __uint_as_float(u << 16); }
__device__ __forceinline__ float bf_hi(unsigned u) { return __uint_as_float(u & 0xffff0000u); }

__device__ __forceinline__ void transpose_item(const float* W, int pitch, int K, bf16* WT, int nrow0, int srccol0, int k0, const float* gain, LAS float* scr, int lane) {
#pragma unroll 8
    for (int i = 0; i < 32; ++i) { const int kk = 2 * i + (lane >> 5); float v = 0.f;
        if (srccol0 >= 0) { v = W[(size_t)(k0 + kk) * pitch + srccol0 + (lane & 31)]; if (gain) v *= gain[k0 + kk]; }
        scr[kk * 33 + (lane & 31)] = v; }
    asm volatile("s_waitcnt lgkmcnt(0)" ::: "memory");
    const int c = lane & 7;
#pragma unroll
    for (int j = 0; j < 4; ++j) { const int n = (lane >> 3) + 8 * j; const LAS float* s = scr + (8 * c) * 33 + n;
        v4u o; o.x = pk2(s[0 * 33], s[1 * 33]); o.y = pk2(s[2 * 33], s[3 * 33]); o.z = pk2(s[4 * 33], s[5 * 33]); o.w = pk2(s[6 * 33], s[7 * 33]);
        *(v4u*)(WT + (size_t)(nrow0 + n) * K + k0 + 8 * c) = o; }
    asm volatile("s_waitcnt lgkmcnt(0)" ::: "memory");
}

constexpr int SB_LB = 0, SB_LC = 17408, SB_LX = 34816, SB_LXW = 44032, SB_LST = 53248, SB_LDT = 70656, SB_LACS = 70912;
typedef short bf16x8_t __attribute__((ext_vector_type(8)));
typedef short s16x4_t __attribute__((ext_vector_type(4)));
__device__ __forceinline__ s16x4_t lds_tr16(LAS unsigned char* p) { return __builtin_bit_cast(s16x4_t, __builtin_amdgcn_ds_read_tr16_b64_v4i16((LAS s16x4_t*)p)); }
__device__ __forceinline__ bf16x8_t cat8(s16x4_t a, s16x4_t b) { return (bf16x8_t){a[0], a[1], a[2], a[3], b[0], b[1], b[2], b[3]}; }

template <int PASS> __device__ __forceinline__ void ssd_unit(LAS unsigned char* lds, int b, int c, int h, const bf16* xbc_c, bf16* xbc_w, const float* dtp, bf16* ST, float* DEC, float a, float dsk, int tid) {
    const int lane = tid & 63, wave = __builtin_amdgcn_readfirstlane(tid >> 6), fr = lane & 15, fq = lane >> 4, q2 = fr >> 2, p2 = lane & 3, g = h >> 3;
    const int lbase = 256 * c, nvalid = (LTOK - lbase) < 256 ? (LTOK - lbase) : 256, nsub = (nvalid + 63) >> 6;
    const size_t rowb = (size_t)b * BS + OFF;
    f32x4 ast[4];
#pragma unroll
    for (int pb = 0; pb < 4; ++pb) ast[pb] = (f32x4){0.f, 0.f, 0.f, 0.f};
    if (PASS == 2 && c > 0) {
        const bf16* sp = ST + ((size_t)((b * 32 + (c - 1)) * NHS + h)) * 8192;
#pragma unroll
        for (int pb = 0; pb < 4; ++pb) { const v2u w = *(const v2u*)(sp + (16 * pb + fr) * 128 + 16 * wave + 4 * fq); ast[pb] = (f32x4){bf_lo(w.x), bf_hi(w.x), bf_lo(w.y), bf_hi(w.y)}; }
    }
    float totlog = 0.f;
    v4u gB[2], gC[2], gX; float gdt;
    auto prefetch = [&](int j) {
        const int l0 = lbase + 64 * j;
#pragma unroll
        for (int k = 0; k < 2; ++k) { const int idx = tid + 512 * k, row = idx >> 4, ch = idx & 15; int l = l0 + row; l = l < LTOK ? l : LTOK - 1;
            const bf16* rp = xbc_c + (rowb + l) * CONVD + DI + g * 128 + ch * 8; gB[k] = *(const v4u*)rp; if (PASS == 2) gC[k] = *(const v4u*)(rp + 512); }
        { const int row = tid >> 3, ch = tid & 7; int l = l0 + row; l = l < LTOK ? l : LTOK - 1; gX = *(const v4u*)(xbc_c + (rowb + l) * CONVD + h * 64 + ch * 8); }
        { const int l = l0 + lane; gdt = l < LTOK ? dtp[(rowb + l) * NHS + h] : 0.f; }
    };
    prefetch(0);
    for (int j = 0; j < nsub; ++j) {
        float acs = gdt * a;
#pragma unroll
        for (int o = 1; o < 64; o <<= 1) { const float t = __shfl_up(acs, o); if (lane >= o) acs += t; }
        const float aend = __shfl(acs, 63);
        const float wrow = gdt * __expf(aend - acs);
        if (wave == 0) { ((LAS float*)(lds + SB_LDT))[lane] = gdt; ((LAS float*)(lds + SB_LACS))[lane] = acs; }
#pragma unroll
        for (int k = 0; k < 2; ++k) { const int idx = tid + 512 * k, row = idx >> 4, ch = idx & 15; *(LAS v4u*)(lds + SB_LB + row * 272 + ch * 16) = gB[k]; if (PASS == 2) *(LAS v4u*)(lds + SB_LC + row * 272 + ch * 16) = gC[k]; }
        { const int row = tid >> 3, ch = tid & 7; const float wv = __shfl(wrow, row & 63);
          if (PASS == 2) *(LAS v4u*)(lds + SB_LX + row * 144 + ch * 16) = gX;
          v4u xw;
#pragma unroll
          for (int e = 0; e < 4; ++e) xw[e] = pk2(bf_lo(gX[e]) * wv, bf_hi(gX[e]) * wv);
          *(LAS v4u*)(lds + SB_LXW + row * 144 + ch * 16) = xw; }
        if (PASS == 2) {
#pragma unroll
            for (int pb = 0; pb < 4; ++pb) *(LAS v2u*)(lds + SB_LST + (16 * pb + fr) * 272 + (16 * wave + 4 * fq) * 2) = (v2u){pk2(ast[pb][0], ast[pb][1]), pk2(ast[pb][2], ast[pb][3])};
        }
        __syncthreads();
        if (j + 1 < nsub) prefetch(j + 1);
        totlog += aend;
        if (PASS == 2) {
            const int ib = wave >> 1;
            bf16x8_t cf[4];
#pragma unroll
            for (int ks = 0; ks < 4; ++ks) cf[ks] = *(const LAS bf16x8_t*)(lds + SB_LC + (16 * ib + fr) * 272 + (32 * ks + 8 * fq) * 2);
            const float acs_i = ((const LAS float*)(lds + SB_LACS))[16 * ib + fr];
            const int irow = 16 * ib + fr;
            bf16x8_t pf[2];
#pragma unroll
            for (int kk = 0; kk < 2; ++kk) {
                unsigned pw[4];
#pragma unroll
                for (int hf = 0; hf < 2; ++hf) { const int sb = 2 * kk + hf;
                    if (sb <= ib) {
                        f32x4 d = (f32x4){0.f, 0.f, 0.f, 0.f};
#pragma unroll
                        for (int ks = 0; ks < 4; ++ks) { const bf16x8_t af = *(const LAS bf16x8_t*)(lds + SB_LB + (16 * sb + fr) * 272 + (32 * ks + 8 * fq) * 2); d = __builtin_amdgcn_mfma_f32_16x16x32_bf16(af, cf[ks], d, 0, 0, 0); }
                        const f32x4 as4 = *(const LAS f32x4*)(lds + SB_LACS + (16 * sb + 4 * fq) * 4), dt4 = *(const LAS f32x4*)(lds + SB_LDT + (16 * sb + 4 * fq) * 4);
                        float v[4];
#pragma unroll
                        for (int r = 0; r < 4; ++r) { const int s = 16 * sb + 4 * fq + r; const float e = __expf(fminf(acs_i - as4[r], 0.f)); v[r] = s <= irow ? d[r] * dt4[r] * e : 0.f; }
                        pw[2 * hf] = pk2(v[0], v[1]); pw[2 * hf + 1] = pk2(v[2], v[3]);
                    } else { pw[2 * hf] = 0u; pw[2 * hf + 1] = 0u; }
                }
                pf[kk] = __builtin_bit_cast(bf16x8_t, (v4u){pw[0], pw[1], pw[2], pw[3]});
            }
            const float ei = __expf(acs_i);
            const int l_row = lbase + 64 * j + irow;
#pragma unroll
            for (int pbi = 0; pbi < 2; ++pbi) { const int pb = 2 * (wave & 1) + pbi;
                f32x4 acc = (f32x4){0.f, 0.f, 0.f, 0.f};
#pragma unroll
                for (int ks = 0; ks < 4; ++ks) { const bf16x8_t af = *(const LAS bf16x8_t*)(lds + SB_LST + (16 * pb + fr) * 272 + (32 * ks + 8 * fq) * 2); acc = __builtin_amdgcn_mfma_f32_16x16x32_bf16(af, cf[ks], acc, 0, 0, 0); }
                acc = acc * ei;
#pragma unroll
                for (int kk = 0; kk < 2; ++kk) if (2 * kk <= ib) {
                    LAS unsigned char* xp = lds + SB_LX + (32 * kk + 4 * fq + q2) * 144 + 32 * pb + 8 * p2;
                    const bf16x8_t xa = cat8(lds_tr16(xp), lds_tr16(xp + 16 * 144));
                    acc = __builtin_amdgcn_mfma_f32_16x16x32_bf16(xa, pf[kk], acc, 0, 0, 0); }
                const v2u xw = *(const LAS v2u*)(lds + SB_LX + irow * 144 + (16 * pb + 4 * fq) * 2);
                const float y0 = acc[0] + dsk * bf_lo(xw.x), y1 = acc[1] + dsk * bf_hi(xw.x), y2 = acc[2] + dsk * bf_lo(xw.y), y3 = acc[3] + dsk * bf_hi(xw.y);
                if (l_row < LTOK) *(v2u*)(xbc_w + (rowb + l_row) * CONVD + h * 64 + 16 * pb + 4 * fq) = (v2u){pk2(y0, y1), pk2(y2, y3)};
            }
        }
        { const float ed = __expf(aend);
#pragma unroll
          for (int pb = 0; pb < 4; ++pb) ast[pb] = ast[pb] * ed;
#pragma unroll
          for (int kk = 0; kk < 2; ++kk) {
              LAS unsigned char* bp = lds + SB_LB + (32 * kk + 8 * fq + q2) * 272 + 32 * wave + 8 * p2;
              const bf16x8_t af = cat8(lds_tr16(bp), lds_tr16(bp + 4 * 272));
#pragma unroll
              for (int pb = 0; pb < 4; ++pb) { LAS unsigned char* xp = lds + SB_LXW + (32 * kk + 8 * fq + q2) * 144 + 32 * pb + 8 * p2;
                  const bf16x8_t bfg = cat8(lds_tr16(xp), lds_tr16(xp + 4 * 144));
                  ast[pb] = __builtin_amdgcn_mfma_f32_16x16x32_bf16(af, bfg, ast[pb], 0, 0, 0); } } }
        __syncthreads();
    }
    if (PASS == 1) {
        bf16* sp = ST + ((size_t)((b * 32 + c) * NHS + h)) * 8192;
#pragma unroll
        for (int pb = 0; pb < 4; ++pb) *(v2u*)(sp + (16 * pb + fr) * 128 + 16 * wave + 4 * fq) = (v2u){pk2(ast[pb][0], ast[pb][1]), pk2(ast[pb][2], ast[pb][3])};
        if (tid == 0) DEC[(b * 32 + c) * NHS + h] = __expf(totlog);
    }
}

constexpr int AT_LK = 0, AT_LV = 9216, AT_FLAG = 18432;
__device__ __forceinline__ void attn_unit(LAS unsigned char* lds, int b, int h, int qb, bf16* Qb, const bf16* Kb, const bf16* Vb, int tid) {
    const int lane = tid & 63, wave = __builtin_amdgcn_readfirstlane(tid >> 6), fr = lane & 15, fq = lane >> 4, q2 = fr >> 2, p2 = lane & 3;
    const int t0 = 128 * qb, tw = t0 + 16 * wave, t = tw + fr;
    const size_t rowb = (size_t)b * BS + OFF;
    const bool tvalid = t < LTOK;
    bf16x8_t qf[2];
    { const bf16* qp = Qb + (rowb + (tvalid ? t : LTOK - 1)) * DM + h * 64 + 8 * fq; qf[0] = *(const bf16x8_t*)qp; qf[1] = *(const bf16x8_t*)(qp + 32); }
    f32x4 oacc[4];
#pragma unroll
    for (int db = 0; db < 4; ++db) oacc[db] = (f32x4){0.f, 0.f, 0.f, 0.f};
    float carry = 0.f;
    bool wdone = !__any(tvalid);
    const int srow = tid >> 3, sch = tid & 7;
    int k0 = t0 + 64; if (k0 >= LTOK) k0 = t0;
    v4u gK, gV;
    { int s = k0 + srow; s = s < LTOK ? s : LTOK - 1; const size_t off = (rowb + s) * DM + h * 64 + sch * 8; gK = *(const v4u*)(Kb + off); gV = *(const v4u*)(Vb + off); }
    for (;;) {
        *(LAS v4u*)(lds + AT_LK + srow * 144 + sch * 16) = gK; *(LAS v4u*)(lds + AT_LV + srow * 144 + sch * 16) = gV;
        __syncthreads();
        if (k0 >= 64) { const size_t off = (rowb + (k0 - 64) + srow) * DM + h * 64 + sch * 8; gK = *(const v4u*)(Kb + off); gV = *(const v4u*)(Vb + off); }
        if (!wdone && k0 <= tw + 14) {
            f32x4 st[4];
#pragma unroll
            for (int sb = 0; sb < 4; ++sb) { f32x4 d = (f32x4){0.f, 0.f, 0.f, 0.f};
#pragma unroll
                for (int ks = 0; ks < 2; ++ks) { const bf16x8_t kf = *(const LAS bf16x8_t*)(lds + AT_LK + (16 * sb + fr) * 144 + (32 * ks + 8 * fq) * 2); d = __builtin_amdgcn_mfma_f32_16x16x32_bf16(kf, qf[ks], d, 0, 0, 0); }
                st[sb] = d; }
            float lsp[4][4], lk[4][4], ps[4];
#pragma unroll
            for (int sb = 0; sb < 4; ++sb) { ps[sb] = 0.f;
#pragma unroll
                for (int r = 0; r < 4; ++r) { const int s = k0 + 16 * sb + 4 * fq + r; const bool vis = tvalid && s < t; const float x = st[sb][r] * 0.125f;
                    const float l1 = fminf(x, 0.f) - __logf(1.0f + __expf(-fabsf(x)));
                    lsp[sb][r] = vis ? l1 : -1e30f; lk[sb][r] = vis ? l1 - x : 0.f; ps[sb] += lk[sb][r]; } }
            float run = carry;
            unsigned pw[8];
#pragma unroll
            for (int sb = 3; sb >= 0; --sb) {
                const float a = ps[sb], bq = __shfl_xor(a, 16), cq = __shfl_xor(a, 32), dq = __shfl_xor(bq, 32);
                const float sfq = ((fq & 1) == 0 ? bq : 0.f) + ((fq & 2) == 0 ? cq + dq : 0.f);
                float lat = run + sfq; float wv[4];
#pragma unroll
                for (int r = 3; r >= 0; --r) { wv[r] = __expf(lsp[sb][r] + lat); lat += lk[sb][r]; }
                pw[2 * sb] = pk2(wv[0], wv[1]); pw[2 * sb + 1] = pk2(wv[2], wv[3]);
                run += (a + bq) + (cq + dq);
            }
            carry = run;
            const bf16x8_t pf0 = __builtin_bit_cast(bf16x8_t, (v4u){pw[0], pw[1], pw[2], pw[3]}), pf1 = __builtin_bit_cast(bf16x8_t, (v4u){pw[4], pw[5], pw[6], pw[7]});
#pragma unroll
            for (int db = 0; db < 4; ++db) {
                LAS unsigned char* vp = lds + AT_LV + (4 * fq + q2) * 144 + 32 * db + 8 * p2;
                const bf16x8_t va0 = cat8(lds_tr16(vp), lds_tr16(vp + 16 * 144)), va1 = cat8(lds_tr16(vp + 32 * 144), lds_tr16(vp + 48 * 144));
                oacc[db] = __builtin_amdgcn_mfma_f32_16x16x32_bf16(va0, pf0, oacc[db], 0, 0, 0);
                oacc[db] = __builtin_amdgcn_mfma_f32_16x16x32_bf16(va1, pf1, oacc[db], 0, 0, 0); }
            wdone = __all(!tvalid || carry < -105.f);
        }
        if (lane == 0) ((LAS int*)(lds + AT_FLAG))[wave] = wdone ? 1 : 0;
        __syncthreads();
        k0 -= 64;
        if (k0 < 0) break;
        { const LAS int* fl = (const LAS int*)(lds + AT_FLAG); const int alld = fl[0] & fl[1] & fl[2] & fl[3] & fl[4] & fl[5] & fl[6] & fl[7]; if (alld) break; }
    }
    if (tvalid) { bf16* op = Qb + (rowb + t) * DM + h * 64 + 4 * fq;
#pragma unroll
        for (int db = 0; db < 4; ++db) *(v2u*)(op + 16 * db) = (v2u){pk2(oacc[db][0], oacc[db][1]), pk2(oacc[db][2], oacc[db][3])}; }
    __syncthreads();
}

struct Args {
    const float* in[22]; float* outp; unsigned char* wsp; int ph_lo, ph_hi, coop, pad;
};

__device__ __forceinline__ void norm_row(const float* src, bf16* dst, int lane) {
    v2u* o8 = (v2u*)dst + lane;
    if (!src) {
#pragma unroll
        for (int j = 0; j < 4; ++j) o8[64 * j] = (v2u){0u, 0u};
        return; }
    const f32x4* xr = (const f32x4*)src + lane;
    f32x4 v[4]; float s = 0.f;
#pragma unroll
    for (int j = 0; j < 4; ++j) { v[j] = xr[64 * j]; s += (v[j].x * v[j].x + v[j].y * v[j].y) + (v[j].z * v[j].z + v[j].w * v[j].w); }
    const float rstd = 1.0f / sqrtf(wave_sum(s) * (1.f / DM) + EPS);
#pragma unroll
    for (int j = 0; j < 4; ++j) o8[64 * j] = (v2u){pk2(v[j].x * rstd, v[j].y * rstd), pk2(v[j].z * rstd, v[j].w * rstd)};
}
__device__ __forceinline__ const float* stream_row(int r, int mode, const float* H, const float* x, const float* meta) {
    if (r >= 2 * BS) return nullptr;
    const int b = r >= BS ? 1 : 0, l = r - b * BS - OFF;
    if (l < 0 || l >= LTOK) return nullptr;
    if (mode == 0) return H + (size_t)r * DM;
    return l < NMETA ? meta + (size_t)l * DM : x + ((size_t)b * SEQ + (l - NMETA)) * DM;
}

__device__ __forceinline__ const void* ptab(volatile LAS unsigned* PT, int k) {
    const unsigned lo_ = PT[2 * k], hi_ = PT[2 * k + 1];
    return (const void*)(const __attribute__((address_space(1))) void*)(((unsigned long long)(unsigned)__builtin_amdgcn_readfirstlane((int)hi_) << 32) | (unsigned long long)(unsigned)__builtin_amdgcn_readfirstlane((int)lo_));
}
#define xin ((const float*)ptab(PT, 0))
#define metain ((const float*)ptab(PT, 1))
#define ssd_norm ((const float*)ptab(PT, 2))
#define ssd_w_in ((const float*)ptab(PT, 3))
#define ssd_conv_w ((const float*)ptab(PT, 4))
#define ssd_conv_b ((const float*)ptab(PT, 5))
#define ssd_dt_bias ((const float*)ptab(PT, 6))
#define ssd_a_log ((const float*)ptab(PT, 7))
#define ssd_d_skip ((const float*)ptab(PT, 8))
#define ssd_gate_norm ((const float*)ptab(PT, 9))
#define ssd_w_out ((const float*)ptab(PT, 10))
#define kv_norm ((const float*)ptab(PT, 11))
#define w_kv ((const float*)ptab(PT, 12))
#define sb_norm ((const float*)ptab(PT, 13))
#define sb_w_q ((const float*)ptab(PT, 14))
#define sb_w_o ((const float*)ptab(PT, 15))
#define ffn_norm ((const float*)ptab(PT, 16))
#define ffn_w_up ((const float*)ptab(PT, 17))
#define ffn_conv_w ((const float*)ptab(PT, 18))
#define ffn_conv_b ((const float*)ptab(PT, 19))
#define ffn_w_down ((const float*)ptab(PT, 20))
#define final_norm ((const float*)ptab(PT, 21))
#define ws ((unsigned char*)ptab(PT, 22))
#define Win ((bf16*)(ws + WS_WIN))
#define Wout ((bf16*)(ws + WS_WOUT))
#define Wkvq ((bf16*)(ws + WS_WKVQ))
#define Wo ((bf16*)(ws + WS_WO))
#define Wup0 ((bf16*)(ws + WS_WUP0))
#define Wup1 ((bf16*)(ws + WS_WUP1))
#define Wdn0 ((bf16*)(ws + WS_WDN0))
#define Wdn1 ((bf16*)(ws + WS_WDN1))
#define DT ((float*)(ws + WS_DT))
#define XBC ((bf16*)(ws + WS_XBC))
#define H ((float*)(ws + WS_H))
#define Z ((bf16*)(ws + WS_Z))
#define ACT ((bf16*)(ws + WS_ACT))
#define KB ((bf16*)(ws + WS_K))
#define VB ((bf16*)(ws + WS_V))
#define QB ((bf16*)(ws + WS_Q))
#define XN ((bf16*)ptab(PT, 23))
#define OUTP ((float*)ptab(PT, 23))
__global__ void __launch_bounds__(NTHR, 2) mega(const Args args) {
    extern __shared__ __attribute__((aligned(16))) unsigned char lds_raw[];
    LAS unsigned char* lds = (LAS unsigned char*)lds_raw;
    const int tid = threadIdx.x, lane = tid & 63, wave = __builtin_amdgcn_readfirstlane(tid >> 6);
    const int G = gridDim.x, bx = blockIdx.x;
    const int gw = bx * NWAVES + wave, NGW = G * NWAVES;
    volatile LAS unsigned* PT = (volatile LAS unsigned*)(lds + RING_BYTES + XCH_BYTES);
    if (tid < 24) { const unsigned long long pv = tid < 22 ? (unsigned long long)args.in[tid] : (tid == 22 ? (unsigned long long)args.wsp : (unsigned long long)args.outp); PT[2 * tid] = (unsigned)pv; PT[2 * tid + 1] = (unsigned)(pv >> 32); }
    __syncthreads();
    const int lo = args.ph_lo, hi = args.ph_hi;
#define IN(k) (lo <= (k) && (k) < hi)
#define SEAM(k) do { if (args.coop && IN(k) && IN((k) + 1)) { cg::this_grid().sync(); } } while (0)

    if (IN(0)) {
        LAS float* scr = (LAS float*)(lds + wave * 16384);
        constexpr int I_IN = 16 * (NIN / 32), I_OUT = 32 * 32, I_KVQ = 16 * 96, I_O = 16 * 32, I_UP = 16 * (NUP / 32), I_DN = 44 * 32;
        constexpr int NITEMS = I_IN + I_OUT + I_KVQ + I_O + 2 * I_UP + 2 * I_DN;
        for (int it = gw; it < NITEMS; it += NGW) {
            int r = it;
            if (r < I_IN) { const int nb = r % (NIN / 32), kb = r / (NIN / 32), n0 = nb * 32; transpose_item(ssd_w_in, NIN_REAL, DM, Win, n0, n0 < NIN_REAL ? n0 : -1, kb * 64, ssd_norm, scr, lane); continue; } r -= I_IN;
            if (r < I_OUT) { const int nb = r % 32, kb = r / 32; transpose_item(ssd_w_out, DM, DI, Wout, nb * 32, nb * 32, kb * 64, ssd_gate_norm, scr, lane); continue; } r -= I_OUT;
            if (r < I_KVQ) { const int nb = r % 96, kb = r / 96, n0 = nb * 32;
                if (n0 < 2048) transpose_item(w_kv, 2048, DM, Wkvq, n0, n0, kb * 64, kv_norm, scr, lane); else transpose_item(sb_w_q, DM, DM, Wkvq, n0, n0 - 2048, kb * 64, sb_norm, scr, lane);
                continue; } r -= I_KVQ;
            if (r < I_O) { const int nb = r % 32, kb = r / 32; transpose_item(sb_w_o, DM, DM, Wo, nb * 32, nb * 32, kb * 64, nullptr, scr, lane); continue; } r -= I_O;
            if (r < 2 * I_UP) { const int ly = r / I_UP; r -= ly * I_UP; const int nb = r % (NUP / 32), kb = r / (NUP / 32), n0 = nb * 32;
                const int src = ((n0 >> 7) & 1) * DFF + (n0 >> 8) * 128 + (n0 & 127);
                transpose_item(ffn_w_up + (size_t)ly * DM * NUP, NUP, DM, ly ? Wup1 : Wup0, n0, src, kb * 64, ffn_norm + ly * DM, scr, lane); continue; } r -= 2 * I_UP;
            { const int ly = r / I_DN; r -= ly * I_DN; const int nb = r % 32, kb = r / 32;
              transpose_item(ffn_w_down + (size_t)ly * DFF * DM, DM, DFF, ly ? Wdn1 : Wdn0, nb * 32, nb * 32, kb * 64, nullptr, scr, lane); }
        }
        for (int r = gw; r < MRX; r += NGW) norm_row(stream_row(r, 1, H, xin, metain), XN + (size_t)r * DM, lane);
    }
    SEAM(0);
    if (IN(1)) {
        pg8::Gemm g{XN, Win, 2 * TPB * 256, NIN, DM, 3}; pg8::StaticOrder S; S.init(2 * TPB * 256, NIN, G, bx);
        pg8::EpiInProj E{Z, XBC, DT, ssd_conv_w, ssd_conv_b, ssd_dt_bias};
        pg8::gemm_phase<pg8::EpiInProj, pg8::StaticOrder, true, true>(lds, g, S, E);
    }
    SEAM(1);
    if (IN(2)) {
        bf16* xbc = XBC; const float* dtp = DT; bf16* ST = (bf16*)(ws + WS_ST); float* DEC = (float*)(ws + 4096);
        for (int u = bx; u < NBATCH * 32 * NHS; u += G) { const int h = u % NHS, c = (u / NHS) % 32, b = u / (NHS * 32);
            ssd_unit<1>(lds, b, c, h, xbc, xbc, dtp, ST, DEC, -__expf(ssd_a_log[h]), 0.f, tid); }
        if (args.coop) cg::this_grid().sync();
        { const int gt = bx * NTHR + tid;
          if (gt < NBATCH * NHS * 1024) { const int bh = gt >> 10, e = gt & 1023, b = bh / NHS, h = bh % NHS; float run[8];
#pragma unroll
              for (int k = 0; k < 8; ++k) run[k] = 0.f;
              for (int c = 0; c < 32; ++c) { v4u* sp = (v4u*)(ST + ((size_t)((b * 32 + c) * NHS + h)) * 8192 + e * 8); const v4u w = *sp; const float d = DEC[(b * 32 + c) * NHS + h];
#pragma unroll
                  for (int k = 0; k < 4; ++k) { run[2 * k] = run[2 * k] * d + bf_lo(w[k]); run[2 * k + 1] = run[2 * k + 1] * d + bf_hi(w[k]); }
                  *sp = (v4u){pk2(run[0], run[1]), pk2(run[2], run[3]), pk2(run[4], run[5]), pk2(run[6], run[7])}; } } }
        if (args.coop) cg::this_grid().sync();
        for (int u = bx; u < NBATCH * 33 * NHS; u += G) { const int h = u % NHS, c = (u / NHS) % 33, b = u / (NHS * 33);
            ssd_unit<2>(lds, b, c, h, xbc, xbc, dtp, ST, DEC, -__expf(ssd_a_log[h]), ssd_d_skip[h], tid); }
    }
    SEAM(2);
    if (IN(3)) {
        for (int r = gw; r < 2 * BS; r += NGW) {
            const int b = r >= BS ? 1 : 0, l = r - b * BS - OFF; if (l < 0 || l >= LTOK) continue;
#pragma unroll
            for (int g = 0; g < 4; ++g) {
                const v4u yq = *(const v4u*)(XBC + (size_t)r * CONVD + g * 512 + lane * 8); v4u* zp = (v4u*)(Z + (size_t)r * DI + g * 512 + lane * 8); const v4u zq = *zp;
                float hv[8]; float ss = 0.f;
#pragma unroll
                for (int e = 0; e < 4; ++e) { const float y0 = bf_lo(yq[e]), y1 = bf_hi(yq[e]), z0 = bf_lo(zq[e]), z1 = bf_hi(zq[e]);
                    hv[2 * e] = y0 * pg8::silu_f(z0); hv[2 * e + 1] = y1 * pg8::silu_f(z1); ss += hv[2 * e] * hv[2 * e] + hv[2 * e + 1] * hv[2 * e + 1]; }
                const float rs = 1.0f / sqrtf(wave_sum(ss) * (1.f / 512.f) + EPS);
                *zp = (v4u){pk2(hv[0] * rs, hv[1] * rs), pk2(hv[2] * rs, hv[3] * rs), pk2(hv[4] * rs, hv[5] * rs), pk2(hv[6] * rs, hv[7] * rs)};
            }
        }
    }
    SEAM(3);
    if (IN(4)) {
        pg8::Gemm g{Z, Wout, MR, DM, DI, 0}; pg8::StaticOrder S; S.init(MR, DM, G, bx);
        pg8::EpiResid<1> E{H, xin, metain};
        pg8::gemm_phase<pg8::EpiResid<1>, pg8::StaticOrder, true, true>(lds, g, S, E);
    }
    SEAM(4);
#pragma unroll 1
    for (int ly = 0; ly < 2; ++ly) {
        const int pb = ly == 0 ? 5 : 12;
        if (ly == 1) {
            if (IN(8)) { for (int r = gw; r < MRX; r += NGW) norm_row(stream_row(r, 0, H, xin, metain), XN + (size_t)r * DM, lane); }
            SEAM(8);
            if (IN(9)) {
                pg8::Gemm g{XN, Wkvq, MR, 3072, DM, 0}; pg8::StaticOrder S; S.init(MR, 3072, G, bx);
                pg8::EpiBf16 E{KB, DM, DM, (size_t)(WS_V - WS_K) / 2};
                pg8::gemm_phase<pg8::EpiBf16, pg8::StaticOrder, true, true>(lds, g, S, E);
            }
            SEAM(9);
            if (IN(10)) {
                constexpr int NQB = (LTOK + 127) / 128;
                bf16* qb_ = QB; const bf16* kb_ = KB; const bf16* vb_ = VB;
                for (int u = bx; u < NBATCH * 16 * NQB; u += G) { const int hh = u % 16, qi = (u / 16) % NQB, bb = u / (16 * NQB);
                    attn_unit(lds, bb, hh, qi, qb_, kb_, vb_, tid); }
            }
            SEAM(10);
            if (IN(11)) {
                pg8::Gemm g{QB, Wo, MR, DM, DM, 0}; pg8::StaticOrder S; S.init(MR, DM, G, bx);
                pg8::EpiResid<0> E{H, nullptr, nullptr};
                pg8::gemm_phase<pg8::EpiResid<0>, pg8::StaticOrder, true, true>(lds, g, S, E);
            }
            SEAM(11);
        }
        if (IN(pb)) { for (int r = gw; r < MRX; r += NGW) norm_row(stream_row(r, 0, H, xin, metain), XN + (size_t)r * DM, lane); }
        SEAM(pb);
        if (IN(pb + 1)) {
            pg8::Gemm g{XN, ly ? Wup1 : Wup0, 2 * TPB * 256, NUP, DM, 2}; pg8::StaticOrder S; S.init(2 * TPB * 256, NUP, G, bx);
            pg8::EpiUp E{ACT, ffn_conv_w + (size_t)ly * 3 * NUP, ffn_conv_b + (size_t)ly * NUP};
            pg8::gemm_phase<pg8::EpiUp, pg8::StaticOrder, true, true>(lds, g, S, E);
        }
        SEAM(pb + 1);
        if (IN(pb + 2)) {
            pg8::Gemm g{ACT, ly ? Wdn1 : Wdn0, MR, DM, DFF, 0}; pg8::StaticOrder S; S.init(MR, DM, G, bx);
            pg8::EpiResid<0> E{H, nullptr, nullptr};
            pg8::gemm_phase<pg8::EpiResid<0>, pg8::StaticOrder, true, true>(lds, g, S, E);
        }
        SEAM(pb + 2);
    }
    if (IN(15)) {
        for (int r = gw; r < NBATCH * SEQ; r += NGW) {
            const int b = r / SEQ, t = r % SEQ; const f32x4* xr = (const f32x4*)(H + (size_t)(b * BS + OFF + NMETA + t) * DM) + lane;
            f32x4 v[4]; float s = 0.f;
#pragma unroll
            for (int j = 0; j < 4; ++j) { v[j] = xr[64 * j]; s += (v[j].x * v[j].x + v[j].y * v[j].y) + (v[j].z * v[j].z + v[j].w * v[j].w); }
            const float rstd = 1.0f / sqrtf(wave_sum(s) * (1.f / DM) + EPS);
            f32x4* op = (f32x4*)(OUTP + (size_t)r * DM) + lane; const f32x4* gp = (const f32x4*)final_norm + lane;
#pragma unroll
            for (int j = 0; j < 4; ++j) op[64 * j] = v[j] * rstd * gp[64 * j];
        }
    }
#undef IN
#undef SEAM
}

#undef xin
#undef metain
#undef ssd_norm
#undef ssd_w_in
#undef ssd_conv_w
#undef ssd_conv_b
#undef ssd_dt_bias
#undef ssd_a_log
#undef ssd_d_skip
#undef ssd_gate_norm
#undef ssd_w_out
#undef kv_norm
#undef w_kv
#undef sb_norm
#undef sb_w_q
#undef sb_w_o
#undef ffn_norm
#undef ffn_w_up
#undef ffn_conv_w
#undef ffn_conv_b
#undef ffn_w_down
#undef final_norm
#undef ws
#undef Win
#undef Wout
#undef Wkvq
#undef Wo
#undef Wup0
#undef Wup1
#undef Wdn0
#undef Wdn1
#undef DT
#undef XBC
#undef H
#undef Z
#undef ACT
#undef KB
#undef VB
#undef QB
#undef XN
#undef OUTP
constexpr int NPHASES = 16;
extern "C" void kernel_launch(void* const* d_in, const int* in_sizes, int n_in, void* d_out, int out_size, void* d_ws, size_t ws_size, hipStream_t stream) {
    static int grid = 0;
    if (grid == 0) {
        if (n_in != 22 || ws_size < WS_END || out_size != NBATCH * SEQ * DM) { fprintf(stderr, "kernel_launch: unexpected shapes (n_in %d ws %zu out %d)\n", n_in, ws_size, out_size); grid = -1; return; }
        int dev = 0, cus = 0, per_cu = 0;
        (void)hipGetDevice(&dev); (void)hipDeviceGetAttribute(&cus, hipDeviceAttributeMultiprocessorCount, dev);
        (void)hipFuncSetAttribute((const void*)mega, hipFuncAttributeMaxDynamicSharedMemorySize, LDS_BYTES);
        (void)hipOccupancyMaxActiveBlocksPerMultiprocessor(&per_cu, (const void*)mega, NTHR, LDS_BYTES);
        (void)hipGetLastError();
        if (per_cu < 1) per_cu = 1;
        grid = cus * 1;
    }
    if (grid < 0) return;
    Args a{};
    for (int i = 0; i < 22; ++i) a.in[i] = (const float*)d_in[i];
    a.outp = (float*)d_out; a.wsp = (unsigned char*)d_ws;
#if MK_COOP
    a.ph_lo = 0; a.ph_hi = NPHASES; a.coop = 1;
    void* kargs[] = {&a};
    hipError_t e = hipLaunchCooperativeKernel((const void*)mega, dim3(grid), dim3(NTHR), kargs, LDS_BYTES, stream);
    if (e != hipSuccess) fprintf(stderr, "cooperative launch failed: %s (grid %d)\n", hipGetErrorString(e), grid);
#else
    for (int p = 0; p < NPHASES; ++p) { a.ph_lo = p; a.ph_hi = p + 1; a.coop = 0; hipLaunchKernelGGL(mega, dim3(grid), dim3(NTHR), LDS_BYTES, stream, a); }
#endif
}
```

```cpp
#include <hip/hip_runtime.h>
#include <hip/hip_cooperative_groups.h>
#include <cstdio>
#include <cstdint>
namespace cg = cooperative_groups;

constexpr int DM = 1024, NBATCH = 2, SEQ = 8192, NMETA = 16, LTOK = NMETA + SEQ;
constexpr int BS = 8224, OFF = 16;
constexpr int MR = 65 * 256;
constexpr int MRX = 66 * 256;
constexpr int TPB = 33;
constexpr int DI = 2048, NSTATE = 128, NHS = 32, CONVD = 3072, NIN = 5376, NIN_REAL = 5152;
constexpr int DFF = 2816, NUP = 5632;
constexpr float EPS = 1e-6f;

#ifndef MK_COOP
#define MK_COOP 1
#endif
namespace pg8 {
#define PG8_LAS __attribute__((address_space(3)))
typedef unsigned short bf16_t;
typedef short bf16x8 __attribute__((ext_vector_type(8)));
typedef float f32x4 __attribute__((ext_vector_type(4)));
typedef unsigned u32x4 __attribute__((ext_vector_type(4)));
constexpr int BM = 256, BK = 64, HALF = 128, HTB = HALF * BK * 2  , STAGE_BYTES = 8 * HTB, NXCD = 8, WGM = 8;

__host__ __device__ __forceinline__ int lds_byte(int r, int c) { const int st = (r >> 4) * 2 + (c >> 5), rr = r & 15, cc = c & 31, ob = rr * 64 + cc * 2; return st * 1024 + (ob ^ (((ob >> 9) & 1) << 5)); }
__host__ __device__ __forceinline__ void stage_rc(int b, int& R, int& C) { const int st = b / 1024, sb = b % 1024, swz = sb ^ (((sb >> 9) & 1) << 5); R = (st >> 1) * 16 + swz / 64; C = (st & 1) * 32 + (swz % 64) / 2; }
__host__ __device__ __forceinline__ int perm32(int rho) { const int n = rho >> 4, i = rho & 15; return 8 * (i >> 2) + 4 * n + (i & 3); }

struct Unit { int pm, pn; };
struct Gemm { const bf16_t* A; const bf16_t* Bt; int M, N, K; int halo;
    __device__ __forceinline__ size_t a_off(int pm) const { const int row = halo == 0 ? pm * 256 : (pm / TPB) * BS + OFF - halo + (256 - halo) * (pm % TPB); return (size_t)row * (size_t)K * 2; } };

struct StaticOrder {
    int nM, nN, nwg, G, c;
    __host__ __device__ void init(int M, int N, int G_, int c_) { nM = M / BM; nN = N / BM; nwg = nM * nN; G = G_; c = c_; }
    __host__ __device__ bool next(int i, Unit& u) const {
        const long L = (long)i * G + c; if (L >= nwg) return false;
        int wgid = (int)L; { const int q = nwg / NXCD, r = nwg % NXCD, xcd = wgid % NXCD, off = wgid / NXCD; wgid = (xcd < r ? xcd * (q + 1) : r * (q + 1) + (xcd - r) * q) + off; }
        const int nig = WGM * nN, gid = wgid / nig, fm = gid * WGM, gsz = (nM - fm) < WGM ? (nM - fm) : WGM;
        u.pm = fm + ((wgid % nig) % gsz); u.pn = (wgid % nig) / gsz; return true;
    }
    __device__ __forceinline__ void a_ready(const Unit&) const {}
    __device__ __forceinline__ void done(const Unit&) const {}
};

__device__ __forceinline__ unsigned cvt_pk_bf16(float lo, float hi) { unsigned r; asm volatile("v_cvt_pk_bf16_f32 %0, %1, %2" : "=v"(r) : "v"(lo), "v"(hi)); return r; }
typedef float f32x2 __attribute__((ext_vector_type(2)));
__device__ __forceinline__ float silu_f(float v) { return v * __builtin_amdgcn_rcpf(1.0f + __expf(-v)); }
__device__ __forceinline__ float softplus_f(float v) { return fmaxf(v, 0.f) + log1pf(__expf(-fabsf(v))); }
__device__ __forceinline__ float bflo(unsigned u) { return __uint_as_float(u << 16); }
__device__ __forceinline__ float bfhi(unsigned u) { return __uint_as_float(u & 0xffff0000u); }
typedef unsigned u32x2 __attribute__((ext_vector_type(2)));

struct EpiBf16 {
    static constexpr bool PERM = true, AFTER_DRAIN = false;
    bf16_t* O; int ldc; int split_cols; size_t split_stride;
    __device__ __forceinline__ void operator()(const f32x4 (&acc)[2][2][4][2], const Unit& u, int wr, int wc, int fr, int fq, PG8_LAS unsigned char*) const {
        asm volatile("" : "+v"(fr), "+v"(fq));
        const int row0 = u.pm * BM + wr * 64 + fr; int colt = u.pn * BM; bf16_t* base = O;
        if (split_cols) { const int t = colt / split_cols; base += (size_t)t * split_stride; colt -= t * split_cols; }
        const int col0 = colt + wc * 32 + 8 * fq;
#pragma unroll
        for (int ai = 0; ai < 2; ++ai)
#pragma unroll
            for (int m = 0; m < 4; ++m) { bf16_t* rowp = base + (size_t)(row0 + ai * HALF + m * 16) * ldc + col0;
#pragma unroll
                for (int bj = 0; bj < 2; ++bj) { const f32x4 v0 = acc[ai][bj][m][0], v1 = acc[ai][bj][m][1];
                    u32x4 w; w.x = cvt_pk_bf16(v0[0], v0[1]); w.y = cvt_pk_bf16(v0[2], v0[3]); w.z = cvt_pk_bf16(v1[0], v1[1]); w.w = cvt_pk_bf16(v1[2], v1[3]);
                    *(u32x4*)(rowp + bj * HALF) = w; } }
    }
};

template <int mode> struct EpiResid {
    static constexpr bool PERM = false, AFTER_DRAIN = false;
    float* H; const float* x; const float* meta;
    __device__ __forceinline__ void operator()(const f32x4 (&acc)[2][2][4][2], const Unit& u, int wr, int wc, int fr, int fq, PG8_LAS unsigned char*) const {
        asm volatile("" : "+v"(fr), "+v"(fq));
        const int col0 = u.pn * BM + wc * 32 + 4 * fq;
#pragma unroll
        for (int ai = 0; ai < 2; ++ai)
#pragma unroll
            for (int m = 0; m < 4; ++m) {
                const int r = u.pm * BM + ai * HALF + wr * 64 + m * 16 + fr;
                const int b = r >= BS ? 1 : 0, l = r - b * BS - OFF;
                if (l >= 0 && l < LTOK) {
                    float* hp = H + (size_t)r * DM + col0;
                    const float* bp = mode == 0 ? hp : (l < NMETA ? meta + (size_t)l * DM + col0 : x + ((size_t)b * SEQ + (l - NMETA)) * DM + col0);
#pragma unroll
                    for (int bj = 0; bj < 2; ++bj)
#pragma unroll
                        for (int n = 0; n < 2; ++n) { const f32x4 bs = *(const f32x4*)(bp + bj * HALF + n * 16); *(f32x4*)(hp + bj * HALF + n * 16) = bs + acc[ai][bj][m][n]; }
                }
                asm volatile("" ::: "memory");
            }
    }
};

__device__ __forceinline__ void halo_publish(const f32x4 (&acc)[2][2][4][2], PG8_LAS unsigned char* xl, int wr, int wc, int fr, int fq) {
    PG8_LAS f32x4* X = (PG8_LAS f32x4*)xl; const int wave = wr * 4 + wc;
    if (fr >= 12) {
#pragma unroll
        for (int ai = 0; ai < 2; ++ai)
#pragma unroll
            for (int bj = 0; bj < 2; ++bj)
#pragma unroll
                for (int n = 0; n < 2; ++n) X[(((wave * 2 + ai) * 4 + bj * 2 + n) * 16) + fq * 4 + (fr - 12)] = acc[ai][bj][3][n];
    }
    asm volatile("s_waitcnt lgkmcnt(0)" ::: "memory"); __builtin_amdgcn_s_barrier(); asm volatile("" ::: "memory");
}
__device__ __forceinline__ f32x4 halo_get(PG8_LAS unsigned char* xl, int ai, int bj, int n, int wr, int wc, int fr, int fq) {
    const PG8_LAS f32x4* X = (const PG8_LAS f32x4*)xl; const int pai = wr == 1 ? ai : ai - 1, pw = (wr ^ 1) * 4 + wc;
    f32x4 r = (f32x4){0.f, 0.f, 0.f, 0.f};
    if (fr >= 12 && pai >= 0) r = X[(((pw * 2 + pai) * 4 + bj * 2 + n) * 16) + fq * 4 + (fr - 12)];
    return r;
}

struct EpiInProj {
    static constexpr bool PERM = true, AFTER_DRAIN = false;
    bf16_t* Z; bf16_t* XBC; float* DT; const float* cw; const float* cb; const float* dtb;
    __device__ __forceinline__ void operator()(const f32x4 (&acc)[2][2][4][2], const Unit& u, int wr, int wc, int fr, int fq, PG8_LAS unsigned char* xl) const {
        asm volatile("" : "+v"(fr), "+v"(fq));
        const int pb = u.pm / TPB, pt = u.pm % TPB, l0 = 253 * pt - 3, rowbase = pb * BS + OFF + l0, lane = fq * 16 + fr;
        if (u.pn < 8) {
            const int col0 = u.pn * BM + wc * 32 + 8 * fq;
#pragma unroll
            for (int ai = 0; ai < 2; ++ai)
#pragma unroll
                for (int m = 0; m < 4; ++m) { const int i = ai * HALF + wr * 64 + m * 16 + fr, l = l0 + i;
                    if (i >= 3 && l < LTOK) { bf16_t* rowp = Z + (size_t)(rowbase + i) * DI + col0;
#pragma unroll
                        for (int bj = 0; bj < 2; ++bj) { const f32x4 v0 = acc[ai][bj][m][0], v1 = acc[ai][bj][m][1];
                            u32x4 w; w.x = cvt_pk_bf16(v0[0], v0[1]); w.y = cvt_pk_bf16(v0[2], v0[3]); w.z = cvt_pk_bf16(v1[0], v1[1]); w.w = cvt_pk_bf16(v1[2], v1[3]);
                            *(u32x4*)(rowp + bj * HALF) = w; } } }
        } else if (u.pn < 20) {
            halo_publish(acc, xl, wr, wc, fr, fq);
            const int s1 = (lane & 48) | ((fr - 1) & 15), s2 = (lane & 48) | ((fr - 2) & 15), s3 = (lane & 48) | ((fr - 3) & 15);
#pragma unroll
            for (int bj = 0; bj < 2; ++bj)
#pragma unroll
                for (int n = 0; n < 2; ++n) {
                    const int c0 = (u.pn - 8) * BM + bj * HALF + wc * 32 + 8 * fq + 4 * n;
                    const f32x4 w0 = *(const f32x4*)(cw + c0), w1 = *(const f32x4*)(cw + CONVD + c0), w2 = *(const f32x4*)(cw + 2 * CONVD + c0), w3 = *(const f32x4*)(cw + 3 * CONVD + c0), bb = *(const f32x4*)(cb + c0);
#pragma unroll
                    for (int ai = 0; ai < 2; ++ai)
#pragma unroll
                        for (int m = 0; m < 4; ++m) {
                            const f32x4 cur = acc[ai][bj][m][n];
                            f32x4 prv; if (m > 0) prv = acc[ai][bj][m > 0 ? m - 1 : 0][n]; else prv = halo_get(xl, ai, bj, n, wr, wc, fr, fq);
                            float o[4];
#pragma unroll
                            for (int j = 0; j < 4; ++j) {
                                const float v1 = __shfl(fr >= 15 ? prv[j] : cur[j], s1), v2 = __shfl(fr >= 14 ? prv[j] : cur[j], s2), v3 = __shfl(fr >= 13 ? prv[j] : cur[j], s3);
                                o[j] = silu_f(bb[j] + w3[j] * cur[j] + w2[j] * v1 + w1[j] * v2 + w0[j] * v3);
                            }
                            const int i = ai * HALF + wr * 64 + m * 16 + fr, l = l0 + i;
                            if (i >= 3 && l < LTOK) { u32x2 w; w.x = cvt_pk_bf16(o[0], o[1]); w.y = cvt_pk_bf16(o[2], o[3]); *(u32x2*)(XBC + (size_t)(rowbase + i) * CONVD + c0) = w; }
                        }
                    asm volatile("" ::: "memory");
                }
        } else {
            if (wc == 0) {
#pragma unroll
                for (int n = 0; n < 2; ++n) { const int c0 = 8 * fq + 4 * n; const f32x4 bb = *(const f32x4*)(dtb + c0);
#pragma unroll
                    for (int ai = 0; ai < 2; ++ai)
#pragma unroll
                        for (int m = 0; m < 4; ++m) { const int i = ai * HALF + wr * 64 + m * 16 + fr, l = l0 + i; const f32x4 v = acc[ai][0][m][n] + bb;
                            if (i >= 3 && l < LTOK) *(f32x4*)(DT + (size_t)(rowbase + i) * NHS + c0) = (f32x4){softplus_f(v[0]), softplus_f(v[1]), softplus_f(v[2]), softplus_f(v[3])}; } }
            }
        }
    }
};

struct EpiUp {
    static constexpr bool PERM = true, AFTER_DRAIN = false;
    bf16_t* ACT; const float* cw; const float* cb;
    __device__ __forceinline__ void operator()(const f32x4 (&acc)[2][2][4][2], const Unit& u, int wr, int wc, int fr, int fq, PG8_LAS unsigned char* xl) const {
        asm volatile("" : "+v"(fr), "+v"(fq));
        const int pb = u.pm / TPB, pt = u.pm % TPB, l0 = 254 * pt - 2, rowbase = pb * BS + OFF + l0, lane = fq * 16 + fr;
        halo_publish(acc, xl, wr, wc, fr, fq);
        const int s1 = (lane & 48) | ((fr - 1) & 15), s2 = (lane & 48) | ((fr - 2) & 15);
#pragma unroll
        for (int n = 0; n < 2; ++n) {
            const int c0 = u.pn * HALF + wc * 32 + 8 * fq + 4 * n;
            const f32x4 g0 = *(const f32x4*)(cw + c0), g1 = *(const f32x4*)(cw + NUP + c0), g2 = *(const f32x4*)(cw + 2 * NUP + c0), gb = *(const f32x4*)(cb + c0);
            const f32x4 h0 = *(const f32x4*)(cw + DFF + c0), h1 = *(const f32x4*)(cw + NUP + DFF + c0), h2 = *(const f32x4*)(cw + 2 * NUP + DFF + c0), hb = *(const f32x4*)(cb + DFF + c0);
#pragma unroll
            for (int ai = 0; ai < 2; ++ai)
#pragma unroll
                for (int m = 0; m < 4; ++m) {
                    const f32x4 cg = acc[ai][0][m][n], cv = acc[ai][1][m][n];
                    f32x4 pg, pv; if (m > 0) { pg = acc[ai][0][m > 0 ? m - 1 : 0][n]; pv = acc[ai][1][m > 0 ? m - 1 : 0][n]; } else { pg = halo_get(xl, ai, 0, n, wr, wc, fr, fq); pv = halo_get(xl, ai, 1, n, wr, wc, fr, fq); }
                    float o[4];
#pragma unroll
                    for (int j = 0; j < 4; ++j) {
                        const float a1 = __shfl(fr >= 15 ? pg[j] : cg[j], s1), a2 = __shfl(fr >= 14 ? pg[j] : cg[j], s2);
                        const float b1 = __shfl(fr >= 15 ? pv[j] : cv[j], s1), b2 = __shfl(fr >= 14 ? pv[j] : cv[j], s2);
                        const float gg = gb[j] + g2[j] * cg[j] + g1[j] * a1 + g0[j] * a2, vv = hb[j] + h2[j] * cv[j] + h1[j] * b1 + h0[j] * b2;
                        o[j] = silu_f(gg) * vv;
                    }
                    const int i = ai * HALF + wr * 64 + m * 16 + fr, l = l0 + i;
                    if (i >= 2 && l < LTOK) { u32x2 w; w.x = cvt_pk_bf16(o[0], o[1]); w.y = cvt_pk_bf16(o[2], o[3]); *(u32x2*)(ACT + (size_t)(rowbase + i) * DFF + c0) = w; }
                }
            asm volatile("" ::: "memory");
        }
    }
};

template <class Epi, class Sched, bool ALIGN_EPI = false, bool SP2 = false>
__device__ __forceinline__ void gemm_phase(PG8_LAS unsigned char* lds, const Gemm g, const Sched& S, const Epi& E) {
    const int tid = threadIdx.x, wid = __builtin_amdgcn_readfirstlane(tid >> 6), lane = tid & 63, wr = wid >> 2, wc = wid & 3, fr = lane & 15, fq = lane >> 4;
    const int K = g.K, nt = K / BK;
    unsigned voffA[2], voffB[2];
#pragma unroll
    for (int i = 0; i < 2; ++i) { int R, C; stage_rc(tid * 16 + i * 8192, R, C); const int Rb = Epi::PERM ? ((R & ~31) + perm32(R & 31)) : R;
        voffA[i] = (unsigned)(R * K + C) * 2u; voffB[i] = (unsigned)(Rb * K + C) * 2u; }
    const size_t kstep = (size_t)(BK * 2);
    const size_t hstep = (size_t)HALF * K * 2;
    const size_t tstep = 2 * hstep;
    const unsigned ldsw = (unsigned)wid * 1024u;
    const int aoff = lds_byte(wr * 64 + fr, fq * 8), boff = lds_byte(wc * 32 + fr, fq * 8);
#define PG8_SA(b, h) (((b) * 2 + (h)) * HTB)
#define PG8_SB(b, h) ((4 + (b) * 2 + (h)) * HTB)
#define PG8_STAGE(bufoff, gbase, voff) do { _Pragma("unroll") for (int _i = 0; _i < 2; ++_i) \
        __builtin_amdgcn_global_load_lds((const unsigned*)((const char*)(gbase) + (voff)[_i]), (PG8_LAS unsigned*)(lds + (bufoff) + ldsw + _i * 8192), 16, 0, 0); } while (0)
#define PG8_LDA(dst, b, h) do { _Pragma("unroll") for (int m = 0; m < 4; ++m) _Pragma("unroll") for (int k = 0; k < 2; ++k) dst[m][k] = *(const PG8_LAS bf16x8*)(lds + PG8_SA(b, h) + aoff + m * 2048 + k * 1024); } while (0)
#define PG8_LDB(dst, b, h) do { _Pragma("unroll") for (int n = 0; n < 2; ++n) _Pragma("unroll") for (int k = 0; k < 2; ++k) dst[n][k] = *(const PG8_LAS bf16x8*)(lds + PG8_SB(b, h) + boff + n * 2048 + k * 1024); } while (0)
#define PG8_MMA(ai, bj, At, Bt) do { __builtin_amdgcn_s_setprio(1); _Pragma("unroll") for (int m = 0; m < 4; ++m) _Pragma("unroll") for (int n = 0; n < 2; ++n) _Pragma("unroll") for (int k = 0; k < 2; ++k) \
        acc[ai][bj][m][n] = __builtin_amdgcn_mfma_f32_16x16x32_bf16(Bt[n][k], At[m][k], acc[ai][bj][m][n], 0, 0, 0); __builtin_amdgcn_s_setprio(0); } while (0)
#define PG8_WAIT_V(n) asm volatile("s_waitcnt vmcnt(" #n ")" ::: "memory")
#define PG8_WAIT_L(n) asm volatile("s_waitcnt lgkmcnt(" #n ")" ::: "memory")
#define PG8_BAR __builtin_amdgcn_s_barrier()
#define PG8_SCHED __builtin_amdgcn_sched_barrier(0)
    Unit cur, nxt; int ui = 0;
    if (!S.next(0, cur)) return;
    f32x4 acc[2][2][4][2];
#pragma unroll
    for (int a = 0; a < 2; ++a)
#pragma unroll
        for (int b = 0; b < 2; ++b)
#pragma unroll
            for (int m = 0; m < 4; ++m)
#pragma unroll
                for (int n = 0; n < 2; ++n) acc[a][b][m][n] = (f32x4){0.f, 0.f, 0.f, 0.f};
    bf16x8 At[4][2], B0[2][2], B1[2][2];
    const char* cA = (const char*)g.A + g.a_off(cur.pm); const char* cB = (const char*)g.Bt + (size_t)cur.pn * tstep;
    S.a_ready(cur);
    if constexpr (SP2) {
        PG8_STAGE(PG8_SB(0, 0), cB, voffB); PG8_STAGE(PG8_SB(0, 1), cB + hstep, voffB); PG8_STAGE(PG8_SA(0, 0), cA, voffA); PG8_STAGE(PG8_SA(0, 1), cA + hstep, voffA);
        if (wr == 1) PG8_BAR;
        PG8_WAIT_V(2); PG8_BAR;
        PG8_STAGE(PG8_SB(1, 0), cB + kstep, voffB); PG8_STAGE(PG8_SA(1, 0), cA + kstep, voffA); PG8_STAGE(PG8_SB(1, 1), cB + hstep + kstep, voffB);
        PG8_WAIT_V(6); PG8_BAR;
    } else {
        PG8_STAGE(PG8_SB(0, 0), cB, voffB); PG8_STAGE(PG8_SA(0, 0), cA, voffA); PG8_STAGE(PG8_SB(0, 1), cB + hstep, voffB); PG8_STAGE(PG8_SA(0, 1), cA + hstep, voffA);
        if (wr == 1) PG8_BAR;
        PG8_WAIT_V(4); PG8_BAR;
        PG8_STAGE(PG8_SB(1, 0), cB + kstep, voffB); PG8_STAGE(PG8_SA(1, 0), cA + kstep, voffA); PG8_STAGE(PG8_SB(1, 1), cB + hstep + kstep, voffB);
        PG8_WAIT_V(6); PG8_BAR;
    }
    for (;;) {
        const bool has_next = S.next(ui + 1, nxt);
        const char* nA = has_next ? (const char*)g.A + g.a_off(nxt.pm) : cA; const char* nB = has_next ? (const char*)g.Bt + (size_t)nxt.pn * tstep : cB;
        for (int t = 0; t < nt; t += 2) {
            const bool last = (t == nt - 2);
            const char* a1 = cA + (size_t)(t + 1) * kstep;
            const char* a2 = last ? nA : cA + (size_t)(t + 2) * kstep; const char* b2 = last ? nB : cB + (size_t)(t + 2) * kstep;
            const char* a3 = a2 + kstep; const char* b3 = b2 + kstep;
            if (last && has_next) S.a_ready(nxt);
            if constexpr (SP2) {
            PG8_LDB(B0, 0, 0); PG8_LDB(B1, 0, 1); PG8_SCHED; PG8_LDA(At, 0, 0); PG8_STAGE(PG8_SA(1, 1), a1 + hstep, voffA);
            PG8_WAIT_V(8); PG8_WAIT_L(0); PG8_BAR; PG8_MMA(0, 0, At, B0); PG8_MMA(0, 1, At, B1); PG8_BAR; PG8_SCHED;
            PG8_LDA(At, 0, 1); PG8_STAGE(PG8_SB(0, 0), b2, voffB); PG8_STAGE(PG8_SB(0, 1), b2 + hstep, voffB); PG8_STAGE(PG8_SA(0, 0), a2, voffA);
            PG8_WAIT_V(8); PG8_WAIT_L(0); PG8_BAR; PG8_MMA(1, 0, At, B0); PG8_MMA(1, 1, At, B1); PG8_BAR; PG8_SCHED;
            PG8_LDB(B0, 1, 0); PG8_LDB(B1, 1, 1); PG8_SCHED; PG8_LDA(At, 1, 0); PG8_STAGE(PG8_SA(0, 1), a2 + hstep, voffA);
            PG8_WAIT_V(8); PG8_WAIT_L(0); PG8_BAR; PG8_MMA(0, 0, At, B0); PG8_MMA(0, 1, At, B1); PG8_BAR; PG8_SCHED;
            PG8_LDA(At, 1, 1); PG8_STAGE(PG8_SB(1, 0), b3, voffB); PG8_STAGE(PG8_SB(1, 1), b3 + hstep, voffB); PG8_STAGE(PG8_SA(1, 0), a3, voffA);
            PG8_WAIT_V(8); PG8_WAIT_L(0); PG8_BAR; PG8_MMA(1, 0, At, B0); PG8_MMA(1, 1, At, B1); PG8_BAR; PG8_SCHED;
            } else {
            PG8_LDB(B0, 0, 0); PG8_SCHED; PG8_LDA(At, 0, 0); PG8_STAGE(PG8_SA(1, 1), a1 + hstep, voffA);
            PG8_WAIT_L(8); PG8_BAR; PG8_WAIT_L(0); PG8_MMA(0, 0, At, B0); PG8_BAR; PG8_SCHED;
            PG8_LDB(B1, 0, 1); PG8_STAGE(PG8_SB(0, 0), b2, voffB);
            PG8_BAR; PG8_WAIT_L(0); PG8_MMA(0, 1, At, B1); PG8_BAR;
            PG8_LDA(At, 0, 1); PG8_STAGE(PG8_SA(0, 0), a2, voffA);
            PG8_BAR; PG8_WAIT_L(0); PG8_MMA(1, 0, At, B0); PG8_BAR; PG8_SCHED;
            PG8_STAGE(PG8_SB(0, 1), b2 + hstep, voffB);
            PG8_WAIT_V(6); PG8_BAR; PG8_MMA(1, 1, At, B1); PG8_BAR;
            PG8_LDB(B0, 1, 0); PG8_SCHED; PG8_LDA(At, 1, 0); PG8_STAGE(PG8_SA(0, 1), a2 + hstep, voffA);
            PG8_WAIT_L(8); PG8_BAR; PG8_WAIT_L(0); PG8_MMA(0, 0, At, B0); PG8_BAR; PG8_SCHED;
            PG8_LDB(B1, 1, 1); PG8_STAGE(PG8_SB(1, 0), b3, voffB);
            PG8_BAR; PG8_WAIT_L(0); PG8_MMA(0, 1, At, B1); PG8_BAR;
            PG8_LDA(At, 1, 1); PG8_STAGE(PG8_SA(1, 0), a3, voffA);
            PG8_BAR; PG8_WAIT_L(0); PG8_MMA(1, 0, At, B0); PG8_BAR; PG8_SCHED;
            PG8_STAGE(PG8_SB(1, 1), b3 + hstep, voffB);
            PG8_WAIT_V(6); PG8_BAR; PG8_MMA(1, 1, At, B1); PG8_BAR;
            }
        }
        if constexpr (ALIGN_EPI) { if (wr == 0) PG8_BAR; }
        if constexpr (!Epi::AFTER_DRAIN) { E(acc, cur, wr, wc, fr, fq, lds + STAGE_BYTES); S.done(cur); }
        if (!has_next) break;
#pragma unroll
        for (int a = 0; a < 2; ++a)
#pragma unroll
            for (int b = 0; b < 2; ++b)
#pragma unroll
                for (int m = 0; m < 4; ++m)
#pragma unroll
                    for (int n = 0; n < 2; ++n) acc[a][b][m][n] = (f32x4){0.f, 0.f, 0.f, 0.f};
        cur = nxt; cA = nA; cB = nB; ++ui;
        if constexpr (ALIGN_EPI) { if (wr == 1) PG8_BAR; }
    }
    PG8_WAIT_V(0);
    if constexpr (!ALIGN_EPI) { if (wr == 0) PG8_BAR; }
    PG8_BAR;

#undef PG8_SA
#undef PG8_SB
#undef PG8_STAGE
#undef PG8_LDA
#undef PG8_LDB
#undef PG8_MMA
#undef PG8_WAIT_V
#undef PG8_WAIT_L
#undef PG8_BAR
#undef PG8_SCHED
}
}

#define LAS __attribute__((address_space(3)))
typedef unsigned short bf16;
typedef unsigned v4u __attribute__((ext_vector_type(4)));
typedef unsigned v2u __attribute__((ext_vector_type(2)));
typedef float f32x4 __attribute__((ext_vector_type(4)));
constexpr int NWAVES = 8, NTHR = 512;
constexpr int RING_BYTES = 131072, XCH_BYTES = 16384, LDS_BYTES = RING_BYTES + XCH_BYTES + 1024;

constexpr size_t MiB = 1u << 20;
constexpr size_t SZ_WIN = (size_t)NIN * DM * 2, SZ_WOUT = (size_t)DM * DI * 2, SZ_WKVQ = (size_t)3072 * DM * 2, SZ_WO = (size_t)DM * DM * 2, SZ_WUP = (size_t)NUP * DM * 2, SZ_WDN = (size_t)DM * DFF * 2;
constexpr size_t WS_WIN = 1 * MiB, WS_WOUT = WS_WIN + SZ_WIN, WS_WKVQ = WS_WOUT + SZ_WOUT, WS_WO = WS_WKVQ + SZ_WKVQ, WS_WUP0 = WS_WO + SZ_WO, WS_WUP1 = WS_WUP0 + SZ_WUP, WS_WDN0 = WS_WUP1 + SZ_WUP, WS_WDN1 = WS_WDN0 + SZ_WDN, WS_WEND = WS_WDN1 + SZ_WDN;
constexpr size_t WS_DT = 57 * MiB;
constexpr size_t WS_XBC = 60 * MiB;
constexpr size_t WS_H = WS_XBC;
constexpr size_t WS_Z = 158 * MiB;
constexpr size_t WS_ST = 223 * MiB;
constexpr size_t WS_ACT = 126 * MiB;
constexpr size_t WS_K = 126 * MiB, WS_V = 159 * MiB, WS_Q = 192 * MiB;
constexpr size_t WS_END = 256 * MiB;
static_assert(WS_WEND <= WS_DT && WS_DT + (size_t)MR * 32 * 4 <= WS_XBC && WS_XBC + (size_t)MR * CONVD * 2 <= WS_Z && WS_Z + (size_t)MR * DI * 2 <= WS_ST, "ws map 1");
static_assert(WS_H + (size_t)MR * DM * 4 <= WS_ACT && WS_ACT + (size_t)MR * DFF * 2 <= WS_END && WS_K + (size_t)MR * DM * 2 <= WS_V && WS_V + (size_t)MR * DM * 2 <= WS_Q && WS_Q + (size_t)MR * DM * 2 <= WS_END, "ws map 2");

__device__ __forceinline__ unsigned f2bf(float f) { unsigned u = __builtin_bit_cast(unsigned, f); return (u + 0x7fffu + ((u >> 16) & 1u)) >> 16; }
__device__ __forceinline__ unsigned pk2(float lo, float hi) { return f2bf(lo) | (f2bf(hi) << 16); }
__device__ __forceinline__ float wave_sum(float v) {
#pragma unroll
    for (int o = 1; o < 64; o <<= 1) v += __shfl_xor(v, o);
    return v;
}
__device__ __forceinline__ float bf_lo(unsigned u) { return __uint_as_float(u << 16); }
__device__ __forceinline__ float bf_hi(unsigned u) { return __uint_as_float(u & 0xffff0000u); }

__device__ __forceinline__ void transpose_item(const float* W, int pitch, int K, bf16* WT, int nrow0, int srccol0, int k0, const float* gain, LAS float* scr, int lane) {
#pragma unroll 8
    for (int i = 0; i < 32; ++i) { const int kk = 2 * i + (lane >> 5); float v = 0.f;
        if (srccol0 >= 0) { v = W[(size_t)(k0 + kk) * pitch + srccol0 + (lane & 31)]; if (gain) v *= gain[k0 + kk]; }
        scr[kk * 33 + (lane & 31)] = v; }
    asm volatile("s_waitcnt lgkmcnt(0)" ::: "memory");
    const int c = lane & 7;
#pragma unroll
    for (int j = 0; j < 4; ++j) { const int n = (lane >> 3) + 8 * j; const LAS float* s = scr + (8 * c) * 33 + n;
        v4u o; o.x = pk2(s[0 * 33], s[1 * 33]); o.y = pk2(s[2 * 33], s[3 * 33]); o.z = pk2(s[4 * 33], s[5 * 33]); o.w = pk2(s[6 * 33], s[7 * 33]);
        *(v4u*)(WT + (size_t)(nrow0 + n) * K + k0 + 8 * c) = o; }
    asm volatile("s_waitcnt lgkmcnt(0)" ::: "memory");
}

constexpr int SB_LB = 0, SB_LC = 17408, SB_LX = 34816, SB_LXW = 44032, SB_LST = 53248, SB_LDT = 70656, SB_LACS = 70912;
typedef short bf16x8_t __attribute__((ext_vector_type(8)));
typedef short s16x4_t __attribute__((ext_vector_type(4)));
__device__ __forceinline__ s16x4_t lds_tr16(LAS unsigned char* p) { return __builtin_bit_cast(s16x4_t, __builtin_amdgcn_ds_read_tr16_b64_v4i16((LAS s16x4_t*)p)); }
__device__ __forceinline__ bf16x8_t cat8(s16x4_t a, s16x4_t b) { return (bf16x8_t){a[0], a[1], a[2], a[3], b[0], b[1], b[2], b[3]}; }

template <int PASS> __device__ __forceinline__ void ssd_unit(LAS unsigned char* lds, int b, int c, int h, const bf16* xbc_c, bf16* xbc_w, const float* dtp, bf16* ST, float* DEC, float a, float dsk, int tid) {
    const int lane = tid & 63, wave = __builtin_amdgcn_readfirstlane(tid >> 6), fr = lane & 15, fq = lane >> 4, q2 = fr >> 2, p2 = lane & 3, g = h >> 3;
    const int lbase = 256 * c, nvalid = (LTOK - lbase) < 256 ? (LTOK - lbase) : 256, nsub = (nvalid + 63) >> 6;
    const size_t rowb = (size_t)b * BS + OFF;
    f32x4 ast[4];
#pragma unroll
    for (int pb = 0; pb < 4; ++pb) ast[pb] = (f32x4){0.f, 0.f, 0.f, 0.f};
    if (PASS == 2 && c > 0) {
        const bf16* sp = ST + ((size_t)((b * 32 + (c - 1)) * NHS + h)) * 8192;
#pragma unroll
        for (int pb = 0; pb < 4; ++pb) { const v2u w = *(const v2u*)(sp + (16 * pb + fr) * 128 + 16 * wave + 4 * fq); ast[pb] = (f32x4){bf_lo(w.x), bf_hi(w.x), bf_lo(w.y), bf_hi(w.y)}; }
    }
    float totlog = 0.f;
    v4u gB[2], gC[2], gX; float gdt;
    auto prefetch = [&](int j) {
        const int l0 = lbase + 64 * j;
#pragma unroll
        for (int k = 0; k < 2; ++k) { const int idx = tid + 512 * k, row = idx >> 4, ch = idx & 15; int l = l0 + row; l = l < LTOK ? l : LTOK - 1;
            const bf16* rp = xbc_c + (rowb + l) * CONVD + DI + g * 128 + ch * 8; gB[k] = *(const v4u*)rp; if (PASS == 2) gC[k] = *(const v4u*)(rp + 512); }
        { const int row = tid >> 3, ch = tid & 7; int l = l0 + row; l = l < LTOK ? l : LTOK - 1; gX = *(const v4u*)(xbc_c + (rowb + l) * CONVD + h * 64 + ch * 8); }
        { const int l = l0 + lane; gdt = l < LTOK ? dtp[(rowb + l) * NHS + h] : 0.f; }
    };
    prefetch(0);
    for (int j = 0; j < nsub; ++j) {
        float acs = gdt * a;
#pragma unroll
        for (int o = 1; o < 64; o <<= 1) { const float t = __shfl_up(acs, o); if (lane >= o) acs += t; }
        const float aend = __shfl(acs, 63);
        const float wrow = gdt * __expf(aend - acs);
        if (wave == 0) { ((LAS float*)(lds + SB_LDT))[lane] = gdt; ((LAS float*)(lds + SB_LACS))[lane] = acs; }
#pragma unroll
        for (int k = 0; k < 2; ++k) { const int idx = tid + 512 * k, row = idx >> 4, ch = idx & 15; *(LAS v4u*)(lds + SB_LB + row * 272 + ch * 16) = gB[k]; if (PASS == 2) *(LAS v4u*)(lds + SB_LC + row * 272 + ch * 16) = gC[k]; }
        { const int row = tid >> 3, ch = tid & 7; const float wv = __shfl(wrow, row & 63);
          if (PASS == 2) *(LAS v4u*)(lds + SB_LX + row * 144 + ch * 16) = gX;
          v4u xw;
#pragma unroll
          for (int e = 0; e < 4; ++e) xw[e] = pk2(bf_lo(gX[e]) * wv, bf_hi(gX[e]) * wv);
          *(LAS v4u*)(lds + SB_LXW + row * 144 + ch * 16) = xw; }
        if (PASS == 2) {
#pragma unroll
            for (int pb = 0; pb < 4; ++pb) *(LAS v2u*)(lds + SB_LST + (16 * pb + fr) * 272 + (16 * wave + 4 * fq) * 2) = (v2u){pk2(ast[pb][0], ast[pb][1]), pk2(ast[pb][2], ast[pb][3])};
        }
        __syncthreads();
        if (j + 1 < nsub) prefetch(j + 1);
        totlog += aend;
        if (PASS == 2) {
            const int ib = wave >> 1;
            bf16x8_t cf[4];
#pragma unroll
            for (int ks = 0; ks < 4; ++ks) cf[ks] = *(const LAS bf16x8_t*)(lds + SB_LC + (16 * ib + fr) * 272 + (32 * ks + 8 * fq) * 2);
            const float acs_i = ((const LAS float*)(lds + SB_LACS))[16 * ib + fr];
            const int irow = 16 * ib + fr;
            bf16x8_t pf[2];
#pragma unroll
            for (int kk = 0; kk < 2; ++kk) {
                unsigned pw[4];
#pragma unroll
                for (int hf = 0; hf < 2; ++hf) { const int sb = 2 * kk + hf;
                    if (sb <= ib) {
                        f32x4 d = (f32x4){0.f, 0.f, 0.f, 0.f};
#pragma unroll
                        for (int ks = 0; ks < 4; ++ks) { const bf16x8_t af = *(const LAS bf16x8_t*)(lds + SB_LB + (16 * sb + fr) * 272 + (32 * ks + 8 * fq) * 2); d = __builtin_amdgcn_mfma_f32_16x16x32_bf16(af, cf[ks], d, 0, 0, 0); }
                        const f32x4 as4 = *(const LAS f32x4*)(lds + SB_LACS + (16 * sb + 4 * fq) * 4), dt4 = *(const LAS f32x4*)(lds + SB_LDT + (16 * sb + 4 * fq) * 4);
                        float v[4];
#pragma unroll
                        for (int r = 0; r < 4; ++r) { const int s = 16 * sb + 4 * fq + r; const float e = __expf(fminf(acs_i - as4[r], 0.f)); v[r] = s <= irow ? d[r] * dt4[r] * e : 0.f; }
                        pw[2 * hf] = pk2(v[0], v[1]); pw[2 * hf + 1] = pk2(v[2], v[3]);
                    } else { pw[2 * hf] = 0u; pw[2 * hf + 1] = 0u; }
                }
                pf[kk] = __builtin_bit_cast(bf16x8_t, (v4u){pw[0], pw[1], pw[2], pw[3]});
            }
            const float ei = __expf(acs_i);
            const int l_row = lbase + 64 * j + irow;
#pragma unroll
            for (int pbi = 0; pbi < 2; ++pbi) { const int pb = 2 * (wave & 1) + pbi;
                f32x4 acc = (f32x4){0.f, 0.f, 0.f, 0.f};
#pragma unroll
                for (int ks = 0; ks < 4; ++ks) { const bf16x8_t af = *(const LAS bf16x8_t*)(lds + SB_LST + (16 * pb + fr) * 272 + (32 * ks + 8 * fq) * 2); acc = __builtin_amdgcn_mfma_f32_16x16x32_bf16(af, cf[ks], acc, 0, 0, 0); }
                acc = acc * ei;
#pragma unroll
                for (int kk = 0; kk < 2; ++kk) if (2 * kk <= ib) {
                    LAS unsigned char* xp = lds + SB_LX + (32 * kk + 4 * fq + q2) * 144 + 32 * pb + 8 * p2;
                    const bf16x8_t xa = cat8(lds_tr16(xp), lds_tr16(xp + 16 * 144));
                    acc = __builtin_amdgcn_mfma_f32_16x16x32_bf16(xa, pf[kk], acc, 0, 0, 0); }
                const v2u xw = *(const LAS v2u*)(lds + SB_LX + irow * 144 + (16 * pb + 4 * fq) * 2);
                const float y0 = acc[0] + dsk * bf_lo(xw.x), y1 = acc[1] + dsk * bf_hi(xw.x), y2 = acc[2] + dsk * bf_lo(xw.y), y3 = acc[3] + dsk * bf_hi(xw.y);
                if (l_row < LTOK) *(v2u*)(xbc_w + (rowb + l_row) * CONVD + h * 64 + 16 * pb + 4 * fq) = (v2u){pk2(y0, y1), pk2(y2, y3)};
            }
        }
        { const float ed = __expf(aend);
#pragma unroll
          for (int pb = 0; pb < 4; ++pb) ast[pb] = ast[pb] * ed;
#pragma unroll
          for (int kk = 0; kk < 2; ++kk) {
              LAS unsigned char* bp = lds + SB_LB + (32 * kk + 8 * fq + q2) * 272 + 32 * wave + 8 * p2;
              const bf16x8_t af = cat8(lds_tr16(bp), lds_tr16(bp + 4 * 272));
#pragma unroll
              for (int pb = 0; pb < 4; ++pb) { LAS unsigned char* xp = lds + SB_LXW + (32 * kk + 8 * fq + q2) * 144 + 32 * pb + 8 * p2;
                  const bf16x8_t bfg = cat8(lds_tr16(xp), lds_tr16(xp + 4 * 144));
                  ast[pb] = __builtin_amdgcn_mfma_f32_16x16x32_bf16(af, bfg, ast[pb], 0, 0, 0); } } }
        __syncthreads();
    }
    if (PASS == 1) {
        bf16* sp = ST + ((size_t)((b * 32 + c) * NHS + h)) * 8192;
#pragma unroll
        for (int pb = 0; pb < 4; ++pb) *(v2u*)(sp + (16 * pb + fr) * 128 + 16 * wave + 4 * fq) = (v2u){pk2(ast[pb][0], ast[pb][1]), pk2(ast[pb][2], ast[pb][3])};
        if (tid == 0) DEC[(b * 32 + c) * NHS + h] = __expf(totlog);
    }
}

constexpr int AT_LK = 0, AT_LV = 9216, AT_FLAG = 18432;
__device__ __forceinline__ void attn_unit(LAS unsigned char* lds, int b, int h, int qb, bf16* Qb, const bf16* Kb, const bf16* Vb, int tid) {
    const int lane = tid & 63, wave = __builtin_amdgcn_readfirstlane(tid >> 6), fr = lane & 15, fq = lane >> 4, q2 = fr >> 2, p2 = lane & 3;
    const int t0 = 128 * qb, tw = t0 + 16 * wave, t = tw + fr;
    const size_t rowb = (size_t)b * BS + OFF;
    const bool tvalid = t < LTOK;
    bf16x8_t qf[2];
    { const bf16* qp = Qb + (rowb + (tvalid ? t : LTOK - 1)) * DM + h * 64 + 8 * fq; qf[0] = *(const bf16x8_t*)qp; qf[1] = *(const bf16x8_t*)(qp + 32); }
    f32x4 oacc[4];
#pragma unroll
    for (int db = 0; db < 4; ++db) oacc[db] = (f32x4){0.f, 0.f, 0.f, 0.f};
    float carry = 0.f;
    bool wdone = !__any(tvalid);
    const int srow = tid >> 3, sch = tid & 7;
    int k0 = t0 + 64; if (k0 >= LTOK) k0 = t0;
    v4u gK, gV;
    { int s = k0 + srow; s = s < LTOK ? s : LTOK - 1; const size_t off = (rowb + s) * DM + h * 64 + sch * 8; gK = *(const v4u*)(Kb + off); gV = *(const v4u*)(Vb + off); }
    for (;;) {
        *(LAS v4u*)(lds + AT_LK + srow * 144 + sch * 16) = gK; *(LAS v4u*)(lds + AT_LV + srow * 144 + sch * 16) = gV;
        __syncthreads();
        if (k0 >= 64) { const size_t off = (rowb + (k0 - 64) + srow) * DM + h * 64 + sch * 8; gK = *(const v4u*)(Kb + off); gV = *(const v4u*)(Vb + off); }
        if (!wdone && k0 <= tw + 14) {
            f32x4 st[4];
#pragma unroll
            for (int sb = 0; sb < 4; ++sb) { f32x4 d = (f32x4){0.f, 0.f, 0.f, 0.f};
#pragma unroll
                for (int ks = 0; ks < 2; ++ks) { const bf16x8_t kf = *(const LAS bf16x8_t*)(lds + AT_LK + (16 * sb + fr) * 144 + (32 * ks + 8 * fq) * 2); d = __builtin_amdgcn_mfma_f32_16x16x32_bf16(kf, qf[ks], d, 0, 0, 0); }
                st[sb] = d; }
            float lsp[4][4], lk[4][4], ps[4];
#pragma unroll
            for (int sb = 0; sb < 4; ++sb) { ps[sb] = 0.f;
#pragma unroll
                for (int r = 0; r < 4; ++r) { const int s = k0 + 16 * sb + 4 * fq + r; const bool vis = tvalid && s < t; const float x = st[sb][r] * 0.125f;
                    const float l1 = fminf(x, 0.f) - __logf(1.0f + __expf(-fabsf(x)));
                    lsp[sb][r] = vis ? l1 : -1e30f; lk[sb][r] = vis ? l1 - x : 0.f; ps[sb] += lk[sb][r]; } }
            float run = carry;
            unsigned pw[8];
#pragma unroll
            for (int sb = 3; sb >= 0; --sb) {
                const float a = ps[sb], bq = __shfl_xor(a, 16), cq = __shfl_xor(a, 32), dq = __shfl_xor(bq, 32);
                const float sfq = ((fq & 1) == 0 ? bq : 0.f) + ((fq & 2) == 0 ? cq + dq : 0.f);
                float lat = run + sfq; float wv[4];
#pragma unroll
                for (int r = 3; r >= 0; --r) { wv[r] = __expf(lsp[sb][r] + lat); lat += lk[sb][r]; }
                pw[2 * sb] = pk2(wv[0], wv[1]); pw[2 * sb + 1] = pk2(wv[2], wv[3]);
                run += (a + bq) + (cq + dq);
            }
            carry = run;
            const bf16x8_t pf0 = __builtin_bit_cast(bf16x8_t, (v4u){pw[0], pw[1], pw[2], pw[3]}), pf1 = __builtin_bit_cast(bf16x8_t, (v4u){pw[4], pw[5], pw[6], pw[7]});
#pragma unroll
            for (int db = 0; db < 4; ++db) {
                LAS unsigned char* vp = lds + AT_LV + (4 * fq + q2) * 144 + 32 * db + 8 * p2;
                const bf16x8_t va0 = cat8(lds_tr16(vp), lds_tr16(vp + 16 * 144)), va1 = cat8(lds_tr16(vp + 32 * 144), lds_tr16(vp + 48 * 144));
                oacc[db] = __builtin_amdgcn_mfma_f32_16x16x32_bf16(va0, pf0, oacc[db], 0, 0, 0);
                oacc[db] = __builtin_amdgcn_mfma_f32_16x16x32_bf16(va1, pf1, oacc[db], 0, 0, 0); }
            wdone = __all(!tvalid || carry < -105.f);
        }
        if (lane == 0) ((LAS int*)(lds + AT_FLAG))[wave] = wdone ? 1 : 0;
        __syncthreads();
        k0 -= 64;
        if (k0 < 0) break;
        { const LAS int* fl = (const LAS int*)(lds + AT_FLAG); const int alld = fl[0] & fl[1] & fl[2] & fl[3] & fl[4] & fl[5] & fl[6] & fl[7]; if (alld) break; }
    }
    if (tvalid) { bf16* op = Qb + (rowb + t) * DM + h * 64 + 4 * fq;
#pragma unroll
        for (int db = 0; db < 4; ++db) *(v2u*)(op + 16 * db) = (v2u){pk2(oacc[db][0], oacc[db][1]), pk2(oacc[db][2], oacc[db][3])}; }
    __syncthreads();
}

constexpr int TAIL0 = 64 * 256, MMAIN = 64 * 256;
template <class F> __device__ __forceinline__ void tail_gemm(LAS unsigned char* lds, const bf16* A, const bf16* Bt, int K, int ncb, int bx, int G, int tid, const F& epi) {
    const int lane = tid & 63, wave = __builtin_amdgcn_readfirstlane(tid >> 6), fr = lane & 15, fq = lane >> 4, kw = K >> 3;
    for (int cb = bx; cb < ncb; cb += G) {
        f32x4 acc[4];
#pragma unroll
        for (int rb = 0; rb < 4; ++rb) acc[rb] = (f32x4){0.f, 0.f, 0.f, 0.f};
        const bf16* bp = Bt + (size_t)(16 * cb + fr) * K + wave * kw + 8 * fq;
        const bf16* ap = A + (size_t)(TAIL0 + fr) * K + wave * kw + 8 * fq;
        for (int k = 0; k < kw; k += 32) {
            const bf16x8_t bfg = *(const bf16x8_t*)(bp + k);
#pragma unroll
            for (int rb = 0; rb < 4; ++rb) { const bf16x8_t afg = *(const bf16x8_t*)(ap + (size_t)rb * 16 * K + k); acc[rb] = __builtin_amdgcn_mfma_f32_16x16x32_bf16(bfg, afg, acc[rb], 0, 0, 0); }
        }
        LAS f32x4* P = (LAS f32x4*)lds;
#pragma unroll
        for (int rb = 0; rb < 4; ++rb) P[(wave * 4 + rb) * 64 + lane] = acc[rb];
        __syncthreads();
        if (wave < 4) { f32x4 s = (f32x4){0.f, 0.f, 0.f, 0.f};
#pragma unroll
            for (int w = 0; w < 8; ++w) s += P[(w * 4 + wave) * 64 + lane];
            epi(s, TAIL0 + 16 * wave + fr, 16 * cb + 4 * fq); }
        __syncthreads();
    }
}
template <int mode> struct TailResid { float* H; const float* x;
    __device__ __forceinline__ void operator()(f32x4 s, int row, int col0) const {
        float* hp = H + (size_t)row * DM + col0; const int l = row - BS - OFF;
        const float* bp = mode == 0 ? hp : x + ((size_t)SEQ + (l - NMETA)) * DM + col0;
        *(f32x4*)hp = *(const f32x4*)bp + s; } };
struct TailKVQ { bf16* Kb; size_t stride;
    __device__ __forceinline__ void operator()(f32x4 s, int row, int col0) const {
        const int t = col0 >> 10; bf16* op = Kb + (size_t)t * stride + (size_t)row * DM + (col0 & 1023);
        *(v2u*)op = (v2u){pk2(s[0], s[1]), pk2(s[2], s[3])}; } };

struct Args {
    const float* in[22]; float* outp; unsigned char* wsp; int ph_lo, ph_hi, coop, pad;
};

__device__ __forceinline__ void norm_row(const float* src, bf16* dst, int lane) {
    v2u* o8 = (v2u*)dst + lane;
    if (!src) {
#pragma unroll
        for (int j = 0; j < 4; ++j) o8[64 * j] = (v2u){0u, 0u};
        return; }
    const f32x4* xr = (const f32x4*)src + lane;
    f32x4 v[4]; float s = 0.f;
#pragma unroll
    for (int j = 0; j < 4; ++j) { v[j] = xr[64 * j]; s += (v[j].x * v[j].x + v[j].y * v[j].y) + (v[j].z * v[j].z + v[j].w * v[j].w); }
    const float rstd = 1.0f / sqrtf(wave_sum(s) * (1.f / DM) + EPS);
#pragma unroll
    for (int j = 0; j < 4; ++j) o8[64 * j] = (v2u){pk2(v[j].x * rstd, v[j].y * rstd), pk2(v[j].z * rstd, v[j].w * rstd)};
}
__device__ __forceinline__ const float* stream_row(int r, int mode, const float* H, const float* x, const float* meta) {
    if (r >= 2 * BS) return nullptr;
    const int b = r >= BS ? 1 : 0, l = r - b * BS - OFF;
    if (l < 0 || l >= LTOK) return nullptr;
    if (mode == 0) return H + (size_t)r * DM;
    return l < NMETA ? meta + (size_t)l * DM : x + ((size_t)b * SEQ + (l - NMETA)) * DM;
}

__device__ __forceinline__ const void* ptab(volatile LAS unsigned* PT, int k) {
    const unsigned lo_ = PT[2 * k], hi_ = PT[2 * k + 1];
    return (const void*)(const __attribute__((address_space(1))) void*)(((unsigned long long)(unsigned)__builtin_amdgcn_readfirstlane((int)hi_) << 32) | (unsigned long long)(unsigned)__builtin_amdgcn_readfirstlane((int)lo_));
}
#define xin ((const float*)ptab(PT, 0))
#define metain ((const float*)ptab(PT, 1))
#define ssd_norm ((const float*)ptab(PT, 2))
#define ssd_w_in ((const float*)ptab(PT, 3))
#define ssd_conv_w ((const float*)ptab(PT, 4))
#define ssd_conv_b ((const float*)ptab(PT, 5))
#define ssd_dt_bias ((const float*)ptab(PT, 6))
#define ssd_a_log ((const float*)ptab(PT, 7))
#define ssd_d_skip ((const float*)ptab(PT, 8))
#define ssd_gate_norm ((const float*)ptab(PT, 9))
#define ssd_w_out ((const float*)ptab(PT, 10))
#define kv_norm ((const float*)ptab(PT, 11))
#define w_kv ((const float*)ptab(PT, 12))
#define sb_norm ((const float*)ptab(PT, 13))
#define sb_w_q ((const float*)ptab(PT, 14))
#define sb_w_o ((const float*)ptab(PT, 15))
#define ffn_norm ((const float*)ptab(PT, 16))
#define ffn_w_up ((const float*)ptab(PT, 17))
#define ffn_conv_w ((const float*)ptab(PT, 18))
#define ffn_conv_b ((const float*)ptab(PT, 19))
#define ffn_w_down ((const float*)ptab(PT, 20))
#define final_norm ((const float*)ptab(PT, 21))
#define ws ((unsigned char*)ptab(PT, 22))
#define Win ((bf16*)(ws + WS_WIN))
#define Wout ((bf16*)(ws + WS_WOUT))
#define Wkvq ((bf16*)(ws + WS_WKVQ))
#define Wo ((bf16*)(ws + WS_WO))
#define Wup0 ((bf16*)(ws + WS_WUP0))
#define Wup1 ((bf16*)(ws + WS_WUP1))
#define Wdn0 ((bf16*)(ws + WS_WDN0))
#define Wdn1 ((bf16*)(ws + WS_WDN1))
#define DT ((float*)(ws + WS_DT))
#define XBC ((bf16*)(ws + WS_XBC))
#define H ((float*)(ws + WS_H))
#define Z ((bf16*)(ws + WS_Z))
#define ACT ((bf16*)(ws + WS_ACT))
#define KB ((bf16*)(ws + WS_K))
#define VB ((bf16*)(ws + WS_V))
#define QB ((bf16*)(ws + WS_Q))
#define XN ((bf16*)ptab(PT, 23))
#define OUTP ((float*)ptab(PT, 23))
__global__ void __launch_bounds__(NTHR, 2) mega(const Args args) {
    extern __shared__ __attribute__((aligned(16))) unsigned char lds_raw[];
    LAS unsigned char* lds = (LAS unsigned char*)lds_raw;
    const int tid = threadIdx.x, lane = tid & 63, wave = __builtin_amdgcn_readfirstlane(tid >> 6);
    const int G = gridDim.x, bx = blockIdx.x;
    const int gw = bx * NWAVES + wave, NGW = G * NWAVES;
    volatile LAS unsigned* PT = (volatile LAS unsigned*)(lds + RING_BYTES + XCH_BYTES);
    if (tid < 24) { const unsigned long long pv = tid < 22 ? (unsigned long long)args.in[tid] : (tid == 22 ? (unsigned long long)args.wsp : (unsigned long long)args.outp); PT[2 * tid] = (unsigned)pv; PT[2 * tid + 1] = (unsigned)(pv >> 32); }
    __syncthreads();
    const int lo = args.ph_lo, hi = args.ph_hi;
#define IN(k) (lo <= (k) && (k) < hi)
#define SEAM(k) do { if (args.coop && IN(k) && IN((k) + 1)) { cg::this_grid().sync(); } } while (0)

    if (IN(0)) {
        LAS float* scr = (LAS float*)(lds + wave * 16384);
        constexpr int I_IN = 16 * (NIN / 32), I_OUT = 32 * 32, I_KVQ = 16 * 96, I_O = 16 * 32, I_UP = 16 * (NUP / 32), I_DN = 44 * 32;
        constexpr int NITEMS = I_IN + I_OUT + I_KVQ + I_O + 2 * I_UP + 2 * I_DN;
        for (int it = gw; it < NITEMS; it += NGW) {
            int r = it;
            if (r < I_IN) { const int nb = r % (NIN / 32), kb = r / (NIN / 32), n0 = nb * 32; transpose_item(ssd_w_in, NIN_REAL, DM, Win, n0, n0 < NIN_REAL ? n0 : -1, kb * 64, ssd_norm, scr, lane); continue; } r -= I_IN;
            if (r < I_OUT) { const int nb = r % 32, kb = r / 32; transpose_item(ssd_w_out, DM, DI, Wout, nb * 32, nb * 32, kb * 64, ssd_gate_norm, scr, lane); continue; } r -= I_OUT;
            if (r < I_KVQ) { const int nb = r % 96, kb = r / 96, n0 = nb * 32;
                if (n0 < 2048) transpose_item(w_kv, 2048, DM, Wkvq, n0, n0, kb * 64, kv_norm, scr, lane); else transpose_item(sb_w_q, DM, DM, Wkvq, n0, n0 - 2048, kb * 64, sb_norm, scr, lane);
                continue; } r -= I_KVQ;
            if (r < I_O) { const int nb = r % 32, kb = r / 32; transpose_item(sb_w_o, DM, DM, Wo, nb * 32, nb * 32, kb * 64, nullptr, scr, lane); continue; } r -= I_O;
            if (r < 2 * I_UP) { const int ly = r / I_UP; r -= ly * I_UP; const int nb = r % (NUP / 32), kb = r / (NUP / 32), n0 = nb * 32;
                const int src = ((n0 >> 7) & 1) * DFF + (n0 >> 8) * 128 + (n0 & 127);
                transpose_item(ffn_w_up + (size_t)ly * DM * NUP, NUP, DM, ly ? Wup1 : Wup0, n0, src, kb * 64, ffn_norm + ly * DM, scr, lane); continue; } r -= 2 * I_UP;
            { const int ly = r / I_DN; r -= ly * I_DN; const int nb = r % 32, kb = r / 32;
              transpose_item(ffn_w_down + (size_t)ly * DFF * DM, DM, DFF, ly ? Wdn1 : Wdn0, nb * 32, nb * 32, kb * 64, nullptr, scr, lane); }
        }
        for (int r = gw; r < MRX; r += NGW) norm_row(stream_row(r, 1, H, xin, metain), XN + (size_t)r * DM, lane);
    }
    SEAM(0);
    if (IN(1)) {
        pg8::Gemm g{XN, Win, 2 * TPB * 256, NIN, DM, 3}; pg8::StaticOrder S; S.init(2 * TPB * 256, NIN, G, bx);
        pg8::EpiInProj E{Z, XBC, DT, ssd_conv_w, ssd_conv_b, ssd_dt_bias};
        pg8::gemm_phase<pg8::EpiInProj, pg8::StaticOrder, true, true>(lds, g, S, E);
    }
    SEAM(1);
    if (IN(2)) {
        bf16* xbc = XBC; const float* dtp = DT; bf16* ST = (bf16*)(ws + WS_ST); float* DEC = (float*)(ws + 4096);
        for (int u = bx; u < NBATCH * 32 * NHS; u += G) { const int h = u % NHS, c = (u / NHS) % 32, b = u / (NHS * 32);
            ssd_unit<1>(lds, b, c, h, xbc, xbc, dtp, ST, DEC, -__expf(ssd_a_log[h]), 0.f, tid); }
        if (args.coop) cg::this_grid().sync();
        { const int gt = bx * NTHR + tid;
          if (gt < NBATCH * NHS * 1024) { const int bh = gt >> 10, e = gt & 1023, b = bh / NHS, h = bh % NHS; float run[8];
#pragma unroll
              for (int k = 0; k < 8; ++k) run[k] = 0.f;
              for (int c = 0; c < 32; ++c) { v4u* sp = (v4u*)(ST + ((size_t)((b * 32 + c) * NHS + h)) * 8192 + e * 8); const v4u w = *sp; const float d = DEC[(b * 32 + c) * NHS + h];
#pragma unroll
                  for (int k = 0; k < 4; ++k) { run[2 * k] = run[2 * k] * d + bf_lo(w[k]); run[2 * k + 1] = run[2 * k + 1] * d + bf_hi(w[k]); }
                  *sp = (v4u){pk2(run[0], run[1]), pk2(run[2], run[3]), pk2(run[4], run[5]), pk2(run[6], run[7])}; } } }
        if (args.coop) cg::this_grid().sync();
        for (int u = bx; u < NBATCH * 33 * NHS; u += G) { const int h = u % NHS, c = (u / NHS) % 33, b = u / (NHS * 33);
            ssd_unit<2>(lds, b, c, h, xbc, xbc, dtp, ST, DEC, -__expf(ssd_a_log[h]), ssd_d_skip[h], tid); }
    }
    SEAM(2);
    if (IN(3)) {
        for (int r = gw; r < 2 * BS; r += NGW) {
            const int b = r >= BS ? 1 : 0, l = r - b * BS - OFF; if (l < 0 || l >= LTOK) continue;
#pragma unroll
            for (int g = 0; g < 4; ++g) {
                const v4u yq = *(const v4u*)(XBC + (size_t)r * CONVD + g * 512 + lane * 8); v4u* zp = (v4u*)(Z + (size_t)r * DI + g * 512 + lane * 8); const v4u zq = *zp;
                float hv[8]; float ss = 0.f;
#pragma unroll
                for (int e = 0; e < 4; ++e) { const float y0 = bf_lo(yq[e]), y1 = bf_hi(yq[e]), z0 = bf_lo(zq[e]), z1 = bf_hi(zq[e]);
                    hv[2 * e] = y0 * pg8::silu_f(z0); hv[2 * e + 1] = y1 * pg8::silu_f(z1); ss += hv[2 * e] * hv[2 * e] + hv[2 * e + 1] * hv[2 * e + 1]; }
                const float rs = 1.0f / sqrtf(wave_sum(ss) * (1.f / 512.f) + EPS);
                *zp = (v4u){pk2(hv[0] * rs, hv[1] * rs), pk2(hv[2] * rs, hv[3] * rs), pk2(hv[4] * rs, hv[5] * rs), pk2(hv[6] * rs, hv[7] * rs)};
            }
        }
    }
    SEAM(3);
    if (IN(4)) {
        { TailResid<1> te{H, xin}; tail_gemm(lds, Z, Wout, DI, DM / 16, bx, G, tid, te); }
        pg8::Gemm g{Z, Wout, MMAIN, DM, DI, 0}; pg8::StaticOrder S; S.init(MMAIN, DM, G, bx);
        pg8::EpiResid<1> E{H, xin, metain};
        pg8::gemm_phase<pg8::EpiResid<1>, pg8::StaticOrder, true, true>(lds, g, S, E);
    }
    SEAM(4);
#pragma unroll 1
    for (int ly = 0; ly < 2; ++ly) {
        const int pb = ly == 0 ? 5 : 12;
        if (ly == 1) {
            if (IN(8)) { for (int r = gw; r < MRX; r += NGW) norm_row(stream_row(r, 0, H, xin, metain), XN + (size_t)r * DM, lane); }
            SEAM(8);
            if (IN(9)) {
                { TailKVQ te{KB, (size_t)(WS_V - WS_K) / 2}; tail_gemm(lds, XN, Wkvq, DM, 3072 / 16, bx, G, tid, te); }
                pg8::Gemm g{XN, Wkvq, MMAIN, 3072, DM, 0}; pg8::StaticOrder S; S.init(MMAIN, 3072, G, bx);
                pg8::EpiBf16 E{KB, DM, DM, (size_t)(WS_V - WS_K) / 2};
                pg8::gemm_phase<pg8::EpiBf16, pg8::StaticOrder, true, true>(lds, g, S, E);
            }
            SEAM(9);
            if (IN(10)) {
                constexpr int NQB = (LTOK + 127) / 128;
                bf16* qb_ = QB; const bf16* kb_ = KB; const bf16* vb_ = VB;
                for (int u = bx; u < NBATCH * 16 * NQB; u += G) { const int hh = u % 16, qi = (u / 16) % NQB, bb = u / (16 * NQB);
                    attn_unit(lds, bb, hh, qi, qb_, kb_, vb_, tid); }
            }
            SEAM(10);
            if (IN(11)) {
                { TailResid<0> te{H, nullptr}; tail_gemm(lds, QB, Wo, DM, DM / 16, bx, G, tid, te); }
                pg8::Gemm g{QB, Wo, MMAIN, DM, DM, 0}; pg8::StaticOrder S; S.init(MMAIN, DM, G, bx);
                pg8::EpiResid<0> E{H, nullptr, nullptr};
                pg8::gemm_phase<pg8::EpiResid<0>, pg8::StaticOrder, true, true>(lds, g, S, E);
            }
            SEAM(11);
        }
        if (IN(pb)) { for (int r = gw; r < MRX; r += NGW) norm_row(stream_row(r, 0, H, xin, metain), XN + (size_t)r * DM, lane); }
        SEAM(pb);
        if (IN(pb + 1)) {
            pg8::Gemm g{XN, ly ? Wup1 : Wup0, 2 * TPB * 256, NUP, DM, 2}; pg8::StaticOrder S; S.init(2 * TPB * 256, NUP, G, bx);
            pg8::EpiUp E{ACT, ffn_conv_w + (size_t)ly * 3 * NUP, ffn_conv_b + (size_t)ly * NUP};
            pg8::gemm_phase<pg8::EpiUp, pg8::StaticOrder, true, true>(lds, g, S, E);
        }
        SEAM(pb + 1);
        if (IN(pb + 2)) {
            { TailResid<0> te{H, nullptr}; tail_gemm(lds, ACT, ly ? Wdn1 : Wdn0, DFF, DM / 16, bx, G, tid, te); }
            pg8::Gemm g{ACT, ly ? Wdn1 : Wdn0, MMAIN, DM, DFF, 0}; pg8::StaticOrder S; S.init(MMAIN, DM, G, bx);
            pg8::EpiResid<0> E{H, nullptr, nullptr};
            pg8::gemm_phase<pg8::EpiResid<0>, pg8::StaticOrder, true, true>(lds, g, S, E);
        }
        SEAM(pb + 2);
    }
    if (IN(15)) {
        for (int r = gw; r < NBATCH * SEQ; r += NGW) {
            const int b = r / SEQ, t = r % SEQ; const f32x4* xr = (const f32x4*)(H + (size_t)(b * BS + OFF + NMETA + t) * DM) + lane;
            f32x4 v[4]; float s = 0.f;
#pragma unroll
            for (int j = 0; j < 4; ++j) { v[j] = xr[64 * j]; s += (v[j].x * v[j].x + v[j].y * v[j].y) + (v[j].z * v[j].z + v[j].w * v[j].w); }
            const float rstd = 1.0f / sqrtf(wave_sum(s) * (1.f / DM) + EPS);
            f32x4* op = (f32x4*)(OUTP + (size_t)r * DM) + lane; const f32x4* gp = (const f32x4*)final_norm + lane;
#pragma unroll
            for (int j = 0; j < 4; ++j) op[64 * j] = v[j] * rstd * gp[64 * j];
        }
    }
#undef IN
#undef SEAM
}

#undef xin
#undef metain
#undef ssd_norm
#undef ssd_w_in
#undef ssd_conv_w
#undef ssd_conv_b
#undef ssd_dt_bias
#undef ssd_a_log
#undef ssd_d_skip
#undef ssd_gate_norm
#undef ssd_w_out
#undef kv_norm
#undef w_kv
#undef sb_norm
#undef sb_w_q
#undef sb_w_o
#undef ffn_norm
#undef ffn_w_up
#undef ffn_conv_w
#undef ffn_conv_b
#undef ffn_w_down
#undef final_norm
#undef ws
#undef Win
#undef Wout
#undef Wkvq
#undef Wo
#undef Wup0
#undef Wup1
#undef Wdn0
#undef Wdn1
#undef DT
#undef XBC
#undef H
#undef Z
#undef ACT
#undef KB
#undef VB
#undef QB
#undef XN
#undef OUTP
constexpr int NPHASES = 16;
extern "C" void kernel_launch(void* const* d_in, const int* in_sizes, int n_in, void* d_out, int out_size, void* d_ws, size_t ws_size, hipStream_t stream) {
    static int grid = 0;
    if (grid == 0) {
        if (n_in != 22 || ws_size < WS_END || out_size != NBATCH * SEQ * DM) { fprintf(stderr, "kernel_launch: unexpected shapes (n_in %d ws %zu out %d)\n", n_in, ws_size, out_size); grid = -1; return; }
        int dev = 0, cus = 0, per_cu = 0;
        (void)hipGetDevice(&dev); (void)hipDeviceGetAttribute(&cus, hipDeviceAttributeMultiprocessorCount, dev);
        (void)hipFuncSetAttribute((const void*)mega, hipFuncAttributeMaxDynamicSharedMemorySize, LDS_BYTES);
        (void)hipOccupancyMaxActiveBlocksPerMultiprocessor(&per_cu, (const void*)mega, NTHR, LDS_BYTES);
        (void)hipGetLastError();
        if (per_cu < 1) per_cu = 1;
        grid = cus * 1;
    }
    if (grid < 0) return;
    Args a{};
    for (int i = 0; i < 22; ++i) a.in[i] = (const float*)d_in[i];
    a.outp = (float*)d_out; a.wsp = (unsigned char*)d_ws;
#if MK_COOP
    a.ph_lo = 0; a.ph_hi = NPHASES; a.coop = 1;
    void* kargs[] = {&a};
    hipError_t e = hipLaunchCooperativeKernel((const void*)mega, dim3(grid), dim3(NTHR), kargs, LDS_BYTES, stream);
    if (e != hipSuccess) fprintf(stderr, "cooperative launch failed: %s (grid %d)\n", hipGetErrorString(e), grid);
#else
    for (int p = 0; p < NPHASES; ++p) { a.ph_lo = p; a.ph_hi = p + 1; a.coop = 0; hipLaunchKernelGGL(mega, dim3(grid), dim3(NTHR), LDS_BYTES, stream, a); }
#endif
}
```

```cpp
#include <hip/hip_runtime.h>
#include <hip/hip_cooperative_groups.h>
#include <cstdio>
#include <cstdint>
namespace cg = cooperative_groups;

constexpr int DM = 1024, NBATCH = 2, SEQ = 8192, NMETA = 16, LTOK = NMETA + SEQ;
constexpr int BS = 8224, OFF = 16;
constexpr int MR = 65 * 256;
constexpr int MRX = 66 * 256;
constexpr int TPB = 33;
constexpr int DI = 2048, NSTATE = 128, NHS = 32, CONVD = 3072, NIN = 5376, NIN_REAL = 5152;
constexpr int DFF = 2816, NUP = 5632;
constexpr float EPS = 1e-6f;

#ifndef MK_COOP
#define MK_COOP 1
#endif
#define PROBE_ON 0
#define PROBE_EXPR 0.f
#define EXTRA_SYNCS 0
namespace pg8 {
#define PG8_LAS __attribute__((address_space(3)))
typedef unsigned short bf16_t;
typedef short bf16x8 __attribute__((ext_vector_type(8)));
typedef float f32x4 __attribute__((ext_vector_type(4)));
typedef unsigned u32x4 __attribute__((ext_vector_type(4)));
constexpr int BM = 256, BK = 64, HALF = 128, HTB = HALF * BK * 2  , STAGE_BYTES = 8 * HTB, NXCD = 8, WGM = 8;

__host__ __device__ __forceinline__ int lds_byte(int r, int c) { const int st = (r >> 4) * 2 + (c >> 5), rr = r & 15, cc = c & 31, ob = rr * 64 + cc * 2; return st * 1024 + (ob ^ (((ob >> 9) & 1) << 5)); }
__host__ __device__ __forceinline__ void stage_rc(int b, int& R, int& C) { const int st = b / 1024, sb = b % 1024, swz = sb ^ (((sb >> 9) & 1) << 5); R = (st >> 1) * 16 + swz / 64; C = (st & 1) * 32 + (swz % 64) / 2; }
__host__ __device__ __forceinline__ int perm32(int rho) { const int n = rho >> 4, i = rho & 15; return 8 * (i >> 2) + 4 * n + (i & 3); }

struct Unit { int pm, pn; };
struct Gemm { const bf16_t* A; const bf16_t* Bt; int M, N, K; int halo;
    __device__ __forceinline__ size_t a_off(int pm) const { const int row = halo == 0 ? pm * 256 : (pm / TPB) * BS + OFF - halo + (256 - halo) * (pm % TPB); return (size_t)row * (size_t)K * 2; } };

struct StaticOrder {
    int nM, nN, nwg, G, c;
    __host__ __device__ void init(int M, int N, int G_, int c_) { nM = M / BM; nN = N / BM; nwg = nM * nN; G = G_; c = c_; }
    __host__ __device__ bool next(int i, Unit& u) const {
        const long L = (long)i * G + c; if (L >= nwg) return false;
        int wgid = (int)L; { const int q = nwg / NXCD, r = nwg % NXCD, xcd = wgid % NXCD, off = wgid / NXCD; wgid = (xcd < r ? xcd * (q + 1) : r * (q + 1) + (xcd - r) * q) + off; }
        const int nig = WGM * nN, gid = wgid / nig, fm = gid * WGM, gsz = (nM - fm) < WGM ? (nM - fm) : WGM;
        u.pm = fm + ((wgid % nig) % gsz); u.pn = (wgid % nig) / gsz; return true;
    }
    __device__ __forceinline__ void a_ready(const Unit&) const {}
    __device__ __forceinline__ void done(const Unit&) const {}
};

__device__ __forceinline__ unsigned cvt_pk_bf16(float lo, float hi) { unsigned r; asm volatile("v_cvt_pk_bf16_f32 %0, %1, %2" : "=v"(r) : "v"(lo), "v"(hi)); return r; }
typedef float f32x2 __attribute__((ext_vector_type(2)));
__device__ __forceinline__ float silu_f(float v) { return v * __builtin_amdgcn_rcpf(1.0f + __expf(-v)); }
__device__ __forceinline__ float softplus_f(float v) { return fmaxf(v, 0.f) + log1pf(__expf(-fabsf(v))); }
__device__ __forceinline__ float bflo(unsigned u) { return __uint_as_float(u << 16); }
__device__ __forceinline__ float bfhi(unsigned u) { return __uint_as_float(u & 0xffff0000u); }
typedef unsigned u32x2 __attribute__((ext_vector_type(2)));

struct EpiBf16 {
    static constexpr bool PERM = true, AFTER_DRAIN = false;
    bf16_t* O; int ldc; int split_cols; size_t split_stride;
    __device__ __forceinline__ void operator()(const f32x4 (&acc)[2][2][4][2], const Unit& u, int wr, int wc, int fr, int fq, PG8_LAS unsigned char*) const {
        asm volatile("" : "+v"(fr), "+v"(fq));
        const int row0 = u.pm * BM + wr * 64 + fr; int colt = u.pn * BM; bf16_t* base = O;
        if (split_cols) { const int t = colt / split_cols; base += (size_t)t * split_stride; colt -= t * split_cols; }
        const int col0 = colt + wc * 32 + 8 * fq;
#pragma unroll
        for (int ai = 0; ai < 2; ++ai)
#pragma unroll
            for (int m = 0; m < 4; ++m) { bf16_t* rowp = base + (size_t)(row0 + ai * HALF + m * 16) * ldc + col0;
#pragma unroll
                for (int bj = 0; bj < 2; ++bj) { const f32x4 v0 = acc[ai][bj][m][0], v1 = acc[ai][bj][m][1];
                    u32x4 w; w.x = cvt_pk_bf16(v0[0], v0[1]); w.y = cvt_pk_bf16(v0[2], v0[3]); w.z = cvt_pk_bf16(v1[0], v1[1]); w.w = cvt_pk_bf16(v1[2], v1[3]);
                    *(u32x4*)(rowp + bj * HALF) = w; } }
    }
};

template <int mode> struct EpiResid {
    static constexpr bool PERM = false, AFTER_DRAIN = false;
    float* H; const float* x; const float* meta;
    __device__ __forceinline__ void operator()(const f32x4 (&acc)[2][2][4][2], const Unit& u, int wr, int wc, int fr, int fq, PG8_LAS unsigned char*) const {
        asm volatile("" : "+v"(fr), "+v"(fq));
        const int col0 = u.pn * BM + wc * 32 + 4 * fq;
#pragma unroll
        for (int ai = 0; ai < 2; ++ai)
#pragma unroll
            for (int m = 0; m < 4; ++m) {
                const int r = u.pm * BM + ai * HALF + wr * 64 + m * 16 + fr;
                const int b = r >= BS ? 1 : 0, l = r - b * BS - OFF;
                if (l >= 0 && l < LTOK) {
                    float* hp = H + (size_t)r * DM + col0;
                    const float* bp = mode == 0 ? hp : (l < NMETA ? meta + (size_t)l * DM + col0 : x + ((size_t)b * SEQ + (l - NMETA)) * DM + col0);
#pragma unroll
                    for (int bj = 0; bj < 2; ++bj)
#pragma unroll
                        for (int n = 0; n < 2; ++n) { const f32x4 bs = *(const f32x4*)(bp + bj * HALF + n * 16); *(f32x4*)(hp + bj * HALF + n * 16) = bs + acc[ai][bj][m][n]; }
                }
                asm volatile("" ::: "memory");
            }
    }
};

__device__ __forceinline__ void halo_publish(const f32x4 (&acc)[2][2][4][2], PG8_LAS unsigned char* xl, int wr, int wc, int fr, int fq) {
    PG8_LAS f32x4* X = (PG8_LAS f32x4*)xl; const int wave = wr * 4 + wc;
    if (fr >= 12) {
#pragma unroll
        for (int ai = 0; ai < 2; ++ai)
#pragma unroll
            for (int bj = 0; bj < 2; ++bj)
#pragma unroll
                for (int n = 0; n < 2; ++n) X[(((wave * 2 + ai) * 4 + bj * 2 + n) * 16) + fq * 4 + (fr - 12)] = acc[ai][bj][3][n];
    }
    asm volatile("s_waitcnt lgkmcnt(0)" ::: "memory"); __builtin_amdgcn_s_barrier(); asm volatile("" ::: "memory");
}
__device__ __forceinline__ f32x4 halo_get(PG8_LAS unsigned char* xl, int ai, int bj, int n, int wr, int wc, int fr, int fq) {
    const PG8_LAS f32x4* X = (const PG8_LAS f32x4*)xl; const int pai = wr == 1 ? ai : ai - 1, pw = (wr ^ 1) * 4 + wc;
    f32x4 r = (f32x4){0.f, 0.f, 0.f, 0.f};
    if (fr >= 12 && pai >= 0) r = X[(((pw * 2 + pai) * 4 + bj * 2 + n) * 16) + fq * 4 + (fr - 12)];
    return r;
}

struct EpiInProj {
    static constexpr bool PERM = true, AFTER_DRAIN = false;
    bf16_t* Z; bf16_t* XBC; float* DT; const float* cw; const float* cb; const float* dtb;
    __device__ __forceinline__ void operator()(const f32x4 (&acc)[2][2][4][2], const Unit& u, int wr, int wc, int fr, int fq, PG8_LAS unsigned char* xl) const {
        asm volatile("" : "+v"(fr), "+v"(fq));
        const int pb = u.pm / TPB, pt = u.pm % TPB, l0 = 253 * pt - 3, rowbase = pb * BS + OFF + l0, lane = fq * 16 + fr;
        if (u.pn < 8) {
            const int col0 = u.pn * BM + wc * 32 + 8 * fq;
#pragma unroll
            for (int ai = 0; ai < 2; ++ai)
#pragma unroll
                for (int m = 0; m < 4; ++m) { const int i = ai * HALF + wr * 64 + m * 16 + fr, l = l0 + i;
                    if (i >= 3 && l < LTOK) { bf16_t* rowp = Z + (size_t)(rowbase + i) * DI + col0;
#pragma unroll
                        for (int bj = 0; bj < 2; ++bj) { const f32x4 v0 = acc[ai][bj][m][0], v1 = acc[ai][bj][m][1];
                            u32x4 w; w.x = cvt_pk_bf16(v0[0], v0[1]); w.y = cvt_pk_bf16(v0[2], v0[3]); w.z = cvt_pk_bf16(v1[0], v1[1]); w.w = cvt_pk_bf16(v1[2], v1[3]);
                            *(u32x4*)(rowp + bj * HALF) = w; } } }
        } else if (u.pn < 20) {
            halo_publish(acc, xl, wr, wc, fr, fq);
            const int s1 = (lane & 48) | ((fr - 1) & 15), s2 = (lane & 48) | ((fr - 2) & 15), s3 = (lane & 48) | ((fr - 3) & 15);
#pragma unroll
            for (int bj = 0; bj < 2; ++bj)
#pragma unroll
                for (int n = 0; n < 2; ++n) {
                    const int c0 = (u.pn - 8) * BM + bj * HALF + wc * 32 + 8 * fq + 4 * n;
                    const f32x4 w0 = *(const f32x4*)(cw + c0), w1 = *(const f32x4*)(cw + CONVD + c0), w2 = *(const f32x4*)(cw + 2 * CONVD + c0), w3 = *(const f32x4*)(cw + 3 * CONVD + c0), bb = *(const f32x4*)(cb + c0);
#pragma unroll
                    for (int ai = 0; ai < 2; ++ai)
#pragma unroll
                        for (int m = 0; m < 4; ++m) {
                            const f32x4 cur = acc[ai][bj][m][n];
                            f32x4 prv; if (m > 0) prv = acc[ai][bj][m > 0 ? m - 1 : 0][n]; else prv = halo_get(xl, ai, bj, n, wr, wc, fr, fq);
                            float o[4];
#pragma unroll
                            for (int j = 0; j < 4; ++j) {
                                const float v1 = __shfl(fr >= 15 ? prv[j] : cur[j], s1), v2 = __shfl(fr >= 14 ? prv[j] : cur[j], s2), v3 = __shfl(fr >= 13 ? prv[j] : cur[j], s3);
                                o[j] = silu_f(bb[j] + w3[j] * cur[j] + w2[j] * v1 + w1[j] * v2 + w0[j] * v3);
                            }
                            const int i = ai * HALF + wr * 64 + m * 16 + fr, l = l0 + i;
                            if (i >= 3 && l < LTOK) { u32x2 w; w.x = cvt_pk_bf16(o[0], o[1]); w.y = cvt_pk_bf16(o[2], o[3]); *(u32x2*)(XBC + (size_t)(rowbase + i) * CONVD + c0) = w; }
                        }
                    asm volatile("" ::: "memory");
                }
        } else {
            if (wc == 0) {
#pragma unroll
                for (int n = 0; n < 2; ++n) { const int c0 = 8 * fq + 4 * n; const f32x4 bb = *(const f32x4*)(dtb + c0);
#pragma unroll
                    for (int ai = 0; ai < 2; ++ai)
#pragma unroll
                        for (int m = 0; m < 4; ++m) { const int i = ai * HALF + wr * 64 + m * 16 + fr, l = l0 + i; const f32x4 v = acc[ai][0][m][n] + bb;
                            if (i >= 3 && l < LTOK) *(f32x4*)(DT + (size_t)(rowbase + i) * NHS + c0) = (f32x4){softplus_f(v[0]), softplus_f(v[1]), softplus_f(v[2]), softplus_f(v[3])}; } }
            }
        }
    }
};

struct EpiUp {
    static constexpr bool PERM = true, AFTER_DRAIN = false;
    bf16_t* ACT; const float* cw; const float* cb;
    __device__ __forceinline__ void operator()(const f32x4 (&acc)[2][2][4][2], const Unit& u, int wr, int wc, int fr, int fq, PG8_LAS unsigned char* xl) const {
        asm volatile("" : "+v"(fr), "+v"(fq));
        const int pb = u.pm / TPB, pt = u.pm % TPB, l0 = 254 * pt - 2, rowbase = pb * BS + OFF + l0, lane = fq * 16 + fr;
        halo_publish(acc, xl, wr, wc, fr, fq);
        const int s1 = (lane & 48) | ((fr - 1) & 15), s2 = (lane & 48) | ((fr - 2) & 15);
#pragma unroll
        for (int n = 0; n < 2; ++n) {
            const int c0 = u.pn * HALF + wc * 32 + 8 * fq + 4 * n;
            const f32x4 g0 = *(const f32x4*)(cw + c0), g1 = *(const f32x4*)(cw + NUP + c0), g2 = *(const f32x4*)(cw + 2 * NUP + c0), gb = *(const f32x4*)(cb + c0);
            const f32x4 h0 = *(const f32x4*)(cw + DFF + c0), h1 = *(const f32x4*)(cw + NUP + DFF + c0), h2 = *(const f32x4*)(cw + 2 * NUP + DFF + c0), hb = *(const f32x4*)(cb + DFF + c0);
#pragma unroll
            for (int ai = 0; ai < 2; ++ai)
#pragma unroll
                for (int m = 0; m < 4; ++m) {
                    const f32x4 cg = acc[ai][0][m][n], cv = acc[ai][1][m][n];
                    f32x4 pg, pv; if (m > 0) { pg = acc[ai][0][m > 0 ? m - 1 : 0][n]; pv = acc[ai][1][m > 0 ? m - 1 : 0][n]; } else { pg = halo_get(xl, ai, 0, n, wr, wc, fr, fq); pv = halo_get(xl, ai, 1, n, wr, wc, fr, fq); }
                    float o[4];
#pragma unroll
                    for (int j = 0; j < 4; ++j) {
                        const float a1 = __shfl(fr >= 15 ? pg[j] : cg[j], s1), a2 = __shfl(fr >= 14 ? pg[j] : cg[j], s2);
                        const float b1 = __shfl(fr >= 15 ? pv[j] : cv[j], s1), b2 = __shfl(fr >= 14 ? pv[j] : cv[j], s2);
                        const float gg = gb[j] + g2[j] * cg[j] + g1[j] * a1 + g0[j] * a2, vv = hb[j] + h2[j] * cv[j] + h1[j] * b1 + h0[j] * b2;
                        o[j] = silu_f(gg) * vv;
                    }
                    const int i = ai * HALF + wr * 64 + m * 16 + fr, l = l0 + i;
                    if (i >= 2 && l < LTOK) { u32x2 w; w.x = cvt_pk_bf16(o[0], o[1]); w.y = cvt_pk_bf16(o[2], o[3]); *(u32x2*)(ACT + (size_t)(rowbase + i) * DFF + c0) = w; }
                }
            asm volatile("" ::: "memory");
        }
    }
};

template <class Epi, class Sched, bool ALIGN_EPI = false, bool SP2 = false>
__device__ __forceinline__ void gemm_phase(PG8_LAS unsigned char* lds, const Gemm g, const Sched& S, const Epi& E) {
    const int tid = threadIdx.x, wid = __builtin_amdgcn_readfirstlane(tid >> 6), lane = tid & 63, wr = wid >> 2, wc = wid & 3, fr = lane & 15, fq = lane >> 4;
    const int K = g.K, nt = K / BK;
    unsigned voffA[2], voffB[2];
#pragma unroll
    for (int i = 0; i < 2; ++i) { int R, C; stage_rc(tid * 16 + i * 8192, R, C); const int Rb = Epi::PERM ? ((R & ~31) + perm32(R & 31)) : R;
        voffA[i] = (unsigned)(R * K + C) * 2u; voffB[i] = (unsigned)(Rb * K + C) * 2u; }
    const size_t kstep = (size_t)(BK * 2);
    const size_t hstep = (size_t)HALF * K * 2;
    const size_t tstep = 2 * hstep;
    const unsigned ldsw = (unsigned)wid * 1024u;
    const int aoff = lds_byte(wr * 64 + fr, fq * 8), boff = lds_byte(wc * 32 + fr, fq * 8);
#define PG8_SA(b, h) (((b) * 2 + (h)) * HTB)
#define PG8_SB(b, h) ((4 + (b) * 2 + (h)) * HTB)
#define PG8_STAGE(bufoff, gbase, voff) do { _Pragma("unroll") for (int _i = 0; _i < 2; ++_i) \
        __builtin_amdgcn_global_load_lds((const unsigned*)((const char*)(gbase) + (voff)[_i]), (PG8_LAS unsigned*)(lds + (bufoff) + ldsw + _i * 8192), 16, 0, 0); } while (0)
#define PG8_LDA(dst, b, h) do { _Pragma("unroll") for (int m = 0; m < 4; ++m) _Pragma("unroll") for (int k = 0; k < 2; ++k) dst[m][k] = *(const PG8_LAS bf16x8*)(lds + PG8_SA(b, h) + aoff + m * 2048 + k * 1024); } while (0)
#define PG8_LDB(dst, b, h) do { _Pragma("unroll") for (int n = 0; n < 2; ++n) _Pragma("unroll") for (int k = 0; k < 2; ++k) dst[n][k] = *(const PG8_LAS bf16x8*)(lds + PG8_SB(b, h) + boff + n * 2048 + k * 1024); } while (0)
#define PG8_MMA(ai, bj, At, Bt) do { __builtin_amdgcn_s_setprio(1); _Pragma("unroll") for (int m = 0; m < 4; ++m) _Pragma("unroll") for (int n = 0; n < 2; ++n) _Pragma("unroll") for (int k = 0; k < 2; ++k) \
        acc[ai][bj][m][n] = __builtin_amdgcn_mfma_f32_16x16x32_bf16(Bt[n][k], At[m][k], acc[ai][bj][m][n], 0, 0, 0); __builtin_amdgcn_s_setprio(0); } while (0)
#define PG8_WAIT_V(n) asm volatile("s_waitcnt vmcnt(" #n ")" ::: "memory")
#define PG8_WAIT_L(n) asm volatile("s_waitcnt lgkmcnt(" #n ")" ::: "memory")
#define PG8_BAR __builtin_amdgcn_s_barrier()
#define PG8_SCHED __builtin_amdgcn_sched_barrier(0)
    Unit cur, nxt; int ui = 0;
    if (!S.next(0, cur)) return;
    f32x4 acc[2][2][4][2];
#pragma unroll
    for (int a = 0; a < 2; ++a)
#pragma unroll
        for (int b = 0; b < 2; ++b)
#pragma unroll
            for (int m = 0; m < 4; ++m)
#pragma unroll
                for (int n = 0; n < 2; ++n) acc[a][b][m][n] = (f32x4){0.f, 0.f, 0.f, 0.f};
    bf16x8 At[4][2], B0[2][2], B1[2][2];
    const char* cA = (const char*)g.A + g.a_off(cur.pm); const char* cB = (const char*)g.Bt + (size_t)cur.pn * tstep;
    S.a_ready(cur);
    if constexpr (SP2) {
        PG8_STAGE(PG8_SB(0, 0), cB, voffB); PG8_STAGE(PG8_SB(0, 1), cB + hstep, voffB); PG8_STAGE(PG8_SA(0, 0), cA, voffA); PG8_STAGE(PG8_SA(0, 1), cA + hstep, voffA);
        if (wr == 1) PG8_BAR;
        PG8_WAIT_V(2); PG8_BAR;
        PG8_STAGE(PG8_SB(1, 0), cB + kstep, voffB); PG8_STAGE(PG8_SA(1, 0), cA + kstep, voffA); PG8_STAGE(PG8_SB(1, 1), cB + hstep + kstep, voffB);
        PG8_WAIT_V(6); PG8_BAR;
    } else {
        PG8_STAGE(PG8_SB(0, 0), cB, voffB); PG8_STAGE(PG8_SA(0, 0), cA, voffA); PG8_STAGE(PG8_SB(0, 1), cB + hstep, voffB); PG8_STAGE(PG8_SA(0, 1), cA + hstep, voffA);
        if (wr == 1) PG8_BAR;
        PG8_WAIT_V(4); PG8_BAR;
        PG8_STAGE(PG8_SB(1, 0), cB + kstep, voffB); PG8_STAGE(PG8_SA(1, 0), cA + kstep, voffA); PG8_STAGE(PG8_SB(1, 1), cB + hstep + kstep, voffB);
        PG8_WAIT_V(6); PG8_BAR;
    }
    for (;;) {
        const bool has_next = S.next(ui + 1, nxt);
        const char* nA = has_next ? (const char*)g.A + g.a_off(nxt.pm) : cA; const char* nB = has_next ? (const char*)g.Bt + (size_t)nxt.pn * tstep : cB;
        for (int t = 0; t < nt; t += 2) {
            const bool last = (t == nt - 2);
            const char* a1 = cA + (size_t)(t + 1) * kstep;
            const char* a2 = last ? nA : cA + (size_t)(t + 2) * kstep; const char* b2 = last ? nB : cB + (size_t)(t + 2) * kstep;
            const char* a3 = a2 + kstep; const char* b3 = b2 + kstep;
            if (last && has_next) S.a_ready(nxt);
            if constexpr (SP2) {
            PG8_LDB(B0, 0, 0); PG8_LDB(B1, 0, 1); PG8_SCHED; PG8_LDA(At, 0, 0); PG8_STAGE(PG8_SA(1, 1), a1 + hstep, voffA);
            PG8_WAIT_V(8); PG8_WAIT_L(0); PG8_BAR; PG8_MMA(0, 0, At, B0); PG8_MMA(0, 1, At, B1); PG8_BAR; PG8_SCHED;
            PG8_LDA(At, 0, 1); PG8_STAGE(PG8_SB(0, 0), b2, voffB); PG8_STAGE(PG8_SB(0, 1), b2 + hstep, voffB); PG8_STAGE(PG8_SA(0, 0), a2, voffA);
            PG8_WAIT_V(8); PG8_WAIT_L(0); PG8_BAR; PG8_MMA(1, 0, At, B0); PG8_MMA(1, 1, At, B1); PG8_BAR; PG8_SCHED;
            PG8_LDB(B0, 1, 0); PG8_LDB(B1, 1, 1); PG8_SCHED; PG8_LDA(At, 1, 0); PG8_STAGE(PG8_SA(0, 1), a2 + hstep, voffA);
            PG8_WAIT_V(8); PG8_WAIT_L(0); PG8_BAR; PG8_MMA(0, 0, At, B0); PG8_MMA(0, 1, At, B1); PG8_BAR; PG8_SCHED;
            PG8_LDA(At, 1, 1); PG8_STAGE(PG8_SB(1, 0), b3, voffB); PG8_STAGE(PG8_SB(1, 1), b3 + hstep, voffB); PG8_STAGE(PG8_SA(1, 0), a3, voffA);
            PG8_WAIT_V(8); PG8_WAIT_L(0); PG8_BAR; PG8_MMA(1, 0, At, B0); PG8_MMA(1, 1, At, B1); PG8_BAR; PG8_SCHED;
            } else {
            PG8_LDB(B0, 0, 0); PG8_SCHED; PG8_LDA(At, 0, 0); PG8_STAGE(PG8_SA(1, 1), a1 + hstep, voffA);
            PG8_WAIT_L(8); PG8_BAR; PG8_WAIT_L(0); PG8_MMA(0, 0, At, B0); PG8_BAR; PG8_SCHED;
            PG8_LDB(B1, 0, 1); PG8_STAGE(PG8_SB(0, 0), b2, voffB);
            PG8_BAR; PG8_WAIT_L(0); PG8_MMA(0, 1, At, B1); PG8_BAR;
            PG8_LDA(At, 0, 1); PG8_STAGE(PG8_SA(0, 0), a2, voffA);
            PG8_BAR; PG8_WAIT_L(0); PG8_MMA(1, 0, At, B0); PG8_BAR; PG8_SCHED;
            PG8_STAGE(PG8_SB(0, 1), b2 + hstep, voffB);
            PG8_WAIT_V(6); PG8_BAR; PG8_MMA(1, 1, At, B1); PG8_BAR;
            PG8_LDB(B0, 1, 0); PG8_SCHED; PG8_LDA(At, 1, 0); PG8_STAGE(PG8_SA(0, 1), a2 + hstep, voffA);
            PG8_WAIT_L(8); PG8_BAR; PG8_WAIT_L(0); PG8_MMA(0, 0, At, B0); PG8_BAR; PG8_SCHED;
            PG8_LDB(B1, 1, 1); PG8_STAGE(PG8_SB(1, 0), b3, voffB);
            PG8_BAR; PG8_WAIT_L(0); PG8_MMA(0, 1, At, B1); PG8_BAR;
            PG8_LDA(At, 1, 1); PG8_STAGE(PG8_SA(1, 0), a3, voffA);
            PG8_BAR; PG8_WAIT_L(0); PG8_MMA(1, 0, At, B0); PG8_BAR; PG8_SCHED;
            PG8_STAGE(PG8_SB(1, 1), b3 + hstep, voffB);
            PG8_WAIT_V(6); PG8_BAR; PG8_MMA(1, 1, At, B1); PG8_BAR;
            }
        }
        if constexpr (ALIGN_EPI) { if (wr == 0) PG8_BAR; }
        if constexpr (!Epi::AFTER_DRAIN) { E(acc, cur, wr, wc, fr, fq, lds + STAGE_BYTES); S.done(cur); }
        if (!has_next) break;
#pragma unroll
        for (int a = 0; a < 2; ++a)
#pragma unroll
            for (int b = 0; b < 2; ++b)
#pragma unroll
                for (int m = 0; m < 4; ++m)
#pragma unroll
                    for (int n = 0; n < 2; ++n) acc[a][b][m][n] = (f32x4){0.f, 0.f, 0.f, 0.f};
        cur = nxt; cA = nA; cB = nB; ++ui;
        if constexpr (ALIGN_EPI) { if (wr == 1) PG8_BAR; }
    }
    PG8_WAIT_V(0);
    if constexpr (!ALIGN_EPI) { if (wr == 0) PG8_BAR; }
    PG8_BAR;

#undef PG8_SA
#undef PG8_SB
#undef PG8_STAGE
#undef PG8_LDA
#undef PG8_LDB
#undef PG8_MMA
#undef PG8_WAIT_V
#undef PG8_WAIT_L
#undef PG8_BAR
#undef PG8_SCHED
}
}

#define LAS __attribute__((address_space(3)))
typedef unsigned short bf16;
typedef unsigned v4u __attribute__((ext_vector_type(4)));
typedef unsigned v2u __attribute__((ext_vector_type(2)));
typedef float f32x4 __attribute__((ext_vector_type(4)));
constexpr int NWAVES = 8, NTHR = 512;
constexpr int RING_BYTES = 131072, XCH_BYTES = 16384, LDS_BYTES = RING_BYTES + XCH_BYTES + 1024;

constexpr size_t MiB = 1u << 20;
constexpr size_t SZ_WIN = (size_t)NIN * DM * 2, SZ_WOUT = (size_t)DM * DI * 2, SZ_WKVQ = (size_t)3072 * DM * 2, SZ_WO = (size_t)DM * DM * 2, SZ_WUP = (size_t)NUP * DM * 2, SZ_WDN = (size_t)DM * DFF * 2;
constexpr size_t WS_WIN = 1 * MiB, WS_WOUT = WS_WIN + SZ_WIN, WS_WKVQ = WS_WOUT + SZ_WOUT, WS_WO = WS_WKVQ + SZ_WKVQ, WS_WUP0 = WS_WO + SZ_WO, WS_WUP1 = WS_WUP0 + SZ_WUP, WS_WDN0 = WS_WUP1 + SZ_WUP, WS_WDN1 = WS_WDN0 + SZ_WDN, WS_WEND = WS_WDN1 + SZ_WDN;
constexpr size_t WS_DT = 57 * MiB;
constexpr size_t WS_XBC = 60 * MiB;
constexpr size_t WS_H = WS_XBC;
constexpr size_t WS_Z = 158 * MiB;
constexpr size_t WS_ST = 223 * MiB;
constexpr size_t WS_ACT = 126 * MiB;
constexpr size_t WS_K = 126 * MiB, WS_V = 159 * MiB, WS_Q = 192 * MiB;
constexpr size_t WS_END = 256 * MiB;
static_assert(WS_WEND <= WS_DT && WS_DT + (size_t)MR * 32 * 4 <= WS_XBC && WS_XBC + (size_t)MR * CONVD * 2 <= WS_Z && WS_Z + (size_t)MR * DI * 2 <= WS_ST, "ws map 1");
static_assert(WS_H + (size_t)MR * DM * 4 <= WS_ACT && WS_ACT + (size_t)MR * DFF * 2 <= WS_END && WS_K + (size_t)MR * DM * 2 <= WS_V && WS_V + (size_t)MR * DM * 2 <= WS_Q && WS_Q + (size_t)MR * DM * 2 <= WS_END, "ws map 2");

__device__ __forceinline__ unsigned f2bf(float f) { unsigned u = __builtin_bit_cast(unsigned, f); return (u + 0x7fffu + ((u >> 16) & 1u)) >> 16; }
__device__ __forceinline__ unsigned pk2(float lo, float hi) { return f2bf(lo) | (f2bf(hi) << 16); }
__device__ __forceinline__ float wave_sum(float v) {
#pragma unroll
    for (int o = 1; o < 64; o <<= 1) v += __shfl_xor(v, o);
    return v;
}
__device__ __forceinline__ float bf_lo(unsigned u) { return __uint_as_float(u << 16); }
__device__ __forceinline__ float bf_hi(unsigned u) { return __uint_as_float(u & 0xffff0000u); }

__device__ __forceinline__ void transpose_item(const float* W, int pitch, int K, bf16* WT, int nrow0, int srccol0, int k0, const float* gain, LAS float* scr, int lane) {
#pragma unroll 8
    for (int i = 0; i < 32; ++i) { const int kk = 2 * i + (lane >> 5); float v = 0.f;
        if (srccol0 >= 0) { v = W[(size_t)(k0 + kk) * pitch + srccol0 + (lane & 31)]; if (gain) v *= gain[k0 + kk]; }
        scr[kk * 33 + (lane & 31)] = v; }
    asm volatile("s_waitcnt lgkmcnt(0)" ::: "memory");
    const int c = lane & 7;
#pragma unroll
    for (int j = 0; j < 4; ++j) { const int n = (lane >> 3) + 8 * j; const LAS float* s = scr + (8 * c) * 33 + n;
        v4u o; o.x = pk2(s[0 * 33], s[1 * 33]); o.y = pk2(s[2 * 33], s[3 * 33]); o.z = pk2(s[4 * 33], s[5 * 33]); o.w = pk2(s[6 * 33], s[7 * 33]);
        *(v4u*)(WT + (size_t)(nrow0 + n) * K + k0 + 8 * c) = o; }
    asm volatile("s_waitcnt lgkmcnt(0)" ::: "memory");
}

constexpr int SB_LB = 0, SB_LC = 17408, SB_LX = 34816, SB_LXW = 44032, SB_LST = 53248, SB_LDT = 70656, SB_LACS = 70912;
typedef short bf16x8_t __attribute__((ext_vector_type(8)));
typedef short s16x4_t __attribute__((ext_vector_type(4)));
__device__ __forceinline__ s16x4_t lds_tr16(LAS unsigned char* p) { return __builtin_bit_cast(s16x4_t, __builtin_amdgcn_ds_read_tr16_b64_v4i16((LAS s16x4_t*)p)); }
__device__ __forceinline__ bf16x8_t cat8(s16x4_t a, s16x4_t b) { return (bf16x8_t){a[0], a[1], a[2], a[3], b[0], b[1], b[2], b[3]}; }

template <int PASS> __device__ __forceinline__ void ssd_unit(LAS unsigned char* lds, int b, int c, int h, const bf16* xbc_c, bf16* xbc_w, const float* dtp, bf16* ST, float* DEC, float a, float dsk, int tid) {
    const int lane = tid & 63, wave = __builtin_amdgcn_readfirstlane(tid >> 6), fr = lane & 15, fq = lane >> 4, q2 = fr >> 2, p2 = lane & 3, g = h >> 3;
    const int lbase = 256 * c, nvalid = (LTOK - lbase) < 256 ? (LTOK - lbase) : 256, nsub = (nvalid + 63) >> 6;
    const size_t rowb = (size_t)b * BS + OFF;
    f32x4 ast[4];
#pragma unroll
    for (int pb = 0; pb < 4; ++pb) ast[pb] = (f32x4){0.f, 0.f, 0.f, 0.f};
    if (PASS == 2 && c > 0) {
        const bf16* sp = ST + ((size_t)((b * 32 + (c - 1)) * NHS + h)) * 8192;
#pragma unroll
        for (int pb = 0; pb < 4; ++pb) { const v2u w = *(const v2u*)(sp + (16 * pb + fr) * 128 + 16 * wave + 4 * fq); ast[pb] = (f32x4){bf_lo(w.x), bf_hi(w.x), bf_lo(w.y), bf_hi(w.y)}; }
    }
    float totlog = 0.f;
    v4u gB[2], gC[2], gX; float gdt;
    auto prefetch = [&](int j) {
        const int l0 = lbase + 64 * j;
#pragma unroll
        for (int k = 0; k < 2; ++k) { const int idx = tid + 512 * k, row = idx >> 4, ch = idx & 15; int l = l0 + row; l = l < LTOK ? l : LTOK - 1;
            const bf16* rp = xbc_c + (rowb + l) * CONVD + DI + g * 128 + ch * 8; gB[k] = *(const v4u*)rp; if (PASS == 2) gC[k] = *(const v4u*)(rp + 512); }
        { const int row = tid >> 3, ch = tid & 7; int l = l0 + row; l = l < LTOK ? l : LTOK - 1; gX = *(const v4u*)(xbc_c + (rowb + l) * CONVD + h * 64 + ch * 8); }
        { const int l = l0 + lane; gdt = l < LTOK ? dtp[(rowb + l) * NHS + h] : 0.f; }
    };
    prefetch(0);
    for (int j = 0; j < nsub; ++j) {
        float acs = gdt * a;
#pragma unroll
        for (int o = 1; o < 64; o <<= 1) { const float t = __shfl_up(acs, o); if (lane >= o) acs += t; }
        const float aend = __shfl(acs, 63);
        const float wrow = gdt * __expf(aend - acs);
        if (wave == 0) { ((LAS float*)(lds + SB_LDT))[lane] = gdt; ((LAS float*)(lds + SB_LACS))[lane] = acs; }
#pragma unroll
        for (int k = 0; k < 2; ++k) { const int idx = tid + 512 * k, row = idx >> 4, ch = idx & 15; *(LAS v4u*)(lds + SB_LB + row * 272 + ch * 16) = gB[k]; if (PASS == 2) *(LAS v4u*)(lds + SB_LC + row * 272 + ch * 16) = gC[k]; }
        { const int row = tid >> 3, ch = tid & 7; const float wv = __shfl(wrow, row & 63);
          if (PASS == 2) *(LAS v4u*)(lds + SB_LX + row * 144 + ch * 16) = gX;
          v4u xw;
#pragma unroll
          for (int e = 0; e < 4; ++e) xw[e] = pk2(bf_lo(gX[e]) * wv, bf_hi(gX[e]) * wv);
          *(LAS v4u*)(lds + SB_LXW + row * 144 + ch * 16) = xw; }
        if (PASS == 2) {
#pragma unroll
            for (int pb = 0; pb < 4; ++pb) *(LAS v2u*)(lds + SB_LST + (16 * pb + fr) * 272 + (16 * wave + 4 * fq) * 2) = (v2u){pk2(ast[pb][0], ast[pb][1]), pk2(ast[pb][2], ast[pb][3])};
        }
        __syncthreads();
        if (j + 1 < nsub) prefetch(j + 1);
        totlog += aend;
        if (PASS == 2) {
            const int ib = wave >> 1;
            bf16x8_t cf[4];
#pragma unroll
            for (int ks = 0; ks < 4; ++ks) cf[ks] = *(const LAS bf16x8_t*)(lds + SB_LC + (16 * ib + fr) * 272 + (32 * ks + 8 * fq) * 2);
            const float acs_i = ((const LAS float*)(lds + SB_LACS))[16 * ib + fr];
            const int irow = 16 * ib + fr;
            bf16x8_t pf[2];
#pragma unroll
            for (int kk = 0; kk < 2; ++kk) {
                unsigned pw[4];
#pragma unroll
                for (int hf = 0; hf < 2; ++hf) { const int sb = 2 * kk + hf;
                    if (sb <= ib) {
                        f32x4 d = (f32x4){0.f, 0.f, 0.f, 0.f};
#pragma unroll
                        for (int ks = 0; ks < 4; ++ks) { const bf16x8_t af = *(const LAS bf16x8_t*)(lds + SB_LB + (16 * sb + fr) * 272 + (32 * ks + 8 * fq) * 2); d = __builtin_amdgcn_mfma_f32_16x16x32_bf16(af, cf[ks], d, 0, 0, 0); }
                        const f32x4 as4 = *(const LAS f32x4*)(lds + SB_LACS + (16 * sb + 4 * fq) * 4), dt4 = *(const LAS f32x4*)(lds + SB_LDT + (16 * sb + 4 * fq) * 4);
                        float v[4];
#pragma unroll
                        for (int r = 0; r < 4; ++r) { const int s = 16 * sb + 4 * fq + r; const float e = __expf(fminf(acs_i - as4[r], 0.f)); v[r] = s <= irow ? d[r] * dt4[r] * e : 0.f; }
                        pw[2 * hf] = pk2(v[0], v[1]); pw[2 * hf + 1] = pk2(v[2], v[3]);
                    } else { pw[2 * hf] = 0u; pw[2 * hf + 1] = 0u; }
                }
                pf[kk] = __builtin_bit_cast(bf16x8_t, (v4u){pw[0], pw[1], pw[2], pw[3]});
            }
            const float ei = __expf(acs_i);
            const int l_row = lbase + 64 * j + irow;
#pragma unroll
            for (int pbi = 0; pbi < 2; ++pbi) { const int pb = 2 * (wave & 1) + pbi;
                f32x4 acc = (f32x4){0.f, 0.f, 0.f, 0.f};
#pragma unroll
                for (int ks = 0; ks < 4; ++ks) { const bf16x8_t af = *(const LAS bf16x8_t*)(lds + SB_LST + (16 * pb + fr) * 272 + (32 * ks + 8 * fq) * 2); acc = __builtin_amdgcn_mfma_f32_16x16x32_bf16(af, cf[ks], acc, 0, 0, 0); }
                acc = acc * ei;
#pragma unroll
                for (int kk = 0; kk < 2; ++kk) if (2 * kk <= ib) {
                    LAS unsigned char* xp = lds + SB_LX + (32 * kk + 4 * fq + q2) * 144 + 32 * pb + 8 * p2;
                    const bf16x8_t xa = cat8(lds_tr16(xp), lds_tr16(xp + 16 * 144));
                    acc = __builtin_amdgcn_mfma_f32_16x16x32_bf16(xa, pf[kk], acc, 0, 0, 0); }
                const v2u xw = *(const LAS v2u*)(lds + SB_LX + irow * 144 + (16 * pb + 4 * fq) * 2);
                const float y0 = acc[0] + dsk * bf_lo(xw.x), y1 = acc[1] + dsk * bf_hi(xw.x), y2 = acc[2] + dsk * bf_lo(xw.y), y3 = acc[3] + dsk * bf_hi(xw.y);
                if (l_row < LTOK) *(v2u*)(xbc_w + (rowb + l_row) * CONVD + h * 64 + 16 * pb + 4 * fq) = (v2u){pk2(y0, y1), pk2(y2, y3)};
            }
        }
        { const float ed = __expf(aend);
#pragma unroll
          for (int pb = 0; pb < 4; ++pb) ast[pb] = ast[pb] * ed;
#pragma unroll
          for (int kk = 0; kk < 2; ++kk) {
              LAS unsigned char* bp = lds + SB_LB + (32 * kk + 8 * fq + q2) * 272 + 32 * wave + 8 * p2;
              const bf16x8_t af = cat8(lds_tr16(bp), lds_tr16(bp + 4 * 272));
#pragma unroll
              for (int pb = 0; pb < 4; ++pb) { LAS unsigned char* xp = lds + SB_LXW + (32 * kk + 8 * fq + q2) * 144 + 32 * pb + 8 * p2;
                  const bf16x8_t bfg = cat8(lds_tr16(xp), lds_tr16(xp + 4 * 144));
                  ast[pb] = __builtin_amdgcn_mfma_f32_16x16x32_bf16(af, bfg, ast[pb], 0, 0, 0); } } }
        __syncthreads();
    }
    if (PASS == 1) {
        bf16* sp = ST + ((size_t)((b * 32 + c) * NHS + h)) * 8192;
#pragma unroll
        for (int pb = 0; pb < 4; ++pb) *(v2u*)(sp + (16 * pb + fr) * 128 + 16 * wave + 4 * fq) = (v2u){pk2(ast[pb][0], ast[pb][1]), pk2(ast[pb][2], ast[pb][3])};
        if (tid == 0) DEC[(b * 32 + c) * NHS + h] = __expf(totlog);
    }
}

constexpr int AT_LK = 0, AT_LV = 9216, AT_FLAG = 18432;
__device__ __forceinline__ void attn_unit(LAS unsigned char* lds, int b, int h, int qb, bf16* Qb, const bf16* Kb, const bf16* Vb, int tid) {
    const int lane = tid & 63, wave = __builtin_amdgcn_readfirstlane(tid >> 6), fr = lane & 15, fq = lane >> 4, q2 = fr >> 2, p2 = lane & 3;
    const int t0 = 128 * qb, tw = t0 + 16 * wave, t = tw + fr;
    const size_t rowb = (size_t)b * BS + OFF;
    const bool tvalid = t < LTOK;
    bf16x8_t qf[2];
    { const bf16* qp = Qb + (rowb + (tvalid ? t : LTOK - 1)) * DM + h * 64 + 8 * fq; qf[0] = *(const bf16x8_t*)qp; qf[1] = *(const bf16x8_t*)(qp + 32); }
    f32x4 oacc[4];
#pragma unroll
    for (int db = 0; db < 4; ++db) oacc[db] = (f32x4){0.f, 0.f, 0.f, 0.f};
    float carry = 0.f;
    bool wdone = !__any(tvalid);
    const int srow = tid >> 3, sch = tid & 7;
    int k0 = t0 + 64; if (k0 >= LTOK) k0 = t0;
    v4u gK, gV;
    { int s = k0 + srow; s = s < LTOK ? s : LTOK - 1; const size_t off = (rowb + s) * DM + h * 64 + sch * 8; gK = *(const v4u*)(Kb + off); gV = *(const v4u*)(Vb + off); }
    for (;;) {
        *(LAS v4u*)(lds + AT_LK + srow * 144 + sch * 16) = gK; *(LAS v4u*)(lds + AT_LV + srow * 144 + sch * 16) = gV;
        __syncthreads();
        if (k0 >= 64) { const size_t off = (rowb + (k0 - 64) + srow) * DM + h * 64 + sch * 8; gK = *(const v4u*)(Kb + off); gV = *(const v4u*)(Vb + off); }
        if (!wdone && k0 <= tw + 14) {
            f32x4 st[4];
#pragma unroll
            for (int sb = 0; sb < 4; ++sb) { f32x4 d = (f32x4){0.f, 0.f, 0.f, 0.f};
#pragma unroll
                for (int ks = 0; ks < 2; ++ks) { const bf16x8_t kf = *(const LAS bf16x8_t*)(lds + AT_LK + (16 * sb + fr) * 144 + (32 * ks + 8 * fq) * 2); d = __builtin_amdgcn_mfma_f32_16x16x32_bf16(kf, qf[ks], d, 0, 0, 0); }
                st[sb] = d; }
            float lsp[4][4], lk[4][4], ps[4];
#pragma unroll
            for (int sb = 0; sb < 4; ++sb) { ps[sb] = 0.f;
#pragma unroll
                for (int r = 0; r < 4; ++r) { const int s = k0 + 16 * sb + 4 * fq + r; const bool vis = tvalid && s < t; const float x = st[sb][r] * 0.125f;
                    const float l1 = fminf(x, 0.f) - __logf(1.0f + __expf(-fabsf(x)));
                    lsp[sb][r] = vis ? l1 : -1e30f; lk[sb][r] = vis ? l1 - x : 0.f; ps[sb] += lk[sb][r]; } }
            float run = carry;
            unsigned pw[8];
#pragma unroll
            for (int sb = 3; sb >= 0; --sb) {
                const float a = ps[sb], bq = __shfl_xor(a, 16), cq = __shfl_xor(a, 32), dq = __shfl_xor(bq, 32);
                const float sfq = ((fq & 1) == 0 ? bq : 0.f) + ((fq & 2) == 0 ? cq + dq : 0.f);
                float lat = run + sfq; float wv[4];
#pragma unroll
                for (int r = 3; r >= 0; --r) { wv[r] = __expf(lsp[sb][r] + lat); lat += lk[sb][r]; }
                pw[2 * sb] = pk2(wv[0], wv[1]); pw[2 * sb + 1] = pk2(wv[2], wv[3]);
                run += (a + bq) + (cq + dq);
            }
            carry = run;
            const bf16x8_t pf0 = __builtin_bit_cast(bf16x8_t, (v4u){pw[0], pw[1], pw[2], pw[3]}), pf1 = __builtin_bit_cast(bf16x8_t, (v4u){pw[4], pw[5], pw[6], pw[7]});
#pragma unroll
            for (int db = 0; db < 4; ++db) {
                LAS unsigned char* vp = lds + AT_LV + (4 * fq + q2) * 144 + 32 * db + 8 * p2;
                const bf16x8_t va0 = cat8(lds_tr16(vp), lds_tr16(vp + 16 * 144)), va1 = cat8(lds_tr16(vp + 32 * 144), lds_tr16(vp + 48 * 144));
                oacc[db] = __builtin_amdgcn_mfma_f32_16x16x32_bf16(va0, pf0, oacc[db], 0, 0, 0);
                oacc[db] = __builtin_amdgcn_mfma_f32_16x16x32_bf16(va1, pf1, oacc[db], 0, 0, 0); }
            wdone = __all(!tvalid || carry < -105.f);
        }
        if (lane == 0) ((LAS int*)(lds + AT_FLAG))[wave] = wdone ? 1 : 0;
        __syncthreads();
        k0 -= 64;
        if (k0 < 0) break;
        { const LAS int* fl = (const LAS int*)(lds + AT_FLAG); const int alld = fl[0] & fl[1] & fl[2] & fl[3] & fl[4] & fl[5] & fl[6] & fl[7]; if (alld) break; }
    }
    if (tvalid) { bf16* op = Qb + (rowb + t) * DM + h * 64 + 4 * fq;
#pragma unroll
        for (int db = 0; db < 4; ++db) *(v2u*)(op + 16 * db) = (v2u){pk2(oacc[db][0], oacc[db][1]), pk2(oacc[db][2], oacc[db][3])}; }
    __syncthreads();
}

constexpr int TAIL0 = 64 * 256, MMAIN = 64 * 256;
template <class F> __device__ __forceinline__ void tail_gemm(LAS unsigned char* lds, const bf16* A, const bf16* Bt, int K, int ncb, int bx, int G, int tid, const F& epi) {
    const int lane = tid & 63, wave = __builtin_amdgcn_readfirstlane(tid >> 6), fr = lane & 15, fq = lane >> 4, kw = K >> 3;
    for (int cb = bx; cb < ncb; cb += G) {
        f32x4 acc[4];
#pragma unroll
        for (int rb = 0; rb < 4; ++rb) acc[rb] = (f32x4){0.f, 0.f, 0.f, 0.f};
        const bf16* bp = Bt + (size_t)(16 * cb + fr) * K + wave * kw + 8 * fq;
        const bf16* ap = A + (size_t)(TAIL0 + fr) * K + wave * kw + 8 * fq;
        for (int k = 0; k < kw; k += 32) {
            const bf16x8_t bfg = *(const bf16x8_t*)(bp + k);
#pragma unroll
            for (int rb = 0; rb < 4; ++rb) { const bf16x8_t afg = *(const bf16x8_t*)(ap + (size_t)rb * 16 * K + k); acc[rb] = __builtin_amdgcn_mfma_f32_16x16x32_bf16(bfg, afg, acc[rb], 0, 0, 0); }
        }
        LAS f32x4* P = (LAS f32x4*)lds;
#pragma unroll
        for (int rb = 0; rb < 4; ++rb) P[(wave * 4 + rb) * 64 + lane] = acc[rb];
        __syncthreads();
        if (wave < 4) { f32x4 s = (f32x4){0.f, 0.f, 0.f, 0.f};
#pragma unroll
            for (int w = 0; w < 8; ++w) s += P[(w * 4 + wave) * 64 + lane];
            epi(s, TAIL0 + 16 * wave + fr, 16 * cb + 4 * fq); }
        __syncthreads();
    }
}
template <int mode> struct TailResid { float* H; const float* x;
    __device__ __forceinline__ void operator()(f32x4 s, int row, int col0) const {
        float* hp = H + (size_t)row * DM + col0; const int l = row - BS - OFF;
        const float* bp = mode == 0 ? hp : x + ((size_t)SEQ + (l - NMETA)) * DM + col0;
        *(f32x4*)hp = *(const f32x4*)bp + s; } };
struct TailKVQ { bf16* Kb; size_t stride;
    __device__ __forceinline__ void operator()(f32x4 s, int row, int col0) const {
        const int t = col0 >> 10; bf16* op = Kb + (size_t)t * stride + (size_t)row * DM + (col0 & 1023);
        *(v2u*)op = (v2u){pk2(s[0], s[1]), pk2(s[2], s[3])}; } };

typedef __attribute__((address_space(1))) unsigned gu32;
#define XB_TMO      128
#define XB_XCNT(j)  (256  + 64 * (j))
#define XB_XSUB(j)  (1280 + 64 * (j))
#define XB_XGEN(j)  (2304 + 64 * (j))
#define XB_TOP      3328
#define XB_TOPGEN   3392
#define XCD_BAR_WORDS 3456
#define XB_SPIN_CAP (1u << 18)

__device__ __forceinline__ unsigned xb_ld(unsigned* p)              { return __hip_atomic_load(p, __ATOMIC_RELAXED, __HIP_MEMORY_SCOPE_AGENT); }
__device__ __forceinline__ unsigned xb_add(unsigned* p, unsigned v) { return __hip_atomic_fetch_add(p, v, __ATOMIC_RELAXED, __HIP_MEMORY_SCOPE_AGENT); }
__device__ __forceinline__ unsigned xb_xcc_id() { return (unsigned)__builtin_amdgcn_s_getreg((3 << 11) | 20) & 0xFu; }
#define XB_SPIN(cond, bar) do { unsigned _sp = 0; while (cond) { __builtin_amdgcn_s_sleep(1); \
    if ((++_sp & 255u) == 0u) { if (xb_ld(&(bar)[XB_TMO])) break; if (_sp > XB_SPIN_CAP) { atomicAdd(&(bar)[XB_TMO], 1u); break; } } } } while (0)

struct XcdBarrier {
    unsigned* bar; unsigned x;
    volatile LAS unsigned* st;
};

__device__ __forceinline__ XcdBarrier xcd_barrier_post(unsigned* bar, volatile LAS unsigned* st) {
    XcdBarrier b; b.bar = bar; b.x = xb_xcc_id(); b.st = st;
    if (threadIdx.x == 0) (void)xb_add(&bar[XB_XCNT(b.x)], 1u);
    return b;
}
__device__ __forceinline__ void xcd_barrier_complete(unsigned* bar, unsigned x, unsigned& nloc, unsigned& nx) {
    const unsigned G = gridDim.x * gridDim.y * gridDim.z;
    unsigned sum, cnt, mine, sp = 0u;
    for (;;) {
        sum = 0u; cnt = 0u; mine = 0u;
#pragma unroll
        for (unsigned j = 0; j < 16; ++j) { const unsigned c = xb_ld(&bar[XB_XCNT(j)]); sum += c; cnt += (c > 0u) ? 1u : 0u; mine = (j == x) ? c : mine; }
        if (sum == G) break;
        __builtin_amdgcn_s_sleep(1);
        if ((++sp & 255u) == 0u) { if (xb_ld(&bar[XB_TMO])) break; if (sp > XB_SPIN_CAP) { atomicAdd(&bar[XB_TMO], 1u); break; } }
    }
    nloc = mine > 0u ? mine : 1u; nx = cnt > 0u ? cnt : 1u;
}

__device__ __forceinline__ void xcd_barrier(const XcdBarrier& b) {
    asm volatile("s_waitcnt vmcnt(0)" ::: "memory");
    __syncthreads();
    if (threadIdx.x == 0) {
        unsigned* bar = b.bar;
        __builtin_amdgcn_s_waitcnt(0);
        unsigned nloc = b.st[0], nx = b.st[1];
        if (nloc == 0u) { xcd_barrier_complete(bar, b.x, nloc, nx); b.st[0] = nloc; b.st[1] = nx; }
        const unsigned old = xb_add(&bar[XB_XSUB(b.x)], 1u);
        const unsigned gen = old / nloc;
        if (old + 1u == (gen + 1u) * nloc) {
            __builtin_amdgcn_fence(__ATOMIC_RELEASE, "agent");
            asm volatile("s_waitcnt vmcnt(0)" ::: "memory");
            const unsigned og = xb_add(&bar[XB_TOP], 1u);
            const unsigned tg = og / nx;
            if (og + 1u == (tg + 1u) * nx) xb_add(&bar[XB_TOPGEN], 1u);
            else XB_SPIN(xb_ld(&bar[XB_TOPGEN]) == tg, bar);
            __builtin_amdgcn_fence(__ATOMIC_ACQUIRE, "agent");
            xb_add(&bar[XB_XGEN(b.x)], 1u);
            asm volatile("s_waitcnt vmcnt(0)" ::: "memory");
        } else {
            XB_SPIN(xb_ld(&bar[XB_XGEN(b.x)]) == gen, bar);
            __builtin_amdgcn_fence(__ATOMIC_ACQUIRE, "agent");
            asm volatile("s_waitcnt vmcnt(0)" ::: "memory");
        }
    }
    __syncthreads();
}

struct Args {
    const float* in[22]; float* outp; unsigned char* wsp; int ph_lo, ph_hi, coop, pad;
};

__device__ __forceinline__ void norm_row(const float* src, bf16* dst, int lane) {
    v2u* o8 = (v2u*)dst + lane;
    if (!src) {
#pragma unroll
        for (int j = 0; j < 4; ++j) o8[64 * j] = (v2u){0u, 0u};
        return; }
    const f32x4* xr = (const f32x4*)src + lane;
    f32x4 v[4]; float s = 0.f;
#pragma unroll
    for (int j = 0; j < 4; ++j) { v[j] = xr[64 * j]; s += (v[j].x * v[j].x + v[j].y * v[j].y) + (v[j].z * v[j].z + v[j].w * v[j].w); }
    const float rstd = 1.0f / sqrtf(wave_sum(s) * (1.f / DM) + EPS);
#pragma unroll
    for (int j = 0; j < 4; ++j) o8[64 * j] = (v2u){pk2(v[j].x * rstd, v[j].y * rstd), pk2(v[j].z * rstd, v[j].w * rstd)};
}
__device__ __forceinline__ const float* stream_row(int r, int mode, const float* H, const float* x, const float* meta) {
    if (r >= 2 * BS) return nullptr;
    const int b = r >= BS ? 1 : 0, l = r - b * BS - OFF;
    if (l < 0 || l >= LTOK) return nullptr;
    if (mode == 0) return H + (size_t)r * DM;
    return l < NMETA ? meta + (size_t)l * DM : x + ((size_t)b * SEQ + (l - NMETA)) * DM;
}

__device__ __forceinline__ const void* ptab(volatile LAS unsigned* PT, int k) {
    const unsigned lo_ = PT[2 * k], hi_ = PT[2 * k + 1];
    return (const void*)(const __attribute__((address_space(1))) void*)(((unsigned long long)(unsigned)__builtin_amdgcn_readfirstlane((int)hi_) << 32) | (unsigned long long)(unsigned)__builtin_amdgcn_readfirstlane((int)lo_));
}
#define xin ((const float*)ptab(PT, 0))
#define metain ((const float*)ptab(PT, 1))
#define ssd_norm ((const float*)ptab(PT, 2))
#define ssd_w_in ((const float*)ptab(PT, 3))
#define ssd_conv_w ((const float*)ptab(PT, 4))
#define ssd_conv_b ((const float*)ptab(PT, 5))
#define ssd_dt_bias ((const float*)ptab(PT, 6))
#define ssd_a_log ((const float*)ptab(PT, 7))
#define ssd_d_skip ((const float*)ptab(PT, 8))
#define ssd_gate_norm ((const float*)ptab(PT, 9))
#define ssd_w_out ((const float*)ptab(PT, 10))
#define kv_norm ((const float*)ptab(PT, 11))
#define w_kv ((const float*)ptab(PT, 12))
#define sb_norm ((const float*)ptab(PT, 13))
#define sb_w_q ((const float*)ptab(PT, 14))
#define sb_w_o ((const float*)ptab(PT, 15))
#define ffn_norm ((const float*)ptab(PT, 16))
#define ffn_w_up ((const float*)ptab(PT, 17))
#define ffn_conv_w ((const float*)ptab(PT, 18))
#define ffn_conv_b ((const float*)ptab(PT, 19))
#define ffn_w_down ((const float*)ptab(PT, 20))
#define final_norm ((const float*)ptab(PT, 21))
#define ws ((unsigned char*)ptab(PT, 22))
#define Win ((bf16*)(ws + WS_WIN))
#define Wout ((bf16*)(ws + WS_WOUT))
#define Wkvq ((bf16*)(ws + WS_WKVQ))
#define Wo ((bf16*)(ws + WS_WO))
#define Wup0 ((bf16*)(ws + WS_WUP0))
#define Wup1 ((bf16*)(ws + WS_WUP1))
#define Wdn0 ((bf16*)(ws + WS_WDN0))
#define Wdn1 ((bf16*)(ws + WS_WDN1))
#define DT ((float*)(ws + WS_DT))
#define XBC ((bf16*)(ws + WS_XBC))
#define H ((float*)(ws + WS_H))
#define Z ((bf16*)(ws + WS_Z))
#define ACT ((bf16*)(ws + WS_ACT))
#define KB ((bf16*)(ws + WS_K))
#define VB ((bf16*)(ws + WS_V))
#define QB ((bf16*)(ws + WS_Q))
#define XN ((bf16*)ptab(PT, 23))
#define OUTP ((float*)ptab(PT, 23))
__global__ void __launch_bounds__(NTHR, 2) mega(const Args args) {
    extern __shared__ __attribute__((aligned(16))) unsigned char lds_raw[];
    LAS unsigned char* lds = (LAS unsigned char*)lds_raw;
    const int tid = threadIdx.x, lane = tid & 63, wave = __builtin_amdgcn_readfirstlane(tid >> 6);
    const int G = gridDim.x, bx = blockIdx.x;
    const int gw = bx * NWAVES + wave, NGW = G * NWAVES;
    volatile LAS unsigned* PT = (volatile LAS unsigned*)(lds + RING_BYTES + XCH_BYTES);
    if (tid >= 64 && tid < 66) ((volatile LAS unsigned*)(lds + RING_BYTES + XCH_BYTES + 512))[tid - 64] = 0u;
    if (tid < 24) { const unsigned long long pv = tid < 22 ? (unsigned long long)args.in[tid] : (tid == 22 ? (unsigned long long)args.wsp : (unsigned long long)args.outp); PT[2 * tid] = (unsigned)pv; PT[2 * tid + 1] = (unsigned)(pv >> 32); }
    __syncthreads();
    volatile unsigned long long* TS = (volatile unsigned long long*)(ws + 65536);
#define STAMP(i) do { if (PROBE_ON && bx == 0 && tid == 0) TS[i] = __builtin_amdgcn_s_memrealtime(); } while (0)
    const int lo = args.ph_lo, hi = args.ph_hi;
#define IN(k) (lo <= (k) && (k) < hi)
    constexpr size_t WS_BAR = 131072;
    XcdBarrier xbar; xbar.bar = (unsigned*)(ws + WS_BAR); xbar.x = 0; xbar.st = (volatile LAS unsigned*)(lds + RING_BYTES + XCH_BYTES + 512);
#define SEAM(k) do { if (args.coop && IN(k) && IN((k) + 1)) { xcd_barrier(xbar); } } while (0)

    STAMP(0); if (IN(0)) {
        LAS float* scr = (LAS float*)(lds + wave * 16384);
        constexpr int I_IN = 16 * (NIN / 32), I_OUT = 32 * 32, I_KVQ = 16 * 96, I_O = 16 * 32, I_UP = 16 * (NUP / 32), I_DN = 44 * 32;
        constexpr int NITEMS = I_IN + I_OUT + I_KVQ + I_O + 2 * I_UP + 2 * I_DN;
        for (int it = gw; it < NITEMS; it += NGW) {
            int r = it;
            if (r < I_IN) { const int nb = r % (NIN / 32), kb = r / (NIN / 32), n0 = nb * 32; transpose_item(ssd_w_in, NIN_REAL, DM, Win, n0, n0 < NIN_REAL ? n0 : -1, kb * 64, ssd_norm, scr, lane); continue; } r -= I_IN;
            if (r < I_OUT) { const int nb = r % 32, kb = r / 32; transpose_item(ssd_w_out, DM, DI, Wout, nb * 32, nb * 32, kb * 64, ssd_gate_norm, scr, lane); continue; } r -= I_OUT;
            if (r < I_KVQ) { const int nb = r % 96, kb = r / 96, n0 = nb * 32;
                if (n0 < 2048) transpose_item(w_kv, 2048, DM, Wkvq, n0, n0, kb * 64, kv_norm, scr, lane); else transpose_item(sb_w_q, DM, DM, Wkvq, n0, n0 - 2048, kb * 64, sb_norm, scr, lane);
                continue; } r -= I_KVQ;
            if (r < I_O) { const int nb = r % 32, kb = r / 32; transpose_item(sb_w_o, DM, DM, Wo, nb * 32, nb * 32, kb * 64, nullptr, scr, lane); continue; } r -= I_O;
            if (r < 2 * I_UP) { const int ly = r / I_UP; r -= ly * I_UP; const int nb = r % (NUP / 32), kb = r / (NUP / 32), n0 = nb * 32;
                const int src = ((n0 >> 7) & 1) * DFF + (n0 >> 8) * 128 + (n0 & 127);
                transpose_item(ffn_w_up + (size_t)ly * DM * NUP, NUP, DM, ly ? Wup1 : Wup0, n0, src, kb * 64, ffn_norm + ly * DM, scr, lane); continue; } r -= 2 * I_UP;
            { const int ly = r / I_DN; r -= ly * I_DN; const int nb = r % 32, kb = r / 32;
              transpose_item(ffn_w_down + (size_t)ly * DFF * DM, DM, DFF, ly ? Wdn1 : Wdn0, nb * 32, nb * 32, kb * 64, nullptr, scr, lane); }
        }
        for (int r = gw; r < MRX; r += NGW) norm_row(stream_row(r, 1, H, xin, metain), XN + (size_t)r * DM, lane);
    }
    if (args.coop) {
        if (bx == 0) { unsigned* bw = (unsigned*)(ws + WS_BAR); for (int i_ = tid; i_ < XCD_BAR_WORDS; i_ += NTHR) bw[i_] = 0u; }
        cg::this_grid().sync();
        xbar = xcd_barrier_post((unsigned*)(ws + WS_BAR), (volatile LAS unsigned*)(lds + RING_BYTES + XCH_BYTES + 512));
    }
    STAMP(1); if (IN(1)) {
        pg8::Gemm g{XN, Win, 2 * TPB * 256, NIN, DM, 3}; pg8::StaticOrder S; S.init(2 * TPB * 256, NIN, G, bx);
        pg8::EpiInProj E{Z, XBC, DT, ssd_conv_w, ssd_conv_b, ssd_dt_bias};
        pg8::gemm_phase<pg8::EpiInProj, pg8::StaticOrder, true, true>(lds, g, S, E);
    }
    SEAM(1);
    STAMP(2); if (IN(2)) {
        bf16* xbc = XBC; const float* dtp = DT; bf16* ST = (bf16*)(ws + WS_ST); float* DEC = (float*)(ws + 4096);
        for (int u = bx; u < NBATCH * 32 * NHS; u += G) { const int h = u % NHS, c = (u / NHS) % 32, b = u / (NHS * 32);
            ssd_unit<1>(lds, b, c, h, xbc, xbc, dtp, ST, DEC, -__expf(ssd_a_log[h]), 0.f, tid); }
        if (args.coop) xcd_barrier(xbar);
        STAMP(20);
        { const int gt = bx * NTHR + tid;
          if (gt < NBATCH * NHS * 1024) { const int bh = gt >> 10, e = gt & 1023, b = bh / NHS, h = bh % NHS; float run[8];
#pragma unroll
              for (int k = 0; k < 8; ++k) run[k] = 0.f;
              for (int c = 0; c < 32; ++c) { v4u* sp = (v4u*)(ST + ((size_t)((b * 32 + c) * NHS + h)) * 8192 + e * 8); const v4u w = *sp; const float d = DEC[(b * 32 + c) * NHS + h];
#pragma unroll
                  for (int k = 0; k < 4; ++k) { run[2 * k] = run[2 * k] * d + bf_lo(w[k]); run[2 * k + 1] = run[2 * k + 1] * d + bf_hi(w[k]); }
                  *sp = (v4u){pk2(run[0], run[1]), pk2(run[2], run[3]), pk2(run[4], run[5]), pk2(run[6], run[7])}; } } }
        if (args.coop) xcd_barrier(xbar);
        STAMP(21);
        for (int u = bx; u < NBATCH * 33 * NHS; u += G) { const int h = u % NHS, c = (u / NHS) % 33, b = u / (NHS * 33);
            ssd_unit<2>(lds, b, c, h, xbc, xbc, dtp, ST, DEC, -__expf(ssd_a_log[h]), ssd_d_skip[h], tid); }
    }
    SEAM(2);
    STAMP(3); if (IN(3)) {
        for (int r = gw; r < 2 * BS; r += NGW) {
            const int b = r >= BS ? 1 : 0, l = r - b * BS - OFF; if (l < 0 || l >= LTOK) continue;
#pragma unroll
            for (int g = 0; g < 4; ++g) {
                const v4u yq = *(const v4u*)(XBC + (size_t)r * CONVD + g * 512 + lane * 8); v4u* zp = (v4u*)(Z + (size_t)r * DI + g * 512 + lane * 8); const v4u zq = *zp;
                float hv[8]; float ss = 0.f;
#pragma unroll
                for (int e = 0; e < 4; ++e) { const float y0 = bf_lo(yq[e]), y1 = bf_hi(yq[e]), z0 = bf_lo(zq[e]), z1 = bf_hi(zq[e]);
                    hv[2 * e] = y0 * pg8::silu_f(z0); hv[2 * e + 1] = y1 * pg8::silu_f(z1); ss += hv[2 * e] * hv[2 * e] + hv[2 * e + 1] * hv[2 * e + 1]; }
                const float rs = 1.0f / sqrtf(wave_sum(ss) * (1.f / 512.f) + EPS);
                *zp = (v4u){pk2(hv[0] * rs, hv[1] * rs), pk2(hv[2] * rs, hv[3] * rs), pk2(hv[4] * rs, hv[5] * rs), pk2(hv[6] * rs, hv[7] * rs)};
            }
        }
    }
    SEAM(3);
    STAMP(4); if (IN(4)) {
        { TailResid<1> te{H, xin}; tail_gemm(lds, Z, Wout, DI, DM / 16, bx, G, tid, te); }
        pg8::Gemm g{Z, Wout, MMAIN, DM, DI, 0}; pg8::StaticOrder S; S.init(MMAIN, DM, G, bx);
        pg8::EpiResid<1> E{H, xin, metain};
        pg8::gemm_phase<pg8::EpiResid<1>, pg8::StaticOrder, true, true>(lds, g, S, E);
    }
    SEAM(4);
#pragma unroll 1
    for (int ly = 0; ly < 2; ++ly) {
        const int pb = ly == 0 ? 5 : 12;
        if (ly == 1) {
            STAMP(8); if (IN(8)) { for (int r = gw; r < MRX; r += NGW) norm_row(stream_row(r, 0, H, xin, metain), XN + (size_t)r * DM, lane); }
            SEAM(8);
            STAMP(9); if (IN(9)) {
                { TailKVQ te{KB, (size_t)(WS_V - WS_K) / 2}; tail_gemm(lds, XN, Wkvq, DM, 3072 / 16, bx, G, tid, te); }
                pg8::Gemm g{XN, Wkvq, MMAIN, 3072, DM, 0}; pg8::StaticOrder S; S.init(MMAIN, 3072, G, bx);
                pg8::EpiBf16 E{KB, DM, DM, (size_t)(WS_V - WS_K) / 2};
                pg8::gemm_phase<pg8::EpiBf16, pg8::StaticOrder, true, true>(lds, g, S, E);
            }
            SEAM(9);
            STAMP(10); if (IN(10)) {
                constexpr int NQB = (LTOK + 127) / 128;
                bf16* qb_ = QB; const bf16* kb_ = KB; const bf16* vb_ = VB;
                for (int u = bx; u < NBATCH * 16 * NQB; u += G) { const int hh = u % 16, qi = (u / 16) % NQB, bb = u / (16 * NQB);
                    attn_unit(lds, bb, hh, qi, qb_, kb_, vb_, tid); }
            }
            SEAM(10);
            STAMP(11); if (IN(11)) {
                { TailResid<0> te{H, nullptr}; tail_gemm(lds, QB, Wo, DM, DM / 16, bx, G, tid, te); }
                pg8::Gemm g{QB, Wo, MMAIN, DM, DM, 0}; pg8::StaticOrder S; S.init(MMAIN, DM, G, bx);
                pg8::EpiResid<0> E{H, nullptr, nullptr};
                pg8::gemm_phase<pg8::EpiResid<0>, pg8::StaticOrder, true, true>(lds, g, S, E);
            }
            SEAM(11);
        }
        STAMP(pb); if (IN(pb)) { for (int r = gw; r < MRX; r += NGW) norm_row(stream_row(r, 0, H, xin, metain), XN + (size_t)r * DM, lane); }
        SEAM(pb);
        STAMP(pb + 1); if (IN(pb + 1)) {
            pg8::Gemm g{XN, ly ? Wup1 : Wup0, 2 * TPB * 256, NUP, DM, 2}; pg8::StaticOrder S; S.init(2 * TPB * 256, NUP, G, bx);
            pg8::EpiUp E{ACT, ffn_conv_w + (size_t)ly * 3 * NUP, ffn_conv_b + (size_t)ly * NUP};
            pg8::gemm_phase<pg8::EpiUp, pg8::StaticOrder, true, true>(lds, g, S, E);
        }
        SEAM(pb + 1);
        STAMP(pb + 2); if (IN(pb + 2)) {
            { TailResid<0> te{H, nullptr}; tail_gemm(lds, ACT, ly ? Wdn1 : Wdn0, DFF, DM / 16, bx, G, tid, te); }
            pg8::Gemm g{ACT, ly ? Wdn1 : Wdn0, MMAIN, DM, DFF, 0}; pg8::StaticOrder S; S.init(MMAIN, DM, G, bx);
            pg8::EpiResid<0> E{H, nullptr, nullptr};
            pg8::gemm_phase<pg8::EpiResid<0>, pg8::StaticOrder, true, true>(lds, g, S, E);
        }
        SEAM(pb + 2);
    }
#if EXTRA_SYNCS
    if (args.coop) { for (int i_ = 0; i_ < EXTRA_SYNCS; ++i_) xcd_barrier(xbar); }
#endif
    STAMP(15);
    float probe_b = 0.f;
    if (PROBE_ON) {
#define TD(i, j) ((float)(TS[j] - TS[i]) * 0.01f)
        probe_b = (PROBE_EXPR) * (1.0f / 200.0f);
#undef TD
    }
    if (IN(15)) {
        for (int r = gw; r < NBATCH * SEQ; r += NGW) {
            const int b = r / SEQ, t = r % SEQ; const f32x4* xr = (const f32x4*)(H + (size_t)(b * BS + OFF + NMETA + t) * DM) + lane;
            f32x4 v[4]; float s = 0.f;
#pragma unroll
            for (int j = 0; j < 4; ++j) { v[j] = xr[64 * j]; s += (v[j].x * v[j].x + v[j].y * v[j].y) + (v[j].z * v[j].z + v[j].w * v[j].w); }
            const float rstd = 1.0f / sqrtf(wave_sum(s) * (1.f / DM) + EPS);
            f32x4* op = (f32x4*)(OUTP + (size_t)r * DM) + lane; const f32x4* gp = (const f32x4*)final_norm + lane;
#pragma unroll
            for (int j = 0; j < 4; ++j) op[64 * j] = PROBE_ON ? (f32x4){probe_b, probe_b, probe_b, probe_b} : v[j] * rstd * gp[64 * j];
        }
    }
#undef IN
#undef SEAM
}

#undef xin
#undef metain
#undef ssd_norm
#undef ssd_w_in
#undef ssd_conv_w
#undef ssd_conv_b
#undef ssd_dt_bias
#undef ssd_a_log
#undef ssd_d_skip
#undef ssd_gate_norm
#undef ssd_w_out
#undef kv_norm
#undef w_kv
#undef sb_norm
#undef sb_w_q
#undef sb_w_o
#undef ffn_norm
#undef ffn_w_up
#undef ffn_conv_w
#undef ffn_conv_b
#undef ffn_w_down
#undef final_norm
#undef ws
#undef Win
#undef Wout
#undef Wkvq
#undef Wo
#undef Wup0
#undef Wup1
#undef Wdn0
#undef Wdn1
#undef DT
#undef XBC
#undef H
#undef Z
#undef ACT
#undef KB
#undef VB
#undef QB
#undef XN
#undef OUTP
constexpr int NPHASES = 16;
extern "C" void kernel_launch(void* const* d_in, const int* in_sizes, int n_in, void* d_out, int out_size, void* d_ws, size_t ws_size, hipStream_t stream) {
    static int grid = 0;
    if (grid == 0) {
        if (n_in != 22 || ws_size < WS_END || out_size != NBATCH * SEQ * DM) { fprintf(stderr, "kernel_launch: unexpected shapes (n_in %d ws %zu out %d)\n", n_in, ws_size, out_size); grid = -1; return; }
        int dev = 0, cus = 0, per_cu = 0;
        (void)hipGetDevice(&dev); (void)hipDeviceGetAttribute(&cus, hipDeviceAttributeMultiprocessorCount, dev);
        (void)hipFuncSetAttribute((const void*)mega, hipFuncAttributeMaxDynamicSharedMemorySize, LDS_BYTES);
        (void)hipOccupancyMaxActiveBlocksPerMultiprocessor(&per_cu, (const void*)mega, NTHR, LDS_BYTES);
        (void)hipGetLastError();
        if (per_cu < 1) per_cu = 1;
        grid = cus * 1;
    }
    if (grid < 0) return;
    Args a{};
    for (int i = 0; i < 22; ++i) a.in[i] = (const float*)d_in[i];
    a.outp = (float*)d_out; a.wsp = (unsigned char*)d_ws;
#if MK_COOP
    a.ph_lo = 0; a.ph_hi = NPHASES; a.coop = 1;
    void* kargs[] = {&a};
    hipError_t e = hipLaunchCooperativeKernel((const void*)mega, dim3(grid), dim3(NTHR), kargs, LDS_BYTES, stream);
    if (e != hipSuccess) fprintf(stderr, "cooperative launch failed: %s (grid %d)\n", hipGetErrorString(e), grid);
#else
    for (int p = 0; p < NPHASES; ++p) { a.ph_lo = p; a.ph_hi = p + 1; a.coop = 0; hipLaunchKernelGGL(mega, dim3(grid), dim3(NTHR), LDS_BYTES, stream, a); }
#endif
}
```

```cpp
#include <hip/hip_runtime.h>
#include <hip/hip_cooperative_groups.h>
#include <cstdio>
#include <cstdint>
namespace cg = cooperative_groups;

constexpr int DM = 1024, NBATCH = 2, SEQ = 8192, NMETA = 16, LTOK = NMETA + SEQ;
constexpr int BS = 8224, OFF = 16;
constexpr int MR = 65 * 256;
constexpr int MRX = 66 * 256;
constexpr int TPB = 33;
constexpr int DI = 2048, NSTATE = 128, NHS = 32, CONVD = 3072, NIN = 5376, NIN_REAL = 5152;
constexpr int DFF = 2816, NUP = 5632;
constexpr float EPS = 1e-6f;

#ifndef MK_COOP
#define MK_COOP 1
#endif
#define PROBE_ON 0
#define PROBE_EXPR 0.f
#define EXTRA_SYNCS 0
namespace pg8 {
#define PG8_LAS __attribute__((address_space(3)))
typedef unsigned short bf16_t;
typedef short bf16x8 __attribute__((ext_vector_type(8)));
typedef float f32x4 __attribute__((ext_vector_type(4)));
typedef unsigned u32x4 __attribute__((ext_vector_type(4)));
constexpr int BM = 256, BK = 64, HALF = 128, HTB = HALF * BK * 2  , STAGE_BYTES = 8 * HTB, NXCD = 8, WGM = 8;

__host__ __device__ __forceinline__ int lds_byte(int r, int c) { const int st = (r >> 4) * 2 + (c >> 5), rr = r & 15, cc = c & 31, ob = rr * 64 + cc * 2; return st * 1024 + (ob ^ (((ob >> 9) & 1) << 5)); }
__host__ __device__ __forceinline__ void stage_rc(int b, int& R, int& C) { const int st = b / 1024, sb = b % 1024, swz = sb ^ (((sb >> 9) & 1) << 5); R = (st >> 1) * 16 + swz / 64; C = (st & 1) * 32 + (swz % 64) / 2; }
__host__ __device__ __forceinline__ int perm32(int rho) { const int n = rho >> 4, i = rho & 15; return 8 * (i >> 2) + 4 * n + (i & 3); }

struct Unit { int pm, pn; };
struct Gemm { const bf16_t* A; const bf16_t* Bt; int M, N, K; int halo;
    __device__ __forceinline__ size_t a_off(int pm) const { const int row = halo == 0 ? pm * 256 : (pm / TPB) * BS + OFF - halo + (256 - halo) * (pm % TPB); return (size_t)row * (size_t)K * 2; } };

struct StaticOrder {
    int nM, nN, nwg, G, c;
    __host__ __device__ void init(int M, int N, int G_, int c_) { nM = M / BM; nN = N / BM; nwg = nM * nN; G = G_; c = c_; }
    __host__ __device__ bool next(int i, Unit& u) const {
        const long L = (long)i * G + c; if (L >= nwg) return false;
        int wgid = (int)L; { const int q = nwg / NXCD, r = nwg % NXCD, xcd = wgid % NXCD, off = wgid / NXCD; wgid = (xcd < r ? xcd * (q + 1) : r * (q + 1) + (xcd - r) * q) + off; }
        const int nig = WGM * nN, gid = wgid / nig, fm = gid * WGM, gsz = (nM - fm) < WGM ? (nM - fm) : WGM;
        u.pm = fm + ((wgid % nig) % gsz); u.pn = (wgid % nig) / gsz; return true;
    }
    __device__ __forceinline__ void a_ready(const Unit&) const {}
    __device__ __forceinline__ void done(const Unit&) const {}
};

__device__ __forceinline__ unsigned cvt_pk_bf16(float lo, float hi) { unsigned r; asm volatile("v_cvt_pk_bf16_f32 %0, %1, %2" : "=v"(r) : "v"(lo), "v"(hi)); return r; }
typedef float f32x2 __attribute__((ext_vector_type(2)));
__device__ __forceinline__ float silu_f(float v) { return v * __builtin_amdgcn_rcpf(1.0f + __expf(-v)); }
__device__ __forceinline__ float softplus_f(float v) { return fmaxf(v, 0.f) + log1pf(__expf(-fabsf(v))); }
__device__ __forceinline__ float bflo(unsigned u) { return __uint_as_float(u << 16); }
__device__ __forceinline__ float bfhi(unsigned u) { return __uint_as_float(u & 0xffff0000u); }
typedef unsigned u32x2 __attribute__((ext_vector_type(2)));

struct EpiBf16 {
    static constexpr bool PERM = true, AFTER_DRAIN = false;
    bf16_t* O; int ldc; int split_cols; size_t split_stride; const float* rsq;
    __device__ __forceinline__ void operator()(const f32x4 (&acc)[2][2][4][2], const Unit& u, int wr, int wc, int fr, int fq, PG8_LAS unsigned char*) const {
        asm volatile("" : "+v"(fr), "+v"(fq));
        const int row0 = u.pm * BM + wr * 64 + fr; int colt = u.pn * BM; bf16_t* base = O;
        if (split_cols) { const int t = colt / split_cols; base += (size_t)t * split_stride; colt -= t * split_cols; }
        const int col0 = colt + wc * 32 + 8 * fq;
#pragma unroll
        for (int ai = 0; ai < 2; ++ai)
#pragma unroll
            for (int m = 0; m < 4; ++m) { bf16_t* rowp = base + (size_t)(row0 + ai * HALF + m * 16) * ldc + col0;
                const float rs = rsqrtf(rsq[row0 + ai * HALF + m * 16] * (1.0f / DM) + EPS);
#pragma unroll
                for (int bj = 0; bj < 2; ++bj) { const f32x4 v0 = acc[ai][bj][m][0] * rs, v1 = acc[ai][bj][m][1] * rs;
                    u32x4 w; w.x = cvt_pk_bf16(v0[0], v0[1]); w.y = cvt_pk_bf16(v0[2], v0[3]); w.z = cvt_pk_bf16(v1[0], v1[1]); w.w = cvt_pk_bf16(v1[2], v1[3]);
                    *(u32x4*)(rowp + bj * HALF) = w; } }
    }
};

template <int mode> struct EpiResid {
    static constexpr bool PERM = false, AFTER_DRAIN = false;
    float* H; const float* x; const float* meta; bf16_t* XH; float* rsq;
    __device__ __forceinline__ void operator()(const f32x4 (&acc)[2][2][4][2], const Unit& u, int wr, int wc, int fr, int fq, PG8_LAS unsigned char*) const {
        asm volatile("" : "+v"(fr), "+v"(fq));
        const int col0 = u.pn * BM + wc * 32 + 4 * fq;
#pragma unroll
        for (int ai = 0; ai < 2; ++ai)
#pragma unroll
            for (int m = 0; m < 4; ++m) {
                const int r = u.pm * BM + ai * HALF + wr * 64 + m * 16 + fr;
                const int b = r >= BS ? 1 : 0, l = r - b * BS - OFF;
                const bool valid = l >= 0 && l < LTOK; float ss = 0.f;
                if (valid) {
                    float* hp = H + (size_t)r * DM + col0;
                    const float* bp = mode == 0 ? hp : (l < NMETA ? meta + (size_t)l * DM + col0 : x + ((size_t)b * SEQ + (l - NMETA)) * DM + col0);
#pragma unroll
                    for (int bj = 0; bj < 2; ++bj)
#pragma unroll
                        for (int n = 0; n < 2; ++n) { const f32x4 hv = *(const f32x4*)(bp + bj * HALF + n * 16) + acc[ai][bj][m][n]; *(f32x4*)(hp + bj * HALF + n * 16) = hv;
                            ss += (hv[0] * hv[0] + hv[1] * hv[1]) + (hv[2] * hv[2] + hv[3] * hv[3]);
                            u32x2 w; w.x = cvt_pk_bf16(hv[0], hv[1]); w.y = cvt_pk_bf16(hv[2], hv[3]); *(u32x2*)(XH + (size_t)r * DM + col0 + bj * HALF + n * 16) = w; }
                }
                ss += __shfl_xor(ss, 16); ss += __shfl_xor(ss, 32);
                if (fq == 0 && valid) atomicAdd(rsq + r, ss);
                asm volatile("" ::: "memory");
            }
    }
};

__device__ __forceinline__ void row_scale(f32x4 (&acc)[2][2][4][2], const float* rp) {
#pragma unroll
    for (int ai = 0; ai < 2; ++ai)
#pragma unroll
        for (int m = 0; m < 4; ++m) { const float rs = rsqrtf(rp[ai * HALF + m * 16] * (1.0f / DM) + EPS);
#pragma unroll
            for (int bj = 0; bj < 2; ++bj)
#pragma unroll
                for (int n = 0; n < 2; ++n) acc[ai][bj][m][n] = acc[ai][bj][m][n] * rs; }
}
__device__ __forceinline__ void halo_publish(const f32x4 (&acc)[2][2][4][2], PG8_LAS unsigned char* xl, int wr, int wc, int fr, int fq) {
    PG8_LAS f32x4* X = (PG8_LAS f32x4*)xl; const int wave = wr * 4 + wc;
    if (fr >= 12) {
#pragma unroll
        for (int ai = 0; ai < 2; ++ai)
#pragma unroll
            for (int bj = 0; bj < 2; ++bj)
#pragma unroll
                for (int n = 0; n < 2; ++n) X[(((wave * 2 + ai) * 4 + bj * 2 + n) * 16) + fq * 4 + (fr - 12)] = acc[ai][bj][3][n];
    }
    asm volatile("s_waitcnt lgkmcnt(0)" ::: "memory"); __builtin_amdgcn_s_barrier(); asm volatile("" ::: "memory");
}
__device__ __forceinline__ f32x4 halo_get(PG8_LAS unsigned char* xl, int ai, int bj, int n, int wr, int wc, int fr, int fq) {
    const PG8_LAS f32x4* X = (const PG8_LAS f32x4*)xl; const int pai = wr == 1 ? ai : ai - 1, pw = (wr ^ 1) * 4 + wc;
    f32x4 r = (f32x4){0.f, 0.f, 0.f, 0.f};
    if (fr >= 12 && pai >= 0) r = X[(((pw * 2 + pai) * 4 + bj * 2 + n) * 16) + fq * 4 + (fr - 12)];
    return r;
}

struct EpiInProj {
    static constexpr bool PERM = true, AFTER_DRAIN = false;
    bf16_t* Z; bf16_t* XBC; float* DT; const float* cw; const float* cb; const float* dtb; const float* rsq;
    __device__ __forceinline__ void operator()(f32x4 (&acc)[2][2][4][2], const Unit& u, int wr, int wc, int fr, int fq, PG8_LAS unsigned char* xl) const {
        asm volatile("" : "+v"(fr), "+v"(fq));
        const int pb = u.pm / TPB, pt = u.pm % TPB, l0 = 253 * pt - 3, rowbase = pb * BS + OFF + l0, lane = fq * 16 + fr;
        row_scale(acc, rsq + rowbase + wr * 64 + fr);
        if (u.pn < 8) {
            const int col0 = u.pn * BM + wc * 32 + 8 * fq;
#pragma unroll
            for (int ai = 0; ai < 2; ++ai)
#pragma unroll
                for (int m = 0; m < 4; ++m) { const int i = ai * HALF + wr * 64 + m * 16 + fr, l = l0 + i;
                    if (i >= 3 && l < LTOK) { bf16_t* rowp = Z + (size_t)(rowbase + i) * DI + col0;
#pragma unroll
                        for (int bj = 0; bj < 2; ++bj) { const f32x4 v0 = acc[ai][bj][m][0], v1 = acc[ai][bj][m][1];
                            u32x4 w; w.x = cvt_pk_bf16(v0[0], v0[1]); w.y = cvt_pk_bf16(v0[2], v0[3]); w.z = cvt_pk_bf16(v1[0], v1[1]); w.w = cvt_pk_bf16(v1[2], v1[3]);
                            *(u32x4*)(rowp + bj * HALF) = w; } } }
        } else if (u.pn < 20) {
            halo_publish(acc, xl, wr, wc, fr, fq);
            const int s1 = (lane & 48) | ((fr - 1) & 15), s2 = (lane & 48) | ((fr - 2) & 15), s3 = (lane & 48) | ((fr - 3) & 15);
#pragma unroll
            for (int bj = 0; bj < 2; ++bj)
#pragma unroll
                for (int n = 0; n < 2; ++n) {
                    const int c0 = (u.pn - 8) * BM + bj * HALF + wc * 32 + 8 * fq + 4 * n;
                    const f32x4 w0 = *(const f32x4*)(cw + c0), w1 = *(const f32x4*)(cw + CONVD + c0), w2 = *(const f32x4*)(cw + 2 * CONVD + c0), w3 = *(const f32x4*)(cw + 3 * CONVD + c0), bb = *(const f32x4*)(cb + c0);
#pragma unroll
                    for (int ai = 0; ai < 2; ++ai)
#pragma unroll
                        for (int m = 0; m < 4; ++m) {
                            const f32x4 cur = acc[ai][bj][m][n];
                            f32x4 prv; if (m > 0) prv = acc[ai][bj][m > 0 ? m - 1 : 0][n]; else prv = halo_get(xl, ai, bj, n, wr, wc, fr, fq);
                            float o[4];
#pragma unroll
                            for (int j = 0; j < 4; ++j) {
                                const float v1 = __shfl(fr >= 15 ? prv[j] : cur[j], s1), v2 = __shfl(fr >= 14 ? prv[j] : cur[j], s2), v3 = __shfl(fr >= 13 ? prv[j] : cur[j], s3);
                                o[j] = silu_f(bb[j] + w3[j] * cur[j] + w2[j] * v1 + w1[j] * v2 + w0[j] * v3);
                            }
                            const int i = ai * HALF + wr * 64 + m * 16 + fr, l = l0 + i;
                            if (i >= 3 && l < LTOK) { u32x2 w; w.x = cvt_pk_bf16(o[0], o[1]); w.y = cvt_pk_bf16(o[2], o[3]); *(u32x2*)(XBC + (size_t)(rowbase + i) * CONVD + c0) = w; }
                        }
                    asm volatile("" ::: "memory");
                }
        } else {
            if (wc == 0) {
#pragma unroll
                for (int n = 0; n < 2; ++n) { const int c0 = 8 * fq + 4 * n; const f32x4 bb = *(const f32x4*)(dtb + c0);
#pragma unroll
                    for (int ai = 0; ai < 2; ++ai)
#pragma unroll
                        for (int m = 0; m < 4; ++m) { const int i = ai * HALF + wr * 64 + m * 16 + fr, l = l0 + i; const f32x4 v = acc[ai][0][m][n] + bb;
                            if (i >= 3 && l < LTOK) *(f32x4*)(DT + (size_t)(rowbase + i) * NHS + c0) = (f32x4){softplus_f(v[0]), softplus_f(v[1]), softplus_f(v[2]), softplus_f(v[3])}; } }
            }
        }
    }
};

struct EpiUp {
    static constexpr bool PERM = true, AFTER_DRAIN = false;
    bf16_t* ACT; const float* cw; const float* cb; const float* rsq;
    __device__ __forceinline__ void operator()(f32x4 (&acc)[2][2][4][2], const Unit& u, int wr, int wc, int fr, int fq, PG8_LAS unsigned char* xl) const {
        asm volatile("" : "+v"(fr), "+v"(fq));
        const int pb = u.pm / TPB, pt = u.pm % TPB, l0 = 254 * pt - 2, rowbase = pb * BS + OFF + l0, lane = fq * 16 + fr;
        row_scale(acc, rsq + rowbase + wr * 64 + fr);
        halo_publish(acc, xl, wr, wc, fr, fq);
        const int s1 = (lane & 48) | ((fr - 1) & 15), s2 = (lane & 48) | ((fr - 2) & 15);
#pragma unroll
        for (int n = 0; n < 2; ++n) {
            const int c0 = u.pn * HALF + wc * 32 + 8 * fq + 4 * n;
            const f32x4 g0 = *(const f32x4*)(cw + c0), g1 = *(const f32x4*)(cw + NUP + c0), g2 = *(const f32x4*)(cw + 2 * NUP + c0), gb = *(const f32x4*)(cb + c0);
            const f32x4 h0 = *(const f32x4*)(cw + DFF + c0), h1 = *(const f32x4*)(cw + NUP + DFF + c0), h2 = *(const f32x4*)(cw + 2 * NUP + DFF + c0), hb = *(const f32x4*)(cb + DFF + c0);
#pragma unroll
            for (int ai = 0; ai < 2; ++ai)
#pragma unroll
                for (int m = 0; m < 4; ++m) {
                    const f32x4 cg = acc[ai][0][m][n], cv = acc[ai][1][m][n];
                    f32x4 pg, pv; if (m > 0) { pg = acc[ai][0][m > 0 ? m - 1 : 0][n]; pv = acc[ai][1][m > 0 ? m - 1 : 0][n]; } else { pg = halo_get(xl, ai, 0, n, wr, wc, fr, fq); pv = halo_get(xl, ai, 1, n, wr, wc, fr, fq); }
                    float o[4];
#pragma unroll
                    for (int j = 0; j < 4; ++j) {
                        const float a1 = __shfl(fr >= 15 ? pg[j] : cg[j], s1), a2 = __shfl(fr >= 14 ? pg[j] : cg[j], s2);
                        const float b1 = __shfl(fr >= 15 ? pv[j] : cv[j], s1), b2 = __shfl(fr >= 14 ? pv[j] : cv[j], s2);
                        const float gg = gb[j] + g2[j] * cg[j] + g1[j] * a1 + g0[j] * a2, vv = hb[j] + h2[j] * cv[j] + h1[j] * b1 + h0[j] * b2;
                        o[j] = silu_f(gg) * vv;
                    }
                    const int i = ai * HALF + wr * 64 + m * 16 + fr, l = l0 + i;
                    if (i >= 2 && l < LTOK) { u32x2 w; w.x = cvt_pk_bf16(o[0], o[1]); w.y = cvt_pk_bf16(o[2], o[3]); *(u32x2*)(ACT + (size_t)(rowbase + i) * DFF + c0) = w; }
                }
            asm volatile("" ::: "memory");
        }
    }
};

template <class Epi, class Sched, bool ALIGN_EPI = false, bool SP2 = false>
__device__ __forceinline__ void gemm_phase(PG8_LAS unsigned char* lds, const Gemm g, const Sched& S, const Epi& E) {
    const int tid = threadIdx.x, wid = __builtin_amdgcn_readfirstlane(tid >> 6), lane = tid & 63, wr = wid >> 2, wc = wid & 3, fr = lane & 15, fq = lane >> 4;
    const int K = g.K, nt = K / BK;
    unsigned voffA[2], voffB[2];
#pragma unroll
    for (int i = 0; i < 2; ++i) { int R, C; stage_rc(tid * 16 + i * 8192, R, C); const int Rb = Epi::PERM ? ((R & ~31) + perm32(R & 31)) : R;
        voffA[i] = (unsigned)(R * K + C) * 2u; voffB[i] = (unsigned)(Rb * K + C) * 2u; }
    const size_t kstep = (size_t)(BK * 2);
    const size_t hstep = (size_t)HALF * K * 2;
    const size_t tstep = 2 * hstep;
    const unsigned ldsw = (unsigned)wid * 1024u;
    const int aoff = lds_byte(wr * 64 + fr, fq * 8), boff = lds_byte(wc * 32 + fr, fq * 8);
#define PG8_SA(b, h) (((b) * 2 + (h)) * HTB)
#define PG8_SB(b, h) ((4 + (b) * 2 + (h)) * HTB)
#define PG8_STAGE(bufoff, gbase, voff) do { _Pragma("unroll") for (int _i = 0; _i < 2; ++_i) \
        __builtin_amdgcn_global_load_lds((const unsigned*)((const char*)(gbase) + (voff)[_i]), (PG8_LAS unsigned*)(lds + (bufoff) + ldsw + _i * 8192), 16, 0, 0); } while (0)
#define PG8_LDA(dst, b, h) do { _Pragma("unroll") for (int m = 0; m < 4; ++m) _Pragma("unroll") for (int k = 0; k < 2; ++k) dst[m][k] = *(const PG8_LAS bf16x8*)(lds + PG8_SA(b, h) + aoff + m * 2048 + k * 1024); } while (0)
#define PG8_LDB(dst, b, h) do { _Pragma("unroll") for (int n = 0; n < 2; ++n) _Pragma("unroll") for (int k = 0; k < 2; ++k) dst[n][k] = *(const PG8_LAS bf16x8*)(lds + PG8_SB(b, h) + boff + n * 2048 + k * 1024); } while (0)
#define PG8_MMA(ai, bj, At, Bt) do { __builtin_amdgcn_s_setprio(1); _Pragma("unroll") for (int m = 0; m < 4; ++m) _Pragma("unroll") for (int n = 0; n < 2; ++n) _Pragma("unroll") for (int k = 0; k < 2; ++k) \
        acc[ai][bj][m][n] = __builtin_amdgcn_mfma_f32_16x16x32_bf16(Bt[n][k], At[m][k], acc[ai][bj][m][n], 0, 0, 0); __builtin_amdgcn_s_setprio(0); } while (0)
#define PG8_WAIT_V(n) asm volatile("s_waitcnt vmcnt(" #n ")" ::: "memory")
#define PG8_WAIT_L(n) asm volatile("s_waitcnt lgkmcnt(" #n ")" ::: "memory")
#define PG8_BAR __builtin_amdgcn_s_barrier()
#define PG8_SCHED __builtin_amdgcn_sched_barrier(0)
    Unit cur, nxt; int ui = 0;
    if (!S.next(0, cur)) return;
    f32x4 acc[2][2][4][2];
#pragma unroll
    for (int a = 0; a < 2; ++a)
#pragma unroll
        for (int b = 0; b < 2; ++b)
#pragma unroll
            for (int m = 0; m < 4; ++m)
#pragma unroll
                for (int n = 0; n < 2; ++n) acc[a][b][m][n] = (f32x4){0.f, 0.f, 0.f, 0.f};
    bf16x8 At[4][2], B0[2][2], B1[2][2];
    const char* cA = (const char*)g.A + g.a_off(cur.pm); const char* cB = (const char*)g.Bt + (size_t)cur.pn * tstep;
    S.a_ready(cur);
    if constexpr (SP2) {
        PG8_STAGE(PG8_SB(0, 0), cB, voffB); PG8_STAGE(PG8_SB(0, 1), cB + hstep, voffB); PG8_STAGE(PG8_SA(0, 0), cA, voffA); PG8_STAGE(PG8_SA(0, 1), cA + hstep, voffA);
        if (wr == 1) PG8_BAR;
        PG8_WAIT_V(2); PG8_BAR;
        PG8_STAGE(PG8_SB(1, 0), cB + kstep, voffB); PG8_STAGE(PG8_SA(1, 0), cA + kstep, voffA); PG8_STAGE(PG8_SB(1, 1), cB + hstep + kstep, voffB);
        PG8_WAIT_V(6); PG8_BAR;
    } else {
        PG8_STAGE(PG8_SB(0, 0), cB, voffB); PG8_STAGE(PG8_SA(0, 0), cA, voffA); PG8_STAGE(PG8_SB(0, 1), cB + hstep, voffB); PG8_STAGE(PG8_SA(0, 1), cA + hstep, voffA);
        if (wr == 1) PG8_BAR;
        PG8_WAIT_V(4); PG8_BAR;
        PG8_STAGE(PG8_SB(1, 0), cB + kstep, voffB); PG8_STAGE(PG8_SA(1, 0), cA + kstep, voffA); PG8_STAGE(PG8_SB(1, 1), cB + hstep + kstep, voffB);
        PG8_WAIT_V(6); PG8_BAR;
    }
    for (;;) {
        const bool has_next = S.next(ui + 1, nxt);
        const char* nA = has_next ? (const char*)g.A + g.a_off(nxt.pm) : cA; const char* nB = has_next ? (const char*)g.Bt + (size_t)nxt.pn * tstep : cB;
        for (int t = 0; t < nt; t += 2) {
            const bool last = (t == nt - 2);
            const char* a1 = cA + (size_t)(t + 1) * kstep;
            const char* a2 = last ? nA : cA + (size_t)(t + 2) * kstep; const char* b2 = last ? nB : cB + (size_t)(t + 2) * kstep;
            const char* a3 = a2 + kstep; const char* b3 = b2 + kstep;
            if (last && has_next) S.a_ready(nxt);
            if constexpr (SP2) {
            PG8_LDB(B0, 0, 0); PG8_LDB(B1, 0, 1); PG8_SCHED; PG8_LDA(At, 0, 0); PG8_STAGE(PG8_SA(1, 1), a1 + hstep, voffA);
            PG8_WAIT_V(8); PG8_WAIT_L(0); PG8_BAR; PG8_MMA(0, 0, At, B0); PG8_MMA(0, 1, At, B1); PG8_BAR; PG8_SCHED;
            PG8_LDA(At, 0, 1); PG8_STAGE(PG8_SB(0, 0), b2, voffB); PG8_STAGE(PG8_SB(0, 1), b2 + hstep, voffB); PG8_STAGE(PG8_SA(0, 0), a2, voffA);
            PG8_WAIT_V(8); PG8_WAIT_L(0); PG8_BAR; PG8_MMA(1, 0, At, B0); PG8_MMA(1, 1, At, B1); PG8_BAR; PG8_SCHED;
            PG8_LDB(B0, 1, 0); PG8_LDB(B1, 1, 1); PG8_SCHED; PG8_LDA(At, 1, 0); PG8_STAGE(PG8_SA(0, 1), a2 + hstep, voffA);
            PG8_WAIT_V(8); PG8_WAIT_L(0); PG8_BAR; PG8_MMA(0, 0, At, B0); PG8_MMA(0, 1, At, B1); PG8_BAR; PG8_SCHED;
            PG8_LDA(At, 1, 1); PG8_STAGE(PG8_SB(1, 0), b3, voffB); PG8_STAGE(PG8_SB(1, 1), b3 + hstep, voffB); PG8_STAGE(PG8_SA(1, 0), a3, voffA);
            PG8_WAIT_V(8); PG8_WAIT_L(0); PG8_BAR; PG8_MMA(1, 0, At, B0); PG8_MMA(1, 1, At, B1); PG8_BAR; PG8_SCHED;
            } else {
            PG8_LDB(B0, 0, 0); PG8_SCHED; PG8_LDA(At, 0, 0); PG8_STAGE(PG8_SA(1, 1), a1 + hstep, voffA);
            PG8_WAIT_L(8); PG8_BAR; PG8_WAIT_L(0); PG8_MMA(0, 0, At, B0); PG8_BAR; PG8_SCHED;
            PG8_LDB(B1, 0, 1); PG8_STAGE(PG8_SB(0, 0), b2, voffB);
            PG8_BAR; PG8_WAIT_L(0); PG8_MMA(0, 1, At, B1); PG8_BAR;
            PG8_LDA(At, 0, 1); PG8_STAGE(PG8_SA(0, 0), a2, voffA);
            PG8_BAR; PG8_WAIT_L(0); PG8_MMA(1, 0, At, B0); PG8_BAR; PG8_SCHED;
            PG8_STAGE(PG8_SB(0, 1), b2 + hstep, voffB);
            PG8_WAIT_V(6); PG8_BAR; PG8_MMA(1, 1, At, B1); PG8_BAR;
            PG8_LDB(B0, 1, 0); PG8_SCHED; PG8_LDA(At, 1, 0); PG8_STAGE(PG8_SA(0, 1), a2 + hstep, voffA);
            PG8_WAIT_L(8); PG8_BAR; PG8_WAIT_L(0); PG8_MMA(0, 0, At, B0); PG8_BAR; PG8_SCHED;
            PG8_LDB(B1, 1, 1); PG8_STAGE(PG8_SB(1, 0), b3, voffB);
            PG8_BAR; PG8_WAIT_L(0); PG8_MMA(0, 1, At, B1); PG8_BAR;
            PG8_LDA(At, 1, 1); PG8_STAGE(PG8_SA(1, 0), a3, voffA);
            PG8_BAR; PG8_WAIT_L(0); PG8_MMA(1, 0, At, B0); PG8_BAR; PG8_SCHED;
            PG8_STAGE(PG8_SB(1, 1), b3 + hstep, voffB);
            PG8_WAIT_V(6); PG8_BAR; PG8_MMA(1, 1, At, B1); PG8_BAR;
            }
        }
        if constexpr (ALIGN_EPI) { if (wr == 0) PG8_BAR; }
        if constexpr (!Epi::AFTER_DRAIN) { E(acc, cur, wr, wc, fr, fq, lds + STAGE_BYTES); S.done(cur); }
        if (!has_next) break;
#pragma unroll
        for (int a = 0; a < 2; ++a)
#pragma unroll
            for (int b = 0; b < 2; ++b)
#pragma unroll
                for (int m = 0; m < 4; ++m)
#pragma unroll
                    for (int n = 0; n < 2; ++n) acc[a][b][m][n] = (f32x4){0.f, 0.f, 0.f, 0.f};
        cur = nxt; cA = nA; cB = nB; ++ui;
        if constexpr (ALIGN_EPI) { if (wr == 1) PG8_BAR; }
    }
    PG8_WAIT_V(0);
    if constexpr (!ALIGN_EPI) { if (wr == 0) PG8_BAR; }
    PG8_BAR;

#undef PG8_SA
#undef PG8_SB
#undef PG8_STAGE
#undef PG8_LDA
#undef PG8_LDB
#undef PG8_MMA
#undef PG8_WAIT_V
#undef PG8_WAIT_L
#undef PG8_BAR
#undef PG8_SCHED
}
}

#define LAS __attribute__((address_space(3)))
typedef unsigned short bf16;
typedef unsigned v4u __attribute__((ext_vector_type(4)));
typedef unsigned v2u __attribute__((ext_vector_type(2)));
typedef float f32x4 __attribute__((ext_vector_type(4)));
constexpr int NWAVES = 8, NTHR = 512;
constexpr int RING_BYTES = 131072, XCH_BYTES = 16384, LDS_BYTES = RING_BYTES + XCH_BYTES + 1024;

constexpr size_t MiB = 1u << 20;
constexpr size_t SZ_WIN = (size_t)NIN * DM * 2, SZ_WOUT = (size_t)DM * DI * 2, SZ_WKVQ = (size_t)3072 * DM * 2, SZ_WO = (size_t)DM * DM * 2, SZ_WUP = (size_t)NUP * DM * 2, SZ_WDN = (size_t)DM * DFF * 2;
constexpr size_t WS_WIN = 1 * MiB, WS_WOUT = WS_WIN + SZ_WIN, WS_WKVQ = WS_WOUT + SZ_WOUT, WS_WO = WS_WKVQ + SZ_WKVQ, WS_WUP0 = WS_WO + SZ_WO, WS_WUP1 = WS_WUP0 + SZ_WUP, WS_WDN0 = WS_WUP1 + SZ_WUP, WS_WDN1 = WS_WDN0 + SZ_WDN, WS_WEND = WS_WDN1 + SZ_WDN;
constexpr size_t WS_DT = 57 * MiB;
constexpr size_t WS_XBC = 60 * MiB;
constexpr size_t WS_H = WS_XBC;
constexpr size_t WS_Z = 158 * MiB;
constexpr size_t WS_ST = 223 * MiB;
constexpr size_t WS_ACT = 126 * MiB;
constexpr size_t WS_K = 126 * MiB, WS_V = 159 * MiB, WS_Q = 192 * MiB;
constexpr size_t WS_RSQ = 262144;
constexpr size_t WS_END = 256 * MiB;
static_assert(WS_WEND <= WS_DT && WS_DT + (size_t)MR * 32 * 4 <= WS_XBC && WS_XBC + (size_t)MR * CONVD * 2 <= WS_Z && WS_Z + (size_t)MR * DI * 2 <= WS_ST, "ws map 1");
static_assert(WS_H + (size_t)MR * DM * 4 <= WS_ACT && WS_ACT + (size_t)MR * DFF * 2 <= WS_END && WS_K + (size_t)MR * DM * 2 <= WS_V && WS_V + (size_t)MR * DM * 2 <= WS_Q && WS_Q + (size_t)MR * DM * 2 <= WS_END, "ws map 2");

__device__ __forceinline__ unsigned f2bf(float f) { unsigned u = __builtin_bit_cast(unsigned, f); return (u + 0x7fffu + ((u >> 16) & 1u)) >> 16; }
__device__ __forceinline__ unsigned pk2(float lo, float hi) { return f2bf(lo) | (f2bf(hi) << 16); }
__device__ __forceinline__ float wave_sum(float v) {
#pragma unroll
    for (int o = 1; o < 64; o <<= 1) v += __shfl_xor(v, o);
    return v;
}
__device__ __forceinline__ float bf_lo(unsigned u) { return __uint_as_float(u << 16); }
__device__ __forceinline__ float bf_hi(unsigned u) { return __uint_as_float(u & 0xffff0000u); }

__device__ __forceinline__ void transpose_item(const float* W, int pitch, int K, bf16* WT, int nrow0, int srccol0, int k0, const float* gain, LAS float* scr, int lane) {
#pragma unroll 8
    for (int i = 0; i < 32; ++i) { const int kk = 2 * i + (lane >> 5); float v = 0.f;
        if (srccol0 >= 0) { v = W[(size_t)(k0 + kk) * pitch + srccol0 + (lane & 31)]; if (gain) v *= gain[k0 + kk]; }
        scr[kk * 33 + (lane & 31)] = v; }
    asm volatile("s_waitcnt lgkmcnt(0)" ::: "memory");
    const int c = lane & 7;
#pragma unroll
    for (int j = 0; j < 4; ++j) { const int n = (lane >> 3) + 8 * j; const LAS float* s = scr + (8 * c) * 33 + n;
        v4u o; o.x = pk2(s[0 * 33], s[1 * 33]); o.y = pk2(s[2 * 33], s[3 * 33]); o.z = pk2(s[4 * 33], s[5 * 33]); o.w = pk2(s[6 * 33], s[7 * 33]);
        *(v4u*)(WT + (size_t)(nrow0 + n) * K + k0 + 8 * c) = o; }
    asm volatile("s_waitcnt lgkmcnt(0)" ::: "memory");
}

constexpr int SB_LB = 0, SB_LC = 17408, SB_LX = 34816, SB_LXW = 44032, SB_LST = 53248, SB_LDT = 70656, SB_LACS = 70912;
typedef short bf16x8_t __attribute__((ext_vector_type(8)));
typedef short s16x4_t __attribute__((ext_vector_type(4)));
__device__ __forceinline__ s16x4_t lds_tr16(LAS unsigned char* p) { return __builtin_bit_cast(s16x4_t, __builtin_amdgcn_ds_read_tr16_b64_v4i16((LAS s16x4_t*)p)); }
__device__ __forceinline__ bf16x8_t cat8(s16x4_t a, s16x4_t b) { return (bf16x8_t){a[0], a[1], a[2], a[3], b[0], b[1], b[2], b[3]}; }

template <int PASS> __device__ __forceinline__ void ssd_unit(LAS unsigned char* lds, int b, int c, int h, const bf16* xbc_c, bf16* xbc_w, const float* dtp, bf16* ST, float* DEC, float a, float dsk, int tid) {
    const int lane = tid & 63, wave = __builtin_amdgcn_readfirstlane(tid >> 6), fr = lane & 15, fq = lane >> 4, q2 = fr >> 2, p2 = lane & 3, g = h >> 3;
    const int lbase = 256 * c, nvalid = (LTOK - lbase) < 256 ? (LTOK - lbase) : 256, nsub = (nvalid + 63) >> 6;
    const size_t rowb = (size_t)b * BS + OFF;
    f32x4 ast[4];
#pragma unroll
    for (int pb = 0; pb < 4; ++pb) ast[pb] = (f32x4){0.f, 0.f, 0.f, 0.f};
    if (PASS == 2 && c > 0) {
        const bf16* sp = ST + ((size_t)((b * 32 + (c - 1)) * NHS + h)) * 8192;
#pragma unroll
        for (int pb = 0; pb < 4; ++pb) { const v2u w = *(const v2u*)(sp + (16 * pb + fr) * 128 + 16 * wave + 4 * fq); ast[pb] = (f32x4){bf_lo(w.x), bf_hi(w.x), bf_lo(w.y), bf_hi(w.y)}; }
    }
    float totlog = 0.f;
    v4u gB[2], gC[2], gX; float gdt;
    auto prefetch = [&](int j) {
        const int l0 = lbase + 64 * j;
#pragma unroll
        for (int k = 0; k < 2; ++k) { const int idx = tid + 512 * k, row = idx >> 4, ch = idx & 15; int l = l0 + row; l = l < LTOK ? l : LTOK - 1;
            const bf16* rp = xbc_c + (rowb + l) * CONVD + DI + g * 128 + ch * 8; gB[k] = *(const v4u*)rp; if (PASS == 2) gC[k] = *(const v4u*)(rp + 512); }
        { const int row = tid >> 3, ch = tid & 7; int l = l0 + row; l = l < LTOK ? l : LTOK - 1; gX = *(const v4u*)(xbc_c + (rowb + l) * CONVD + h * 64 + ch * 8); }
        { const int l = l0 + lane; gdt = l < LTOK ? dtp[(rowb + l) * NHS + h] : 0.f; }
    };
    prefetch(0);
    for (int j = 0; j < nsub; ++j) {
        float acs = gdt * a;
#pragma unroll
        for (int o = 1; o < 64; o <<= 1) { const float t = __shfl_up(acs, o); if (lane >= o) acs += t; }
        const float aend = __shfl(acs, 63);
        const float wrow = gdt * __expf(aend - acs);
        if (wave == 0) { ((LAS float*)(lds + SB_LDT))[lane] = gdt; ((LAS float*)(lds + SB_LACS))[lane] = acs; }
#pragma unroll
        for (int k = 0; k < 2; ++k) { const int idx = tid + 512 * k, row = idx >> 4, ch = idx & 15; *(LAS v4u*)(lds + SB_LB + row * 272 + ch * 16) = gB[k]; if (PASS == 2) *(LAS v4u*)(lds + SB_LC + row * 272 + ch * 16) = gC[k]; }
        { const int row = tid >> 3, ch = tid & 7; const float wv = __shfl(wrow, row & 63);
          if (PASS == 2) *(LAS v4u*)(lds + SB_LX + row * 144 + ch * 16) = gX;
          v4u xw;
#pragma unroll
          for (int e = 0; e < 4; ++e) xw[e] = pk2(bf_lo(gX[e]) * wv, bf_hi(gX[e]) * wv);
          *(LAS v4u*)(lds + SB_LXW + row * 144 + ch * 16) = xw; }
        if (PASS == 2) {
#pragma unroll
            for (int pb = 0; pb < 4; ++pb) *(LAS v2u*)(lds + SB_LST + (16 * pb + fr) * 272 + (16 * wave + 4 * fq) * 2) = (v2u){pk2(ast[pb][0], ast[pb][1]), pk2(ast[pb][2], ast[pb][3])};
        }
        __syncthreads();
        if (j + 1 < nsub) prefetch(j + 1);
        totlog += aend;
        if (PASS == 2) {
            const int ib = wave >> 1;
            bf16x8_t cf[4];
#pragma unroll
            for (int ks = 0; ks < 4; ++ks) cf[ks] = *(const LAS bf16x8_t*)(lds + SB_LC + (16 * ib + fr) * 272 + (32 * ks + 8 * fq) * 2);
            const float acs_i = ((const LAS float*)(lds + SB_LACS))[16 * ib + fr];
            const int irow = 16 * ib + fr;
            bf16x8_t pf[2];
#pragma unroll
            for (int kk = 0; kk < 2; ++kk) {
                unsigned pw[4];
#pragma unroll
                for (int hf = 0; hf < 2; ++hf) { const int sb = 2 * kk + hf;
                    if (sb <= ib) {
                        f32x4 d = (f32x4){0.f, 0.f, 0.f, 0.f};
#pragma unroll
                        for (int ks = 0; ks < 4; ++ks) { const bf16x8_t af = *(const LAS bf16x8_t*)(lds + SB_LB + (16 * sb + fr) * 272 + (32 * ks + 8 * fq) * 2); d = __builtin_amdgcn_mfma_f32_16x16x32_bf16(af, cf[ks], d, 0, 0, 0); }
                        const f32x4 as4 = *(const LAS f32x4*)(lds + SB_LACS + (16 * sb + 4 * fq) * 4), dt4 = *(const LAS f32x4*)(lds + SB_LDT + (16 * sb + 4 * fq) * 4);
                        float v[4];
#pragma unroll
                        for (int r = 0; r < 4; ++r) { const int s = 16 * sb + 4 * fq + r; const float e = __expf(fminf(acs_i - as4[r], 0.f)); v[r] = s <= irow ? d[r] * dt4[r] * e : 0.f; }
                        pw[2 * hf] = pk2(v[0], v[1]); pw[2 * hf + 1] = pk2(v[2], v[3]);
                    } else { pw[2 * hf] = 0u; pw[2 * hf + 1] = 0u; }
                }
                pf[kk] = __builtin_bit_cast(bf16x8_t, (v4u){pw[0], pw[1], pw[2], pw[3]});
            }
            const float ei = __expf(acs_i);
            const int l_row = lbase + 64 * j + irow;
#pragma unroll
            for (int pbi = 0; pbi < 2; ++pbi) { const int pb = 2 * (wave & 1) + pbi;
                f32x4 acc = (f32x4){0.f, 0.f, 0.f, 0.f};
#pragma unroll
                for (int ks = 0; ks < 4; ++ks) { const bf16x8_t af = *(const LAS bf16x8_t*)(lds + SB_LST + (16 * pb + fr) * 272 + (32 * ks + 8 * fq) * 2); acc = __builtin_amdgcn_mfma_f32_16x16x32_bf16(af, cf[ks], acc, 0, 0, 0); }
                acc = acc * ei;
#pragma unroll
                for (int kk = 0; kk < 2; ++kk) if (2 * kk <= ib) {
                    LAS unsigned char* xp = lds + SB_LX + (32 * kk + 4 * fq + q2) * 144 + 32 * pb + 8 * p2;
                    const bf16x8_t xa = cat8(lds_tr16(xp), lds_tr16(xp + 16 * 144));
                    acc = __builtin_amdgcn_mfma_f32_16x16x32_bf16(xa, pf[kk], acc, 0, 0, 0); }
                const v2u xw = *(const LAS v2u*)(lds + SB_LX + irow * 144 + (16 * pb + 4 * fq) * 2);
                const float y0 = acc[0] + dsk * bf_lo(xw.x), y1 = acc[1] + dsk * bf_hi(xw.x), y2 = acc[2] + dsk * bf_lo(xw.y), y3 = acc[3] + dsk * bf_hi(xw.y);
                if (l_row < LTOK) *(v2u*)(xbc_w + (rowb + l_row) * CONVD + h * 64 + 16 * pb + 4 * fq) = (v2u){pk2(y0, y1), pk2(y2, y3)};
            }
        }
        { const float ed = __expf(aend);
#pragma unroll
          for (int pb = 0; pb < 4; ++pb) ast[pb] = ast[pb] * ed;
#pragma unroll
          for (int kk = 0; kk < 2; ++kk) {
              LAS unsigned char* bp = lds + SB_LB + (32 * kk + 8 * fq + q2) * 272 + 32 * wave + 8 * p2;
              const bf16x8_t af = cat8(lds_tr16(bp), lds_tr16(bp + 4 * 272));
#pragma unroll
              for (int pb = 0; pb < 4; ++pb) { LAS unsigned char* xp = lds + SB_LXW + (32 * kk + 8 * fq + q2) * 144 + 32 * pb + 8 * p2;
                  const bf16x8_t bfg = cat8(lds_tr16(xp), lds_tr16(xp + 4 * 144));
                  ast[pb] = __builtin_amdgcn_mfma_f32_16x16x32_bf16(af, bfg, ast[pb], 0, 0, 0); } } }
        __syncthreads();
    }
    if (PASS == 1) {
        bf16* sp = ST + ((size_t)((b * 32 + c) * NHS + h)) * 8192;
#pragma unroll
        for (int pb = 0; pb < 4; ++pb) *(v2u*)(sp + (16 * pb + fr) * 128 + 16 * wave + 4 * fq) = (v2u){pk2(ast[pb][0], ast[pb][1]), pk2(ast[pb][2], ast[pb][3])};
        if (tid == 0) DEC[(b * 32 + c) * NHS + h] = __expf(totlog);
    }
}

constexpr int AT_LK = 0, AT_LV = 9216, AT_FLAG = 18432;
__device__ __forceinline__ void attn_unit(LAS unsigned char* lds, int b, int h, int qb, bf16* Qb, const bf16* Kb, const bf16* Vb, int tid) {
    const int lane = tid & 63, wave = __builtin_amdgcn_readfirstlane(tid >> 6), fr = lane & 15, fq = lane >> 4, q2 = fr >> 2, p2 = lane & 3;
    const int t0 = 128 * qb, tw = t0 + 16 * wave, t = tw + fr;
    const size_t rowb = (size_t)b * BS + OFF;
    const bool tvalid = t < LTOK;
    bf16x8_t qf[2];
    { const bf16* qp = Qb + (rowb + (tvalid ? t : LTOK - 1)) * DM + h * 64 + 8 * fq; qf[0] = *(const bf16x8_t*)qp; qf[1] = *(const bf16x8_t*)(qp + 32); }
    f32x4 oacc[4];
#pragma unroll
    for (int db = 0; db < 4; ++db) oacc[db] = (f32x4){0.f, 0.f, 0.f, 0.f};
    float carry = 0.f;
    bool wdone = !__any(tvalid);
    const int srow = tid >> 3, sch = tid & 7;
    int k0 = t0 + 64; if (k0 >= LTOK) k0 = t0;
    v4u gK, gV;
    { int s = k0 + srow; s = s < LTOK ? s : LTOK - 1; const size_t off = (rowb + s) * DM + h * 64 + sch * 8; gK = *(const v4u*)(Kb + off); gV = *(const v4u*)(Vb + off); }
    for (;;) {
        *(LAS v4u*)(lds + AT_LK + srow * 144 + sch * 16) = gK; *(LAS v4u*)(lds + AT_LV + srow * 144 + sch * 16) = gV;
        __syncthreads();
        if (k0 >= 64) { const size_t off = (rowb + (k0 - 64) + srow) * DM + h * 64 + sch * 8; gK = *(const v4u*)(Kb + off); gV = *(const v4u*)(Vb + off); }
        if (!wdone && k0 <= tw + 14) {
            f32x4 st[4];
#pragma unroll
            for (int sb = 0; sb < 4; ++sb) { f32x4 d = (f32x4){0.f, 0.f, 0.f, 0.f};
#pragma unroll
                for (int ks = 0; ks < 2; ++ks) { const bf16x8_t kf = *(const LAS bf16x8_t*)(lds + AT_LK + (16 * sb + fr) * 144 + (32 * ks + 8 * fq) * 2); d = __builtin_amdgcn_mfma_f32_16x16x32_bf16(kf, qf[ks], d, 0, 0, 0); }
                st[sb] = d; }
            float lsp[4][4], lk[4][4], ps[4];
#pragma unroll
            for (int sb = 0; sb < 4; ++sb) { ps[sb] = 0.f;
#pragma unroll
                for (int r = 0; r < 4; ++r) { const int s = k0 + 16 * sb + 4 * fq + r; const bool vis = tvalid && s < t; const float x = st[sb][r] * 0.125f;
                    const float l1 = fminf(x, 0.f) - __logf(1.0f + __expf(-fabsf(x)));
                    lsp[sb][r] = vis ? l1 : -1e30f; lk[sb][r] = vis ? l1 - x : 0.f; ps[sb] += lk[sb][r]; } }
            float run = carry;
            unsigned pw[8];
#pragma unroll
            for (int sb = 3; sb >= 0; --sb) {
                const float a = ps[sb], bq = __shfl_xor(a, 16), cq = __shfl_xor(a, 32), dq = __shfl_xor(bq, 32);
                const float sfq = ((fq & 1) == 0 ? bq : 0.f) + ((fq & 2) == 0 ? cq + dq : 0.f);
                float lat = run + sfq; float wv[4];
#pragma unroll
                for (int r = 3; r >= 0; --r) { wv[r] = __expf(lsp[sb][r] + lat); lat += lk[sb][r]; }
                pw[2 * sb] = pk2(wv[0], wv[1]); pw[2 * sb + 1] = pk2(wv[2], wv[3]);
                run += (a + bq) + (cq + dq);
            }
            carry = run;
            const bf16x8_t pf0 = __builtin_bit_cast(bf16x8_t, (v4u){pw[0], pw[1], pw[2], pw[3]}), pf1 = __builtin_bit_cast(bf16x8_t, (v4u){pw[4], pw[5], pw[6], pw[7]});
#pragma unroll
            for (int db = 0; db < 4; ++db) {
                LAS unsigned char* vp = lds + AT_LV + (4 * fq + q2) * 144 + 32 * db + 8 * p2;
                const bf16x8_t va0 = cat8(lds_tr16(vp), lds_tr16(vp + 16 * 144)), va1 = cat8(lds_tr16(vp + 32 * 144), lds_tr16(vp + 48 * 144));
                oacc[db] = __builtin_amdgcn_mfma_f32_16x16x32_bf16(va0, pf0, oacc[db], 0, 0, 0);
                oacc[db] = __builtin_amdgcn_mfma_f32_16x16x32_bf16(va1, pf1, oacc[db], 0, 0, 0); }
            wdone = __all(!tvalid || carry < -105.f);
        }
        if (lane == 0) ((LAS int*)(lds + AT_FLAG))[wave] = wdone ? 1 : 0;
        __syncthreads();
        k0 -= 64;
        if (k0 < 0) break;
        { const LAS int* fl = (const LAS int*)(lds + AT_FLAG); const int alld = fl[0] & fl[1] & fl[2] & fl[3] & fl[4] & fl[5] & fl[6] & fl[7]; if (alld) break; }
    }
    if (tvalid) { bf16* op = Qb + (rowb + t) * DM + h * 64 + 4 * fq;
#pragma unroll
        for (int db = 0; db < 4; ++db) *(v2u*)(op + 16 * db) = (v2u){pk2(oacc[db][0], oacc[db][1]), pk2(oacc[db][2], oacc[db][3])}; }
    __syncthreads();
}

constexpr int TAIL0 = 64 * 256, MMAIN = 64 * 256;
template <class F> __device__ __forceinline__ void tail_gemm(LAS unsigned char* lds, const bf16* A, const bf16* Bt, int K, int ncb, int bx, int G, int tid, const F& epi) {
    const int lane = tid & 63, wave = __builtin_amdgcn_readfirstlane(tid >> 6), fr = lane & 15, fq = lane >> 4, kw = K >> 3;
    for (int cb = bx; cb < ncb; cb += G) {
        f32x4 acc[4];
#pragma unroll
        for (int rb = 0; rb < 4; ++rb) acc[rb] = (f32x4){0.f, 0.f, 0.f, 0.f};
        const bf16* bp = Bt + (size_t)(16 * cb + fr) * K + wave * kw + 8 * fq;
        const bf16* ap = A + (size_t)(TAIL0 + fr) * K + wave * kw + 8 * fq;
        for (int k = 0; k < kw; k += 32) {
            const bf16x8_t bfg = *(const bf16x8_t*)(bp + k);
#pragma unroll
            for (int rb = 0; rb < 4; ++rb) { const bf16x8_t afg = *(const bf16x8_t*)(ap + (size_t)rb * 16 * K + k); acc[rb] = __builtin_amdgcn_mfma_f32_16x16x32_bf16(bfg, afg, acc[rb], 0, 0, 0); }
        }
        LAS f32x4* P = (LAS f32x4*)lds;
#pragma unroll
        for (int rb = 0; rb < 4; ++rb) P[(wave * 4 + rb) * 64 + lane] = acc[rb];
        __syncthreads();
        if (wave < 4) { f32x4 s = (f32x4){0.f, 0.f, 0.f, 0.f};
#pragma unroll
            for (int w = 0; w < 8; ++w) s += P[(w * 4 + wave) * 64 + lane];
            epi(s, TAIL0 + 16 * wave + fr, 16 * cb + 4 * fq); }
        __syncthreads();
    }
}
template <int mode> struct TailResid { float* H; const float* x; bf16* XH; float* rsq;
    __device__ __forceinline__ void operator()(f32x4 s, int row, int col0) const {
        float* hp = H + (size_t)row * DM + col0; const int l = row - BS - OFF;
        const float* bp = mode == 0 ? hp : x + ((size_t)SEQ + (l - NMETA)) * DM + col0;
        const f32x4 hv = *(const f32x4*)bp + s; *(f32x4*)hp = hv;
        *(v2u*)(XH + (size_t)row * DM + col0) = (v2u){pk2(hv[0], hv[1]), pk2(hv[2], hv[3])};
        float ss = (hv[0] * hv[0] + hv[1] * hv[1]) + (hv[2] * hv[2] + hv[3] * hv[3]); ss += __shfl_xor(ss, 16); ss += __shfl_xor(ss, 32);
        if ((threadIdx.x & 48) == 0) atomicAdd(rsq + row, ss); } };
struct TailKVQ { bf16* Kb; size_t stride; const float* rsq;
    __device__ __forceinline__ void operator()(f32x4 s, int row, int col0) const {
        s = s * rsqrtf(rsq[row] * (1.0f / DM) + EPS);
        const int t = col0 >> 10; bf16* op = Kb + (size_t)t * stride + (size_t)row * DM + (col0 & 1023);
        *(v2u*)op = (v2u){pk2(s[0], s[1]), pk2(s[2], s[3])}; } };

typedef __attribute__((address_space(1))) unsigned gu32;
#define XB_TMO      128
#define XB_XCNT(j)  (256  + 64 * (j))
#define XB_XSUB(j)  (1280 + 64 * (j))
#define XB_XGEN(j)  (2304 + 64 * (j))
#define XB_TOP      3328
#define XB_TOPGEN   3392
#define XCD_BAR_WORDS 3456
#define XB_SPIN_CAP (1u << 18)

__device__ __forceinline__ unsigned xb_ld(unsigned* p)              { return __hip_atomic_load(p, __ATOMIC_RELAXED, __HIP_MEMORY_SCOPE_AGENT); }
__device__ __forceinline__ unsigned xb_add(unsigned* p, unsigned v) { return __hip_atomic_fetch_add(p, v, __ATOMIC_RELAXED, __HIP_MEMORY_SCOPE_AGENT); }
__device__ __forceinline__ unsigned xb_xcc_id() { return (unsigned)__builtin_amdgcn_s_getreg((3 << 11) | 20) & 0xFu; }
#define XB_SPIN(cond, bar) do { unsigned _sp = 0; while (cond) { __builtin_amdgcn_s_sleep(1); \
    if ((++_sp & 255u) == 0u) { if (xb_ld(&(bar)[XB_TMO])) break; if (_sp > XB_SPIN_CAP) { atomicAdd(&(bar)[XB_TMO], 1u); break; } } } } while (0)

struct XcdBarrier {
    unsigned* bar; unsigned x;
    volatile LAS unsigned* st;
};

__device__ __forceinline__ XcdBarrier xcd_barrier_post(unsigned* bar, volatile LAS unsigned* st) {
    XcdBarrier b; b.bar = bar; b.x = xb_xcc_id(); b.st = st;
    if (threadIdx.x == 0) (void)xb_add(&bar[XB_XCNT(b.x)], 1u);
    return b;
}
__device__ __forceinline__ void xcd_barrier_complete(unsigned* bar, unsigned x, unsigned& nloc, unsigned& nx) {
    const unsigned G = gridDim.x * gridDim.y * gridDim.z;
    unsigned sum, cnt, mine, sp = 0u;
    for (;;) {
        sum = 0u; cnt = 0u; mine = 0u;
#pragma unroll
        for (unsigned j = 0; j < 16; ++j) { const unsigned c = xb_ld(&bar[XB_XCNT(j)]); sum += c; cnt += (c > 0u) ? 1u : 0u; mine = (j == x) ? c : mine; }
        if (sum == G) break;
        __builtin_amdgcn_s_sleep(1);
        if ((++sp & 255u) == 0u) { if (xb_ld(&bar[XB_TMO])) break; if (sp > XB_SPIN_CAP) { atomicAdd(&bar[XB_TMO], 1u); break; } }
    }
    nloc = mine > 0u ? mine : 1u; nx = cnt > 0u ? cnt : 1u;
}

__device__ __forceinline__ void xcd_barrier(const XcdBarrier& b) {
    asm volatile("s_waitcnt vmcnt(0)" ::: "memory");
    __syncthreads();
    if (threadIdx.x == 0) {
        unsigned* bar = b.bar;
        __builtin_amdgcn_s_waitcnt(0);
        unsigned nloc = b.st[0], nx = b.st[1];
        if (nloc == 0u) { xcd_barrier_complete(bar, b.x, nloc, nx); b.st[0] = nloc; b.st[1] = nx; }
        const unsigned old = xb_add(&bar[XB_XSUB(b.x)], 1u);
        const unsigned gen = old / nloc;
        if (old + 1u == (gen + 1u) * nloc) {
            __builtin_amdgcn_fence(__ATOMIC_RELEASE, "agent");
            asm volatile("s_waitcnt vmcnt(0)" ::: "memory");
            const unsigned og = xb_add(&bar[XB_TOP], 1u);
            const unsigned tg = og / nx;
            if (og + 1u == (tg + 1u) * nx) xb_add(&bar[XB_TOPGEN], 1u);
            else XB_SPIN(xb_ld(&bar[XB_TOPGEN]) == tg, bar);
            __builtin_amdgcn_fence(__ATOMIC_ACQUIRE, "agent");
            xb_add(&bar[XB_XGEN(b.x)], 1u);
            asm volatile("s_waitcnt vmcnt(0)" ::: "memory");
        } else {
            XB_SPIN(xb_ld(&bar[XB_XGEN(b.x)]) == gen, bar);
            __builtin_amdgcn_fence(__ATOMIC_ACQUIRE, "agent");
            asm volatile("s_waitcnt vmcnt(0)" ::: "memory");
        }
    }
    __syncthreads();
}

struct Args {
    const float* in[22]; float* outp; unsigned char* wsp; int ph_lo, ph_hi, coop, pad;
};

__device__ __forceinline__ void norm_row(const float* src, bf16* dst, float* rsq_out, int lane) {
    v2u* o8 = (v2u*)dst + lane;
    if (!src) {
#pragma unroll
        for (int j = 0; j < 4; ++j) o8[64 * j] = (v2u){0u, 0u};
        if (lane == 0) *rsq_out = 0.f;
        return; }
    const f32x4* xr = (const f32x4*)src + lane;
    f32x4 v[4]; float s = 0.f;
#pragma unroll
    for (int j = 0; j < 4; ++j) { v[j] = xr[64 * j]; s += (v[j].x * v[j].x + v[j].y * v[j].y) + (v[j].z * v[j].z + v[j].w * v[j].w); }
    s = wave_sum(s); if (lane == 0) *rsq_out = s;
#pragma unroll
    for (int j = 0; j < 4; ++j) o8[64 * j] = (v2u){pk2(v[j].x, v[j].y), pk2(v[j].z, v[j].w)};
}
__device__ __forceinline__ const float* stream_row(int r, int mode, const float* H, const float* x, const float* meta) {
    if (r >= 2 * BS) return nullptr;
    const int b = r >= BS ? 1 : 0, l = r - b * BS - OFF;
    if (l < 0 || l >= LTOK) return nullptr;
    if (mode == 0) return H + (size_t)r * DM;
    return l < NMETA ? meta + (size_t)l * DM : x + ((size_t)b * SEQ + (l - NMETA)) * DM;
}

__device__ __forceinline__ const void* ptab(volatile LAS unsigned* PT, int k) {
    const unsigned lo_ = PT[2 * k], hi_ = PT[2 * k + 1];
    return (const void*)(const __attribute__((address_space(1))) void*)(((unsigned long long)(unsigned)__builtin_amdgcn_readfirstlane((int)hi_) << 32) | (unsigned long long)(unsigned)__builtin_amdgcn_readfirstlane((int)lo_));
}
#define xin ((const float*)ptab(PT, 0))
#define metain ((const float*)ptab(PT, 1))
#define ssd_norm ((const float*)ptab(PT, 2))
#define ssd_w_in ((const float*)ptab(PT, 3))
#define ssd_conv_w ((const float*)ptab(PT, 4))
#define ssd_conv_b ((const float*)ptab(PT, 5))
#define ssd_dt_bias ((const float*)ptab(PT, 6))
#define ssd_a_log ((const float*)ptab(PT, 7))
#define ssd_d_skip ((const float*)ptab(PT, 8))
#define ssd_gate_norm ((const float*)ptab(PT, 9))
#define ssd_w_out ((const float*)ptab(PT, 10))
#define kv_norm ((const float*)ptab(PT, 11))
#define w_kv ((const float*)ptab(PT, 12))
#define sb_norm ((const float*)ptab(PT, 13))
#define sb_w_q ((const float*)ptab(PT, 14))
#define sb_w_o ((const float*)ptab(PT, 15))
#define ffn_norm ((const float*)ptab(PT, 16))
#define ffn_w_up ((const float*)ptab(PT, 17))
#define ffn_conv_w ((const float*)ptab(PT, 18))
#define ffn_conv_b ((const float*)ptab(PT, 19))
#define ffn_w_down ((const float*)ptab(PT, 20))
#define final_norm ((const float*)ptab(PT, 21))
#define ws ((unsigned char*)ptab(PT, 22))
#define Win ((bf16*)(ws + WS_WIN))
#define Wout ((bf16*)(ws + WS_WOUT))
#define Wkvq ((bf16*)(ws + WS_WKVQ))
#define Wo ((bf16*)(ws + WS_WO))
#define Wup0 ((bf16*)(ws + WS_WUP0))
#define Wup1 ((bf16*)(ws + WS_WUP1))
#define Wdn0 ((bf16*)(ws + WS_WDN0))
#define Wdn1 ((bf16*)(ws + WS_WDN1))
#define DT ((float*)(ws + WS_DT))
#define XBC ((bf16*)(ws + WS_XBC))
#define H ((float*)(ws + WS_H))
#define Z ((bf16*)(ws + WS_Z))
#define ACT ((bf16*)(ws + WS_ACT))
#define KB ((bf16*)(ws + WS_K))
#define VB ((bf16*)(ws + WS_V))
#define QB ((bf16*)(ws + WS_Q))
#define RSQ(k) ((float*)(ws + WS_RSQ) + (size_t)(k) * MRX)
#define XN ((bf16*)ptab(PT, 23))
#define OUTP ((float*)ptab(PT, 23))
__global__ void __launch_bounds__(NTHR, 2) mega(const Args args) {
    extern __shared__ __attribute__((aligned(16))) unsigned char lds_raw[];
    LAS unsigned char* lds = (LAS unsigned char*)lds_raw;
    const int tid = threadIdx.x, lane = tid & 63, wave = __builtin_amdgcn_readfirstlane(tid >> 6);
    const int G = gridDim.x, bx = blockIdx.x;
    const int gw = bx * NWAVES + wave, NGW = G * NWAVES;
    volatile LAS unsigned* PT = (volatile LAS unsigned*)(lds + RING_BYTES + XCH_BYTES);
    if (tid >= 64 && tid < 66) ((volatile LAS unsigned*)(lds + RING_BYTES + XCH_BYTES + 512))[tid - 64] = 0u;
    if (tid < 24) { const unsigned long long pv = tid < 22 ? (unsigned long long)args.in[tid] : (tid == 22 ? (unsigned long long)args.wsp : (unsigned long long)args.outp); PT[2 * tid] = (unsigned)pv; PT[2 * tid + 1] = (unsigned)(pv >> 32); }
    __syncthreads();
    volatile unsigned long long* TS = (volatile unsigned long long*)(ws + 65536);
#define STAMP(i) do { if (PROBE_ON && bx == 0 && tid == 0) TS[i] = __builtin_amdgcn_s_memrealtime(); } while (0)
    const int lo = args.ph_lo, hi = args.ph_hi;
#define IN(k) (lo <= (k) && (k) < hi)
    constexpr size_t WS_BAR = 131072;
    XcdBarrier xbar; xbar.bar = (unsigned*)(ws + WS_BAR); xbar.x = 0; xbar.st = (volatile LAS unsigned*)(lds + RING_BYTES + XCH_BYTES + 512);
#define SEAM(k) do { if (args.coop && IN(k) && IN((k) + 1)) { xcd_barrier(xbar); } } while (0)

    STAMP(0); if (IN(0)) {
        LAS float* scr = (LAS float*)(lds + wave * 16384);
        constexpr int I_IN = 16 * (NIN / 32), I_OUT = 32 * 32, I_KVQ = 16 * 96, I_O = 16 * 32, I_UP = 16 * (NUP / 32), I_DN = 44 * 32;
        constexpr int NITEMS = I_IN + I_OUT + I_KVQ + I_O + 2 * I_UP + 2 * I_DN;
        for (int it = gw; it < NITEMS; it += NGW) {
            int r = it;
            if (r < I_IN) { const int nb = r % (NIN / 32), kb = r / (NIN / 32), n0 = nb * 32; transpose_item(ssd_w_in, NIN_REAL, DM, Win, n0, n0 < NIN_REAL ? n0 : -1, kb * 64, ssd_norm, scr, lane); continue; } r -= I_IN;
            if (r < I_OUT) { const int nb = r % 32, kb = r / 32; transpose_item(ssd_w_out, DM, DI, Wout, nb * 32, nb * 32, kb * 64, ssd_gate_norm, scr, lane); continue; } r -= I_OUT;
            if (r < I_KVQ) { const int nb = r % 96, kb = r / 96, n0 = nb * 32;
                if (n0 < 2048) transpose_item(w_kv, 2048, DM, Wkvq, n0, n0, kb * 64, kv_norm, scr, lane); else transpose_item(sb_w_q, DM, DM, Wkvq, n0, n0 - 2048, kb * 64, sb_norm, scr, lane);
                continue; } r -= I_KVQ;
            if (r < I_O) { const int nb = r % 32, kb = r / 32; transpose_item(sb_w_o, DM, DM, Wo, nb * 32, nb * 32, kb * 64, nullptr, scr, lane); continue; } r -= I_O;
            if (r < 2 * I_UP) { const int ly = r / I_UP; r -= ly * I_UP; const int nb = r % (NUP / 32), kb = r / (NUP / 32), n0 = nb * 32;
                const int src = ((n0 >> 7) & 1) * DFF + (n0 >> 8) * 128 + (n0 & 127);
                transpose_item(ffn_w_up + (size_t)ly * DM * NUP, NUP, DM, ly ? Wup1 : Wup0, n0, src, kb * 64, ffn_norm + ly * DM, scr, lane); continue; } r -= 2 * I_UP;
            { const int ly = r / I_DN; r -= ly * I_DN; const int nb = r % 32, kb = r / 32;
              transpose_item(ffn_w_down + (size_t)ly * DFF * DM, DM, DFF, ly ? Wdn1 : Wdn0, nb * 32, nb * 32, kb * 64, nullptr, scr, lane); }
        }
        for (int r = gw; r < MRX; r += NGW) norm_row(stream_row(r, 1, H, xin, metain), XN + (size_t)r * DM, RSQ(0) + r, lane);
        for (int i_ = bx * NTHR + tid; i_ < 4 * MRX; i_ += G * NTHR) RSQ(1)[i_] = 0.f;
    }
    if (args.coop) {
        if (bx == 0) { unsigned* bw = (unsigned*)(ws + WS_BAR); for (int i_ = tid; i_ < XCD_BAR_WORDS; i_ += NTHR) bw[i_] = 0u; }
        cg::this_grid().sync();
        xbar = xcd_barrier_post((unsigned*)(ws + WS_BAR), (volatile LAS unsigned*)(lds + RING_BYTES + XCH_BYTES + 512));
    }
    STAMP(1); if (IN(1)) {
        pg8::Gemm g{XN, Win, 2 * TPB * 256, NIN, DM, 3}; pg8::StaticOrder S; S.init(2 * TPB * 256, NIN, G, bx);
        pg8::EpiInProj E{Z, XBC, DT, ssd_conv_w, ssd_conv_b, ssd_dt_bias, RSQ(0)};
        pg8::gemm_phase<pg8::EpiInProj, pg8::StaticOrder, true, true>(lds, g, S, E);
    }
    SEAM(1);
    STAMP(2); if (IN(2)) {
        bf16* xbc = XBC; const float* dtp = DT; bf16* ST = (bf16*)(ws + WS_ST); float* DEC = (float*)(ws + 4096);
        for (int u = bx; u < NBATCH * 32 * NHS; u += G) { const int h = u % NHS, c = (u / NHS) % 32, b = u / (NHS * 32);
            ssd_unit<1>(lds, b, c, h, xbc, xbc, dtp, ST, DEC, -__expf(ssd_a_log[h]), 0.f, tid); }
        if (args.coop) xcd_barrier(xbar);
        STAMP(20);
        { const int gt = bx * NTHR + tid;
          if (gt < NBATCH * NHS * 1024) { const int bh = gt >> 10, e = gt & 1023, b = bh / NHS, h = bh % NHS; float run[8];
#pragma unroll
              for (int k = 0; k < 8; ++k) run[k] = 0.f;
              for (int c = 0; c < 32; ++c) { v4u* sp = (v4u*)(ST + ((size_t)((b * 32 + c) * NHS + h)) * 8192 + e * 8); const v4u w = *sp; const float d = DEC[(b * 32 + c) * NHS + h];
#pragma unroll
                  for (int k = 0; k < 4; ++k) { run[2 * k] = run[2 * k] * d + bf_lo(w[k]); run[2 * k + 1] = run[2 * k + 1] * d + bf_hi(w[k]); }
                  *sp = (v4u){pk2(run[0], run[1]), pk2(run[2], run[3]), pk2(run[4], run[5]), pk2(run[6], run[7])}; } } }
        if (args.coop) xcd_barrier(xbar);
        STAMP(21);
        for (int u = bx; u < NBATCH * 33 * NHS; u += G) { const int h = u % NHS, c = (u / NHS) % 33, b = u / (NHS * 33);
            ssd_unit<2>(lds, b, c, h, xbc, xbc, dtp, ST, DEC, -__expf(ssd_a_log[h]), ssd_d_skip[h], tid); }
    }
    SEAM(2);
    STAMP(3); if (IN(3)) {
        for (int r = gw; r < 2 * BS; r += NGW) {
            const int b = r >= BS ? 1 : 0, l = r - b * BS - OFF; if (l < 0 || l >= LTOK) continue;
#pragma unroll
            for (int g = 0; g < 4; ++g) {
                const v4u yq = *(const v4u*)(XBC + (size_t)r * CONVD + g * 512 + lane * 8); v4u* zp = (v4u*)(Z + (size_t)r * DI + g * 512 + lane * 8); const v4u zq = *zp;
                float hv[8]; float ss = 0.f;
#pragma unroll
                for (int e = 0; e < 4; ++e) { const float y0 = bf_lo(yq[e]), y1 = bf_hi(yq[e]), z0 = bf_lo(zq[e]), z1 = bf_hi(zq[e]);
                    hv[2 * e] = y0 * pg8::silu_f(z0); hv[2 * e + 1] = y1 * pg8::silu_f(z1); ss += hv[2 * e] * hv[2 * e] + hv[2 * e + 1] * hv[2 * e + 1]; }
                const float rs = 1.0f / sqrtf(wave_sum(ss) * (1.f / 512.f) + EPS);
                *zp = (v4u){pk2(hv[0] * rs, hv[1] * rs), pk2(hv[2] * rs, hv[3] * rs), pk2(hv[4] * rs, hv[5] * rs), pk2(hv[6] * rs, hv[7] * rs)};
            }
        }
    }
    SEAM(3);
    STAMP(4); if (IN(4)) {
        { TailResid<1> te{H, xin, XN, RSQ(1)}; tail_gemm(lds, Z, Wout, DI, DM / 16, bx, G, tid, te); }
        pg8::Gemm g{Z, Wout, MMAIN, DM, DI, 0}; pg8::StaticOrder S; S.init(MMAIN, DM, G, bx);
        pg8::EpiResid<1> E{H, xin, metain, XN, RSQ(1)};
        pg8::gemm_phase<pg8::EpiResid<1>, pg8::StaticOrder, true, true>(lds, g, S, E);
    }
    SEAM(4);
    {
        STAMP(6); if (IN(6)) {
            pg8::Gemm g{XN, Wup0, 2 * TPB * 256, NUP, DM, 2}; pg8::StaticOrder S; S.init(2 * TPB * 256, NUP, G, bx);
            pg8::EpiUp E{ACT, ffn_conv_w + (size_t)0 * 3 * NUP, ffn_conv_b + (size_t)0 * NUP, RSQ(1)};
            pg8::gemm_phase<pg8::EpiUp, pg8::StaticOrder, true, true>(lds, g, S, E);
        }
        SEAM(6);
        STAMP(7); if (IN(7)) {
            { TailResid<0> te{H, nullptr, XN, RSQ(2)}; tail_gemm(lds, ACT, Wdn0, DFF, DM / 16, bx, G, tid, te); }
            pg8::Gemm g{ACT, Wdn0, MMAIN, DM, DFF, 0}; pg8::StaticOrder S; S.init(MMAIN, DM, G, bx);
            pg8::EpiResid<0> E{H, nullptr, nullptr, XN, RSQ(2)};
            pg8::gemm_phase<pg8::EpiResid<0>, pg8::StaticOrder, true, true>(lds, g, S, E);
        }
        SEAM(7);
    }
    {
            STAMP(9); if (IN(9)) {
                { TailKVQ te{KB, (size_t)(WS_V - WS_K) / 2, RSQ(2)}; tail_gemm(lds, XN, Wkvq, DM, 3072 / 16, bx, G, tid, te); }
                pg8::Gemm g{XN, Wkvq, MMAIN, 3072, DM, 0}; pg8::StaticOrder S; S.init(MMAIN, 3072, G, bx);
                pg8::EpiBf16 E{KB, DM, DM, (size_t)(WS_V - WS_K) / 2, RSQ(2)};
                pg8::gemm_phase<pg8::EpiBf16, pg8::StaticOrder, true, true>(lds, g, S, E);
            }
            SEAM(9);
            STAMP(10); if (IN(10)) {
                constexpr int NQB = (LTOK + 127) / 128;
                bf16* qb_ = QB; const bf16* kb_ = KB; const bf16* vb_ = VB;
                for (int u = bx; u < NBATCH * 16 * NQB; u += G) { const int hh = u % 16, qi = (u / 16) % NQB, bb = u / (16 * NQB);
                    attn_unit(lds, bb, hh, qi, qb_, kb_, vb_, tid); }
            }
            SEAM(10);
            STAMP(11); if (IN(11)) {
                { TailResid<0> te{H, nullptr, XN, RSQ(3)}; tail_gemm(lds, QB, Wo, DM, DM / 16, bx, G, tid, te); }
                pg8::Gemm g{QB, Wo, MMAIN, DM, DM, 0}; pg8::StaticOrder S; S.init(MMAIN, DM, G, bx);
                pg8::EpiResid<0> E{H, nullptr, nullptr, XN, RSQ(3)};
                pg8::gemm_phase<pg8::EpiResid<0>, pg8::StaticOrder, true, true>(lds, g, S, E);
            }
            SEAM(11);
    }
    {
        STAMP(13); if (IN(13)) {
            pg8::Gemm g{XN, Wup1, 2 * TPB * 256, NUP, DM, 2}; pg8::StaticOrder S; S.init(2 * TPB * 256, NUP, G, bx);
            pg8::EpiUp E{ACT, ffn_conv_w + (size_t)1 * 3 * NUP, ffn_conv_b + (size_t)1 * NUP, RSQ(3)};
            pg8::gemm_phase<pg8::EpiUp, pg8::StaticOrder, true, true>(lds, g, S, E);
        }
        SEAM(13);
        STAMP(14); if (IN(14)) {
            { TailResid<0> te{H, nullptr, XN, RSQ(4)}; tail_gemm(lds, ACT, Wdn1, DFF, DM / 16, bx, G, tid, te); }
            pg8::Gemm g{ACT, Wdn1, MMAIN, DM, DFF, 0}; pg8::StaticOrder S; S.init(MMAIN, DM, G, bx);
            pg8::EpiResid<0> E{H, nullptr, nullptr, XN, RSQ(4)};
            pg8::gemm_phase<pg8::EpiResid<0>, pg8::StaticOrder, true, true>(lds, g, S, E);
        }
        SEAM(14);
    }
#if EXTRA_SYNCS
    if (args.coop) { for (int i_ = 0; i_ < EXTRA_SYNCS; ++i_) xcd_barrier(xbar); }
#endif
    STAMP(15);
    float probe_b = 0.f;
    if (PROBE_ON) {
#define TD(i, j) ((float)(TS[j] - TS[i]) * 0.01f)
        probe_b = (PROBE_EXPR) * (1.0f / 200.0f);
#undef TD
    }
    if (IN(15)) {
        for (int r = gw; r < NBATCH * SEQ; r += NGW) {
            const int b = r / SEQ, t = r % SEQ; const f32x4* xr = (const f32x4*)(H + (size_t)(b * BS + OFF + NMETA + t) * DM) + lane;
            f32x4 v[4]; float s = 0.f;
#pragma unroll
            for (int j = 0; j < 4; ++j) v[j] = xr[64 * j];
            (void)s; const float rstd = rsqrtf(RSQ(4)[b * BS + OFF + NMETA + t] * (1.f / DM) + EPS);
            f32x4* op = (f32x4*)(OUTP + (size_t)r * DM) + lane; const f32x4* gp = (const f32x4*)final_norm + lane;
#pragma unroll
            for (int j = 0; j < 4; ++j) op[64 * j] = PROBE_ON ? (f32x4){probe_b, probe_b, probe_b, probe_b} : v[j] * rstd * gp[64 * j];
        }
    }
#undef IN
#undef SEAM
}

#undef xin
#undef metain
#undef ssd_norm
#undef ssd_w_in
#undef ssd_conv_w
#undef ssd_conv_b
#undef ssd_dt_bias
#undef ssd_a_log
#undef ssd_d_skip
#undef ssd_gate_norm
#undef ssd_w_out
#undef kv_norm
#undef w_kv
#undef sb_norm
#undef sb_w_q
#undef sb_w_o
#undef ffn_norm
#undef ffn_w_up
#undef ffn_conv_w
#undef ffn_conv_b
#undef ffn_w_down
#undef final_norm
#undef ws
#undef Win
#undef Wout
#undef Wkvq
#undef Wo
#undef Wup0
#undef Wup1
#undef Wdn0
#undef Wdn1
#undef DT
#undef XBC
#undef H
#undef Z
#undef ACT
#undef KB
#undef VB
#undef QB
#undef XN
#undef RSQ
#undef OUTP
constexpr int NPHASES = 16;
extern "C" void kernel_launch(void* const* d_in, const int* in_sizes, int n_in, void* d_out, int out_size, void* d_ws, size_t ws_size, hipStream_t stream) {
    static int grid = 0;
    if (grid == 0) {
        if (n_in != 22 || ws_size < WS_END || out_size != NBATCH * SEQ * DM) { fprintf(stderr, "kernel_launch: unexpected shapes (n_in %d ws %zu out %d)\n", n_in, ws_size, out_size); grid = -1; return; }
        int dev = 0, cus = 0, per_cu = 0;
        (void)hipGetDevice(&dev); (void)hipDeviceGetAttribute(&cus, hipDeviceAttributeMultiprocessorCount, dev);
        (void)hipFuncSetAttribute((const void*)mega, hipFuncAttributeMaxDynamicSharedMemorySize, LDS_BYTES);
        (void)hipOccupancyMaxActiveBlocksPerMultiprocessor(&per_cu, (const void*)mega, NTHR, LDS_BYTES);
        (void)hipGetLastError();
        if (per_cu < 1) per_cu = 1;
        grid = cus * 1;
    }
    if (grid < 0) return;
    Args a{};
    for (int i = 0; i < 22; ++i) a.in[i] = (const float*)d_in[i];
    a.outp = (float*)d_out; a.wsp = (unsigned char*)d_ws;
#if MK_COOP
    a.ph_lo = 0; a.ph_hi = NPHASES; a.coop = 1;
    void* kargs[] = {&a};
    hipError_t e = hipLaunchCooperativeKernel((const void*)mega, dim3(grid), dim3(NTHR), kargs, LDS_BYTES, stream);
    if (e != hipSuccess) fprintf(stderr, "cooperative launch failed: %s (grid %d)\n", hipGetErrorString(e), grid);
#else
    for (int p = 0; p < NPHASES; ++p) { a.ph_lo = p; a.ph_hi = p + 1; a.coop = 0; hipLaunchKernelGGL(mega, dim3(grid), dim3(NTHR), LDS_BYTES, stream, a); }
#endif
}
```

```cpp
#include <hip/hip_runtime.h>
#include <hip/hip_cooperative_groups.h>
#include <cstdio>
#include <cstdint>
namespace cg = cooperative_groups;

constexpr int DM = 1024, NBATCH = 2, SEQ = 8192, NMETA = 16, LTOK = NMETA + SEQ;
constexpr int BS = 8224, OFF = 16;
constexpr int MR = 65 * 256;
constexpr int MRX = 66 * 256;
constexpr int TPB = 33;
constexpr int DI = 2048, NSTATE = 128, NHS = 32, CONVD = 3072, NIN = 5376, NIN_REAL = 5152;
constexpr int DFF = 2816, NUP = 5632;
constexpr float EPS = 1e-6f;

#ifndef MK_COOP
#define MK_COOP 1
#endif
#define PROBE_ON 0
#define PROBE_EXPR 0.f
#define EXTRA_SYNCS 0
#define REP_UP 0
#define REP_SSD1 0
#define REP_P0 0
namespace pg8 {
#define PG8_LAS __attribute__((address_space(3)))
typedef unsigned short bf16_t;
typedef short bf16x8 __attribute__((ext_vector_type(8)));
typedef float f32x4 __attribute__((ext_vector_type(4)));
typedef unsigned u32x4 __attribute__((ext_vector_type(4)));
constexpr int BM = 256, BK = 64, HALF = 128, HTB = HALF * BK * 2  , STAGE_BYTES = 8 * HTB, NXCD = 8, WGM = 8;

__host__ __device__ __forceinline__ int lds_byte(int r, int c) { const int st = (r >> 4) * 2 + (c >> 5), rr = r & 15, cc = c & 31, ob = rr * 64 + cc * 2; return st * 1024 + (ob ^ (((ob >> 9) & 1) << 5)); }
__host__ __device__ __forceinline__ void stage_rc(int b, int& R, int& C) { const int st = b / 1024, sb = b % 1024, swz = sb ^ (((sb >> 9) & 1) << 5); R = (st >> 1) * 16 + swz / 64; C = (st & 1) * 32 + (swz % 64) / 2; }
__host__ __device__ __forceinline__ int perm32(int rho) { const int n = rho >> 4, i = rho & 15; return 8 * (i >> 2) + 4 * n + (i & 3); }

struct Unit { int pm, pn; };
struct Gemm { const bf16_t* A; const bf16_t* Bt; int M, N, K; int halo;
    __device__ __forceinline__ size_t a_off(int pm) const { const int row = halo == 0 ? pm * 256 : (pm / TPB) * BS + OFF - halo + (256 - halo) * (pm % TPB); return (size_t)row * (size_t)K * 2; } };

struct StaticOrder {
    int nM, nN, nwg, G, c;
    __host__ __device__ void init(int M, int N, int G_, int c_) { nM = M / BM; nN = N / BM; nwg = nM * nN; G = G_; c = c_; }
    __host__ __device__ bool next(int i, Unit& u) const {
        const long L = (long)i * G + c; if (L >= nwg) return false;
        int wgid = (int)L; { const int q = nwg / NXCD, r = nwg % NXCD, xcd = wgid % NXCD, off = wgid / NXCD; wgid = (xcd < r ? xcd * (q + 1) : r * (q + 1) + (xcd - r) * q) + off; }
        const int nig = WGM * nN, gid = wgid / nig, fm = gid * WGM, gsz = (nM - fm) < WGM ? (nM - fm) : WGM;
        u.pm = fm + ((wgid % nig) % gsz); u.pn = (wgid % nig) / gsz; return true;
    }
    __device__ __forceinline__ void a_ready(const Unit&) const {}
    __device__ __forceinline__ void done(const Unit&) const {}
};

__device__ __forceinline__ unsigned cvt_pk_bf16(float lo, float hi) { unsigned r; asm volatile("v_cvt_pk_bf16_f32 %0, %1, %2" : "=v"(r) : "v"(lo), "v"(hi)); return r; }
typedef float f32x2 __attribute__((ext_vector_type(2)));
__device__ __forceinline__ float silu_f(float v) { return v * __builtin_amdgcn_rcpf(1.0f + __expf(-v)); }
__device__ __forceinline__ float softplus_f(float v) { return fmaxf(v, 0.f) + log1pf(__expf(-fabsf(v))); }
__device__ __forceinline__ float bflo(unsigned u) { return __uint_as_float(u << 16); }
__device__ __forceinline__ float bfhi(unsigned u) { return __uint_as_float(u & 0xffff0000u); }
typedef unsigned u32x2 __attribute__((ext_vector_type(2)));

struct EpiBf16 {
    static constexpr bool PERM = true, AFTER_DRAIN = false;
    bf16_t* O; int ldc; int split_cols; size_t split_stride; const float* rsq;
    __device__ __forceinline__ void operator()(const f32x4 (&acc)[2][2][4][2], const Unit& u, int wr, int wc, int fr, int fq, PG8_LAS unsigned char*) const {
        asm volatile("" : "+v"(fr), "+v"(fq));
        const int row0 = u.pm * BM + wr * 64 + fr; int colt = u.pn * BM; bf16_t* base = O;
        if (split_cols) { const int t = colt / split_cols; base += (size_t)t * split_stride; colt -= t * split_cols; }
        const int col0 = colt + wc * 32 + 8 * fq;
#pragma unroll
        for (int ai = 0; ai < 2; ++ai)
#pragma unroll
            for (int m = 0; m < 4; ++m) { bf16_t* rowp = base + (size_t)(row0 + ai * HALF + m * 16) * ldc + col0;
                const float rs = rsqrtf(rsq[row0 + ai * HALF + m * 16] * (1.0f / DM) + EPS);
#pragma unroll
                for (int bj = 0; bj < 2; ++bj) { const f32x4 v0 = acc[ai][bj][m][0] * rs, v1 = acc[ai][bj][m][1] * rs;
                    u32x4 w; w.x = cvt_pk_bf16(v0[0], v0[1]); w.y = cvt_pk_bf16(v0[2], v0[3]); w.z = cvt_pk_bf16(v1[0], v1[1]); w.w = cvt_pk_bf16(v1[2], v1[3]);
                    *(u32x4*)(rowp + bj * HALF) = w; } }
    }
};

template <int mode> struct EpiResid {
    static constexpr bool PERM = false, AFTER_DRAIN = false;
    float* H; const float* x; const float* meta; bf16_t* XH; float* rsq;
    __device__ __forceinline__ void operator()(const f32x4 (&acc)[2][2][4][2], const Unit& u, int wr, int wc, int fr, int fq, PG8_LAS unsigned char*) const {
        asm volatile("" : "+v"(fr), "+v"(fq));
        const int col0 = u.pn * BM + wc * 32 + 4 * fq;
#pragma unroll
        for (int ai = 0; ai < 2; ++ai)
#pragma unroll
            for (int m = 0; m < 4; ++m) {
                const int r = u.pm * BM + ai * HALF + wr * 64 + m * 16 + fr;
                const int b = r >= BS ? 1 : 0, l = r - b * BS - OFF;
                const bool valid = l >= 0 && l < LTOK; float ss = 0.f;
                if (valid) {
                    float* hp = H + (size_t)r * DM + col0;
                    const float* bp = mode == 0 ? hp : (l < NMETA ? meta + (size_t)l * DM + col0 : x + ((size_t)b * SEQ + (l - NMETA)) * DM + col0);
#pragma unroll
                    for (int bj = 0; bj < 2; ++bj)
#pragma unroll
                        for (int n = 0; n < 2; ++n) { const f32x4 hv = *(const f32x4*)(bp + bj * HALF + n * 16) + acc[ai][bj][m][n]; *(f32x4*)(hp + bj * HALF + n * 16) = hv;
                            ss += (hv[0] * hv[0] + hv[1] * hv[1]) + (hv[2] * hv[2] + hv[3] * hv[3]);
                            u32x2 w; w.x = cvt_pk_bf16(hv[0], hv[1]); w.y = cvt_pk_bf16(hv[2], hv[3]); *(u32x2*)(XH + (size_t)r * DM + col0 + bj * HALF + n * 16) = w; }
                }
                ss += __shfl_xor(ss, 16); ss += __shfl_xor(ss, 32);
                if (fq == 0 && valid) atomicAdd(rsq + r, ss);
                asm volatile("" ::: "memory");
            }
    }
};

__device__ __forceinline__ void row_scale(f32x4 (&acc)[2][2][4][2], const float* rp) {
#pragma unroll
    for (int ai = 0; ai < 2; ++ai)
#pragma unroll
        for (int m = 0; m < 4; ++m) { const float rs = rsqrtf(rp[ai * HALF + m * 16] * (1.0f / DM) + EPS);
#pragma unroll
            for (int bj = 0; bj < 2; ++bj)
#pragma unroll
                for (int n = 0; n < 2; ++n) acc[ai][bj][m][n] = acc[ai][bj][m][n] * rs; }
}
__device__ __forceinline__ void halo_publish(const f32x4 (&acc)[2][2][4][2], PG8_LAS unsigned char* xl, int wr, int wc, int fr, int fq) {
    PG8_LAS f32x4* X = (PG8_LAS f32x4*)xl; const int wave = wr * 4 + wc;
    if (fr >= 12) {
#pragma unroll
        for (int ai = 0; ai < 2; ++ai)
#pragma unroll
            for (int bj = 0; bj < 2; ++bj)
#pragma unroll
                for (int n = 0; n < 2; ++n) X[(((wave * 2 + ai) * 4 + bj * 2 + n) * 16) + fq * 4 + (fr - 12)] = acc[ai][bj][3][n];
    }
    asm volatile("s_waitcnt lgkmcnt(0)" ::: "memory"); __builtin_amdgcn_s_barrier(); asm volatile("" ::: "memory");
}
__device__ __forceinline__ f32x4 halo_get(PG8_LAS unsigned char* xl, int ai, int bj, int n, int wr, int wc, int fr, int fq) {
    const PG8_LAS f32x4* X = (const PG8_LAS f32x4*)xl; const int pai = wr == 1 ? ai : ai - 1, pw = (wr ^ 1) * 4 + wc;
    f32x4 r = (f32x4){0.f, 0.f, 0.f, 0.f};
    if (fr >= 12 && pai >= 0) r = X[(((pw * 2 + pai) * 4 + bj * 2 + n) * 16) + fq * 4 + (fr - 12)];
    return r;
}

struct EpiInProj {
    static constexpr bool PERM = true, AFTER_DRAIN = false;
    bf16_t* Z; bf16_t* XBC; float* DT; const float* cw; const float* cb; const float* dtb; const float* rsq;
    __device__ __forceinline__ void operator()(f32x4 (&acc)[2][2][4][2], const Unit& u, int wr, int wc, int fr, int fq, PG8_LAS unsigned char* xl) const {
        asm volatile("" : "+v"(fr), "+v"(fq));
        const int pb = u.pm / TPB, pt = u.pm % TPB, l0 = 253 * pt - 3, rowbase = pb * BS + OFF + l0, lane = fq * 16 + fr;
        row_scale(acc, rsq + rowbase + wr * 64 + fr);
        if (u.pn < 8) {
            const int col0 = u.pn * BM + wc * 32 + 8 * fq;
#pragma unroll
            for (int ai = 0; ai < 2; ++ai)
#pragma unroll
                for (int m = 0; m < 4; ++m) { const int i = ai * HALF + wr * 64 + m * 16 + fr, l = l0 + i;
                    if (i >= 3 && l < LTOK) { bf16_t* rowp = Z + (size_t)(rowbase + i) * DI + col0;
#pragma unroll
                        for (int bj = 0; bj < 2; ++bj) { const f32x4 v0 = acc[ai][bj][m][0], v1 = acc[ai][bj][m][1];
                            u32x4 w; w.x = cvt_pk_bf16(v0[0], v0[1]); w.y = cvt_pk_bf16(v0[2], v0[3]); w.z = cvt_pk_bf16(v1[0], v1[1]); w.w = cvt_pk_bf16(v1[2], v1[3]);
                            *(u32x4*)(rowp + bj * HALF) = w; } } }
        } else if (u.pn < 20) {
            halo_publish(acc, xl, wr, wc, fr, fq);
            const int s1 = (lane & 48) | ((fr - 1) & 15), s2 = (lane & 48) | ((fr - 2) & 15), s3 = (lane & 48) | ((fr - 3) & 15);
#pragma unroll
            for (int bj = 0; bj < 2; ++bj)
#pragma unroll
                for (int n = 0; n < 2; ++n) {
                    const int c0 = (u.pn - 8) * BM + bj * HALF + wc * 32 + 8 * fq + 4 * n;
                    const f32x4 w0 = *(const f32x4*)(cw + c0), w1 = *(const f32x4*)(cw + CONVD + c0), w2 = *(const f32x4*)(cw + 2 * CONVD + c0), w3 = *(const f32x4*)(cw + 3 * CONVD + c0), bb = *(const f32x4*)(cb + c0);
#pragma unroll
                    for (int ai = 0; ai < 2; ++ai)
#pragma unroll
                        for (int m = 0; m < 4; ++m) {
                            const f32x4 cur = acc[ai][bj][m][n];
                            f32x4 prv; if (m > 0) prv = acc[ai][bj][m > 0 ? m - 1 : 0][n]; else prv = halo_get(xl, ai, bj, n, wr, wc, fr, fq);
                            float o[4];
#pragma unroll
                            for (int j = 0; j < 4; ++j) {
                                const float v1 = __shfl(fr >= 15 ? prv[j] : cur[j], s1), v2 = __shfl(fr >= 14 ? prv[j] : cur[j], s2), v3 = __shfl(fr >= 13 ? prv[j] : cur[j], s3);
                                o[j] = silu_f(bb[j] + w3[j] * cur[j] + w2[j] * v1 + w1[j] * v2 + w0[j] * v3);
                            }
                            const int i = ai * HALF + wr * 64 + m * 16 + fr, l = l0 + i;
                            if (i >= 3 && l < LTOK) { u32x2 w; w.x = cvt_pk_bf16(o[0], o[1]); w.y = cvt_pk_bf16(o[2], o[3]); *(u32x2*)(XBC + (size_t)(rowbase + i) * CONVD + c0) = w; }
                        }
                    asm volatile("" ::: "memory");
                }
        } else {
            if (wc == 0) {
#pragma unroll
                for (int n = 0; n < 2; ++n) { const int c0 = 8 * fq + 4 * n; const f32x4 bb = *(const f32x4*)(dtb + c0);
#pragma unroll
                    for (int ai = 0; ai < 2; ++ai)
#pragma unroll
                        for (int m = 0; m < 4; ++m) { const int i = ai * HALF + wr * 64 + m * 16 + fr, l = l0 + i; const f32x4 v = acc[ai][0][m][n] + bb;
                            if (i >= 3 && l < LTOK) *(f32x4*)(DT + (size_t)(rowbase + i) * NHS + c0) = (f32x4){softplus_f(v[0]), softplus_f(v[1]), softplus_f(v[2]), softplus_f(v[3])}; } }
            }
        }
    }
};

struct EpiUp {
    static constexpr bool PERM = true, AFTER_DRAIN = false;
    bf16_t* ACT; const float* cw; const float* cb; const float* rsq;
    __device__ __forceinline__ void operator()(f32x4 (&acc)[2][2][4][2], const Unit& u, int wr, int wc, int fr, int fq, PG8_LAS unsigned char* xl) const {
        asm volatile("" : "+v"(fr), "+v"(fq));
        const int pb = u.pm / TPB, pt = u.pm % TPB, l0 = 254 * pt - 2, rowbase = pb * BS + OFF + l0, lane = fq * 16 + fr;
        row_scale(acc, rsq + rowbase + wr * 64 + fr);
        halo_publish(acc, xl, wr, wc, fr, fq);
        const int s1 = (lane & 48) | ((fr - 1) & 15), s2 = (lane & 48) | ((fr - 2) & 15);
#pragma unroll
        for (int n = 0; n < 2; ++n) {
            const int c0 = u.pn * HALF + wc * 32 + 8 * fq + 4 * n;
            const f32x4 g0 = *(const f32x4*)(cw + c0), g1 = *(const f32x4*)(cw + NUP + c0), g2 = *(const f32x4*)(cw + 2 * NUP + c0), gb = *(const f32x4*)(cb + c0);
            const f32x4 h0 = *(const f32x4*)(cw + DFF + c0), h1 = *(const f32x4*)(cw + NUP + DFF + c0), h2 = *(const f32x4*)(cw + 2 * NUP + DFF + c0), hb = *(const f32x4*)(cb + DFF + c0);
#pragma unroll
            for (int ai = 0; ai < 2; ++ai)
#pragma unroll
                for (int m = 0; m < 4; ++m) {
                    const f32x4 cg = acc[ai][0][m][n], cv = acc[ai][1][m][n];
                    f32x4 pg, pv; if (m > 0) { pg = acc[ai][0][m > 0 ? m - 1 : 0][n]; pv = acc[ai][1][m > 0 ? m - 1 : 0][n]; } else { pg = halo_get(xl, ai, 0, n, wr, wc, fr, fq); pv = halo_get(xl, ai, 1, n, wr, wc, fr, fq); }
                    float o[4];
#pragma unroll
                    for (int j = 0; j < 4; ++j) {
                        const float a1 = __shfl(fr >= 15 ? pg[j] : cg[j], s1), a2 = __shfl(fr >= 14 ? pg[j] : cg[j], s2);
                        const float b1 = __shfl(fr >= 15 ? pv[j] : cv[j], s1), b2 = __shfl(fr >= 14 ? pv[j] : cv[j], s2);
                        const float gg = gb[j] + g2[j] * cg[j] + g1[j] * a1 + g0[j] * a2, vv = hb[j] + h2[j] * cv[j] + h1[j] * b1 + h0[j] * b2;
                        o[j] = silu_f(gg) * vv;
                    }
                    const int i = ai * HALF + wr * 64 + m * 16 + fr, l = l0 + i;
                    if (i >= 2 && l < LTOK) { u32x2 w; w.x = cvt_pk_bf16(o[0], o[1]); w.y = cvt_pk_bf16(o[2], o[3]); *(u32x2*)(ACT + (size_t)(rowbase + i) * DFF + c0) = w; }
                }
            asm volatile("" ::: "memory");
        }
    }
};

template <class Epi, class Sched, bool ALIGN_EPI = false, bool SP2 = false>
__device__ __forceinline__ void gemm_phase(PG8_LAS unsigned char* lds, const Gemm g, const Sched& S, const Epi& E) {
    const int tid = threadIdx.x, wid = __builtin_amdgcn_readfirstlane(tid >> 6), lane = tid & 63, wr = wid >> 2, wc = wid & 3, fr = lane & 15, fq = lane >> 4;
    const int K = g.K, nt = K / BK;
    unsigned voffA[2], voffB[2];
#pragma unroll
    for (int i = 0; i < 2; ++i) { int R, C; stage_rc(tid * 16 + i * 8192, R, C); const int Rb = Epi::PERM ? ((R & ~31) + perm32(R & 31)) : R;
        voffA[i] = (unsigned)(R * K + C) * 2u; voffB[i] = (unsigned)(Rb * K + C) * 2u; }
    const size_t kstep = (size_t)(BK * 2);
    const size_t hstep = (size_t)HALF * K * 2;
    const size_t tstep = 2 * hstep;
    const unsigned ldsw = (unsigned)wid * 1024u;
    const int aoff = lds_byte(wr * 64 + fr, fq * 8), boff = lds_byte(wc * 32 + fr, fq * 8);
#define PG8_SA(b, h) (((b) * 2 + (h)) * HTB)
#define PG8_SB(b, h) ((4 + (b) * 2 + (h)) * HTB)
#define PG8_STAGE(bufoff, gbase, voff) do { _Pragma("unroll") for (int _i = 0; _i < 2; ++_i) \
        __builtin_amdgcn_global_load_lds((const unsigned*)((const char*)(gbase) + (voff)[_i]), (PG8_LAS unsigned*)(lds + (bufoff) + ldsw + _i * 8192), 16, 0, 0); } while (0)
#define PG8_LDA(dst, b, h) do { _Pragma("unroll") for (int m = 0; m < 4; ++m) _Pragma("unroll") for (int k = 0; k < 2; ++k) dst[m][k] = *(const PG8_LAS bf16x8*)(lds + PG8_SA(b, h) + aoff + m * 2048 + k * 1024); } while (0)
#define PG8_LDB(dst, b, h) do { _Pragma("unroll") for (int n = 0; n < 2; ++n) _Pragma("unroll") for (int k = 0; k < 2; ++k) dst[n][k] = *(const PG8_LAS bf16x8*)(lds + PG8_SB(b, h) + boff + n * 2048 + k * 1024); } while (0)
#define PG8_MMA(ai, bj, At, Bt) do { __builtin_amdgcn_s_setprio(1); _Pragma("unroll") for (int m = 0; m < 4; ++m) _Pragma("unroll") for (int n = 0; n < 2; ++n) _Pragma("unroll") for (int k = 0; k < 2; ++k) \
        acc[ai][bj][m][n] = __builtin_amdgcn_mfma_f32_16x16x32_bf16(Bt[n][k], At[m][k], acc[ai][bj][m][n], 0, 0, 0); __builtin_amdgcn_s_setprio(0); } while (0)
#define PG8_WAIT_V(n) asm volatile("s_waitcnt vmcnt(" #n ")" ::: "memory")
#define PG8_WAIT_L(n) asm volatile("s_waitcnt lgkmcnt(" #n ")" ::: "memory")
#define PG8_BAR __builtin_amdgcn_s_barrier()
#define PG8_SCHED __builtin_amdgcn_sched_barrier(0)
    Unit cur, nxt; int ui = 0;
    if (!S.next(0, cur)) return;
    f32x4 acc[2][2][4][2];
#pragma unroll
    for (int a = 0; a < 2; ++a)
#pragma unroll
        for (int b = 0; b < 2; ++b)
#pragma unroll
            for (int m = 0; m < 4; ++m)
#pragma unroll
                for (int n = 0; n < 2; ++n) acc[a][b][m][n] = (f32x4){0.f, 0.f, 0.f, 0.f};
    bf16x8 At[4][2], B0[2][2], B1[2][2];
    const char* cA = (const char*)g.A + g.a_off(cur.pm); const char* cB = (const char*)g.Bt + (size_t)cur.pn * tstep;
    S.a_ready(cur);
    if constexpr (SP2) {
        PG8_STAGE(PG8_SB(0, 0), cB, voffB); PG8_STAGE(PG8_SB(0, 1), cB + hstep, voffB); PG8_STAGE(PG8_SA(0, 0), cA, voffA); PG8_STAGE(PG8_SA(0, 1), cA + hstep, voffA);
        if (wr == 1) PG8_BAR;
        PG8_WAIT_V(2); PG8_BAR;
        PG8_STAGE(PG8_SB(1, 0), cB + kstep, voffB); PG8_STAGE(PG8_SA(1, 0), cA + kstep, voffA); PG8_STAGE(PG8_SB(1, 1), cB + hstep + kstep, voffB);
        PG8_WAIT_V(6); PG8_BAR;
    } else {
        PG8_STAGE(PG8_SB(0, 0), cB, voffB); PG8_STAGE(PG8_SA(0, 0), cA, voffA); PG8_STAGE(PG8_SB(0, 1), cB + hstep, voffB); PG8_STAGE(PG8_SA(0, 1), cA + hstep, voffA);
        if (wr == 1) PG8_BAR;
        PG8_WAIT_V(4); PG8_BAR;
        PG8_STAGE(PG8_SB(1, 0), cB + kstep, voffB); PG8_STAGE(PG8_SA(1, 0), cA + kstep, voffA); PG8_STAGE(PG8_SB(1, 1), cB + hstep + kstep, voffB);
        PG8_WAIT_V(6); PG8_BAR;
    }
    for (;;) {
        const bool has_next = S.next(ui + 1, nxt);
        const char* nA = has_next ? (const char*)g.A + g.a_off(nxt.pm) : cA; const char* nB = has_next ? (const char*)g.Bt + (size_t)nxt.pn * tstep : cB;
        for (int t = 0; t < nt; t += 2) {
            const bool last = (t == nt - 2);
            const char* a1 = cA + (size_t)(t + 1) * kstep;
            const char* a2 = last ? nA : cA + (size_t)(t + 2) * kstep; const char* b2 = last ? nB : cB + (size_t)(t + 2) * kstep;
            const char* a3 = a2 + kstep; const char* b3 = b2 + kstep;
            if (last && has_next) S.a_ready(nxt);
            if constexpr (SP2) {
            PG8_LDB(B0, 0, 0); PG8_LDB(B1, 0, 1); PG8_SCHED; PG8_LDA(At, 0, 0); PG8_STAGE(PG8_SA(1, 1), a1 + hstep, voffA);
            PG8_WAIT_V(8); PG8_WAIT_L(0); PG8_BAR; PG8_MMA(0, 0, At, B0); PG8_MMA(0, 1, At, B1); PG8_BAR; PG8_SCHED;
            PG8_LDA(At, 0, 1); PG8_STAGE(PG8_SB(0, 0), b2, voffB); PG8_STAGE(PG8_SB(0, 1), b2 + hstep, voffB); PG8_STAGE(PG8_SA(0, 0), a2, voffA);
            PG8_WAIT_V(8); PG8_WAIT_L(0); PG8_BAR; PG8_MMA(1, 0, At, B0); PG8_MMA(1, 1, At, B1); PG8_BAR; PG8_SCHED;
            PG8_LDB(B0, 1, 0); PG8_LDB(B1, 1, 1); PG8_SCHED; PG8_LDA(At, 1, 0); PG8_STAGE(PG8_SA(0, 1), a2 + hstep, voffA);
            PG8_WAIT_V(8); PG8_WAIT_L(0); PG8_BAR; PG8_MMA(0, 0, At, B0); PG8_MMA(0, 1, At, B1); PG8_BAR; PG8_SCHED;
            PG8_LDA(At, 1, 1); PG8_STAGE(PG8_SB(1, 0), b3, voffB); PG8_STAGE(PG8_SB(1, 1), b3 + hstep, voffB); PG8_STAGE(PG8_SA(1, 0), a3, voffA);
            PG8_WAIT_V(8); PG8_WAIT_L(0); PG8_BAR; PG8_MMA(1, 0, At, B0); PG8_MMA(1, 1, At, B1); PG8_BAR; PG8_SCHED;
            } else {
            PG8_LDB(B0, 0, 0); PG8_SCHED; PG8_LDA(At, 0, 0); PG8_STAGE(PG8_SA(1, 1), a1 + hstep, voffA);
            PG8_WAIT_L(8); PG8_BAR; PG8_WAIT_L(0); PG8_MMA(0, 0, At, B0); PG8_BAR; PG8_SCHED;
            PG8_LDB(B1, 0, 1); PG8_STAGE(PG8_SB(0, 0), b2, voffB);
            PG8_BAR; PG8_WAIT_L(0); PG8_MMA(0, 1, At, B1); PG8_BAR;
            PG8_LDA(At, 0, 1); PG8_STAGE(PG8_SA(0, 0), a2, voffA);
            PG8_BAR; PG8_WAIT_L(0); PG8_MMA(1, 0, At, B0); PG8_BAR; PG8_SCHED;
            PG8_STAGE(PG8_SB(0, 1), b2 + hstep, voffB);
            PG8_WAIT_V(6); PG8_BAR; PG8_MMA(1, 1, At, B1); PG8_BAR;
            PG8_LDB(B0, 1, 0); PG8_SCHED; PG8_LDA(At, 1, 0); PG8_STAGE(PG8_SA(0, 1), a2 + hstep, voffA);
            PG8_WAIT_L(8); PG8_BAR; PG8_WAIT_L(0); PG8_MMA(0, 0, At, B0); PG8_BAR; PG8_SCHED;
            PG8_LDB(B1, 1, 1); PG8_STAGE(PG8_SB(1, 0), b3, voffB);
            PG8_BAR; PG8_WAIT_L(0); PG8_MMA(0, 1, At, B1); PG8_BAR;
            PG8_LDA(At, 1, 1); PG8_STAGE(PG8_SA(1, 0), a3, voffA);
            PG8_BAR; PG8_WAIT_L(0); PG8_MMA(1, 0, At, B0); PG8_BAR; PG8_SCHED;
            PG8_STAGE(PG8_SB(1, 1), b3 + hstep, voffB);
            PG8_WAIT_V(6); PG8_BAR; PG8_MMA(1, 1, At, B1); PG8_BAR;
            }
        }
        if constexpr (ALIGN_EPI) { if (wr == 0) PG8_BAR; }
        if constexpr (!Epi::AFTER_DRAIN) { E(acc, cur, wr, wc, fr, fq, lds + STAGE_BYTES); S.done(cur); }
        if (!has_next) break;
#pragma unroll
        for (int a = 0; a < 2; ++a)
#pragma unroll
            for (int b = 0; b < 2; ++b)
#pragma unroll
                for (int m = 0; m < 4; ++m)
#pragma unroll
                    for (int n = 0; n < 2; ++n) acc[a][b][m][n] = (f32x4){0.f, 0.f, 0.f, 0.f};
        cur = nxt; cA = nA; cB = nB; ++ui;
        if constexpr (ALIGN_EPI) { if (wr == 1) PG8_BAR; }
    }
    PG8_WAIT_V(0);
    if constexpr (!ALIGN_EPI) { if (wr == 0) PG8_BAR; }
    PG8_BAR;

#undef PG8_SA
#undef PG8_SB
#undef PG8_STAGE
#undef PG8_LDA
#undef PG8_LDB
#undef PG8_MMA
#undef PG8_WAIT_V
#undef PG8_WAIT_L
#undef PG8_BAR
#undef PG8_SCHED
}
}

#define LAS __attribute__((address_space(3)))
typedef unsigned short bf16;
typedef unsigned v4u __attribute__((ext_vector_type(4)));
typedef unsigned v2u __attribute__((ext_vector_type(2)));
typedef float f32x4 __attribute__((ext_vector_type(4)));
constexpr int NWAVES = 8, NTHR = 512;
constexpr int RING_BYTES = 131072, XCH_BYTES = 16384, LDS_BYTES = RING_BYTES + XCH_BYTES + 1024;

constexpr size_t MiB = 1u << 20;
constexpr size_t SZ_WIN = (size_t)NIN * DM * 2, SZ_WOUT = (size_t)DM * DI * 2, SZ_WKVQ = (size_t)3072 * DM * 2, SZ_WO = (size_t)DM * DM * 2, SZ_WUP = (size_t)NUP * DM * 2, SZ_WDN = (size_t)DM * DFF * 2;
constexpr size_t WS_WIN = 1 * MiB, WS_WOUT = WS_WIN + SZ_WIN, WS_WKVQ = WS_WOUT + SZ_WOUT, WS_WO = WS_WKVQ + SZ_WKVQ, WS_WUP0 = WS_WO + SZ_WO, WS_WUP1 = WS_WUP0 + SZ_WUP, WS_WDN0 = WS_WUP1 + SZ_WUP, WS_WDN1 = WS_WDN0 + SZ_WDN, WS_WEND = WS_WDN1 + SZ_WDN;
constexpr size_t WS_DT = 57 * MiB;
constexpr size_t WS_XBC = 60 * MiB;
constexpr size_t WS_H = WS_XBC;
constexpr size_t WS_Z = 158 * MiB;
constexpr size_t WS_ST = 223 * MiB;
constexpr size_t WS_ACT = 126 * MiB;
constexpr size_t WS_K = 126 * MiB, WS_V = 159 * MiB, WS_Q = 192 * MiB;
constexpr size_t WS_RSQ = 262144;
constexpr size_t WS_END = 256 * MiB;
static_assert(WS_WEND <= WS_DT && WS_DT + (size_t)MR * 32 * 4 <= WS_XBC && WS_XBC + (size_t)MR * CONVD * 2 <= WS_Z && WS_Z + (size_t)MR * DI * 2 <= WS_ST, "ws map 1");
static_assert(WS_H + (size_t)MR * DM * 4 <= WS_ACT && WS_ACT + (size_t)MR * DFF * 2 <= WS_END && WS_K + (size_t)MR * DM * 2 <= WS_V && WS_V + (size_t)MR * DM * 2 <= WS_Q && WS_Q + (size_t)MR * DM * 2 <= WS_END, "ws map 2");

__device__ __forceinline__ unsigned f2bf(float f) { unsigned u = __builtin_bit_cast(unsigned, f); return (u + 0x7fffu + ((u >> 16) & 1u)) >> 16; }
__device__ __forceinline__ unsigned pk2(float lo, float hi) { return f2bf(lo) | (f2bf(hi) << 16); }
__device__ __forceinline__ float wave_sum(float v) {
#pragma unroll
    for (int o = 1; o < 64; o <<= 1) v += __shfl_xor(v, o);
    return v;
}
__device__ __forceinline__ float bf_lo(unsigned u) { return __uint_as_float(u << 16); }
__device__ __forceinline__ float bf_hi(unsigned u) { return __uint_as_float(u & 0xffff0000u); }

__device__ __forceinline__ void transpose_item(const float* W, int pitch, int K, bf16* WT, int nrow0, int srccol0, int srclim, int k0, const float* gain, LAS float* scr, int lane) {
    const int n4 = (lane & 15) * 4; const bool cv = srccol0 + n4 < srclim;
    f32x4 v[16];
#pragma unroll
    for (int i = 0; i < 16; ++i) { const int kk = 4 * i + (lane >> 4); v[i] = cv ? *(const f32x4*)(W + (size_t)(k0 + kk) * pitch + srccol0 + n4) : (f32x4){0.f, 0.f, 0.f, 0.f}; }
#pragma unroll
    for (int i = 0; i < 16; ++i) { const int kk = 4 * i + (lane >> 4); const float gn = gain ? gain[k0 + kk] : 1.0f; LAS float* s = scr + kk * 65 + n4;
        s[0] = v[i][0] * gn; s[1] = v[i][1] * gn; s[2] = v[i][2] * gn; s[3] = v[i][3] * gn; }
    asm volatile("s_waitcnt lgkmcnt(0)" ::: "memory");
    const int c = lane & 7;
#pragma unroll
    for (int j = 0; j < 8; ++j) { const int n = (lane >> 3) + 8 * j; const LAS float* s = scr + (8 * c) * 65 + n;
        v4u o; o.x = pk2(s[0 * 65], s[1 * 65]); o.y = pk2(s[2 * 65], s[3 * 65]); o.z = pk2(s[4 * 65], s[5 * 65]); o.w = pk2(s[6 * 65], s[7 * 65]);
        *(v4u*)(WT + (size_t)(nrow0 + n) * K + k0 + 8 * c) = o; }
    asm volatile("s_waitcnt lgkmcnt(0)" ::: "memory");
}

constexpr int SB_LB = 0, SB_LC = 17408, SB_LX = 34816, SB_LXW = 44032, SB_LST = 53248, SB_LDT = 70656, SB_LACS = 70912;
typedef short bf16x8_t __attribute__((ext_vector_type(8)));
typedef short s16x4_t __attribute__((ext_vector_type(4)));
__device__ __forceinline__ s16x4_t lds_tr16(LAS unsigned char* p) { return __builtin_bit_cast(s16x4_t, __builtin_amdgcn_ds_read_tr16_b64_v4i16((LAS s16x4_t*)p)); }
__device__ __forceinline__ bf16x8_t cat8(s16x4_t a, s16x4_t b) { return (bf16x8_t){a[0], a[1], a[2], a[3], b[0], b[1], b[2], b[3]}; }

template <int PASS> __device__ __forceinline__ void ssd_unit(LAS unsigned char* lds, int b, int c, int h, const bf16* xbc_c, bf16* xbc_w, const float* dtp, bf16* ST, float* DEC, float a, float dsk, int tid) {
    const int lane = tid & 63, wave = __builtin_amdgcn_readfirstlane(tid >> 6), fr = lane & 15, fq = lane >> 4, q2 = fr >> 2, p2 = lane & 3, g = h >> 3;
    const int lbase = 256 * c, nvalid = (LTOK - lbase) < 256 ? (LTOK - lbase) : 256, nsub = (nvalid + 63) >> 6;
    const size_t rowb = (size_t)b * BS + OFF;
    f32x4 ast[4];
#pragma unroll
    for (int pb = 0; pb < 4; ++pb) ast[pb] = (f32x4){0.f, 0.f, 0.f, 0.f};
    if (PASS == 2 && c > 0) {
        const bf16* sp = ST + ((size_t)((b * 32 + (c - 1)) * NHS + h)) * 8192;
#pragma unroll
        for (int pb = 0; pb < 4; ++pb) { const v2u w = *(const v2u*)(sp + (16 * pb + fr) * 128 + 16 * wave + 4 * fq); ast[pb] = (f32x4){bf_lo(w.x), bf_hi(w.x), bf_lo(w.y), bf_hi(w.y)}; }
    }
    float totlog = 0.f;
    v4u gB[2], gC[2], gX; float gdt;
    auto prefetch = [&](int j) {
        const int l0 = lbase + 64 * j;
#pragma unroll
        for (int k = 0; k < 2; ++k) { const int idx = tid + 512 * k, row = idx >> 4, ch = idx & 15; int l = l0 + row; l = l < LTOK ? l : LTOK - 1;
            const bf16* rp = xbc_c + (rowb + l) * CONVD + DI + g * 128 + ch * 8; gB[k] = *(const v4u*)rp; if (PASS == 2) gC[k] = *(const v4u*)(rp + 512); }
        { const int row = tid >> 3, ch = tid & 7; int l = l0 + row; l = l < LTOK ? l : LTOK - 1; gX = *(const v4u*)(xbc_c + (rowb + l) * CONVD + h * 64 + ch * 8); }
        { const int l = l0 + lane; gdt = l < LTOK ? dtp[(rowb + l) * NHS + h] : 0.f; }
    };
    prefetch(0);
    for (int j = 0; j < nsub; ++j) {
        float acs = gdt * a;
#pragma unroll
        for (int o = 1; o < 64; o <<= 1) { const float t = __shfl_up(acs, o); if (lane >= o) acs += t; }
        const float aend = __shfl(acs, 63);
        const float wrow = gdt * __expf(aend - acs);
        if (wave == 0) { ((LAS float*)(lds + SB_LDT))[lane] = gdt; ((LAS float*)(lds + SB_LACS))[lane] = acs; }
#pragma unroll
        for (int k = 0; k < 2; ++k) { const int idx = tid + 512 * k, row = idx >> 4, ch = idx & 15; *(LAS v4u*)(lds + SB_LB + row * 272 + ch * 16) = gB[k]; if (PASS == 2) *(LAS v4u*)(lds + SB_LC + row * 272 + ch * 16) = gC[k]; }
        { const int row = tid >> 3, ch = tid & 7; const float wv = __shfl(wrow, row & 63);
          if (PASS == 2) *(LAS v4u*)(lds + SB_LX + row * 144 + ch * 16) = gX;
          v4u xw;
#pragma unroll
          for (int e = 0; e < 4; ++e) xw[e] = pk2(bf_lo(gX[e]) * wv, bf_hi(gX[e]) * wv);
          *(LAS v4u*)(lds + SB_LXW + row * 144 + ch * 16) = xw; }
        if (PASS == 2) {
#pragma unroll
            for (int pb = 0; pb < 4; ++pb) *(LAS v2u*)(lds + SB_LST + (16 * pb + fr) * 272 + (16 * wave + 4 * fq) * 2) = (v2u){pk2(ast[pb][0], ast[pb][1]), pk2(ast[pb][2], ast[pb][3])};
        }
        __syncthreads();
        if (j + 1 < nsub) prefetch(j + 1);
        totlog += aend;
        if (PASS == 2) {
            const int ib = wave >> 1;
            bf16x8_t cf[4];
#pragma unroll
            for (int ks = 0; ks < 4; ++ks) cf[ks] = *(const LAS bf16x8_t*)(lds + SB_LC + (16 * ib + fr) * 272 + (32 * ks + 8 * fq) * 2);
            const float acs_i = ((const LAS float*)(lds + SB_LACS))[16 * ib + fr];
            const int irow = 16 * ib + fr;
            bf16x8_t pf[2];
#pragma unroll
            for (int kk = 0; kk < 2; ++kk) {
                unsigned pw[4];
#pragma unroll
                for (int hf = 0; hf < 2; ++hf) { const int sb = 2 * kk + hf;
                    if (sb <= ib) {
                        f32x4 d = (f32x4){0.f, 0.f, 0.f, 0.f};
#pragma unroll
                        for (int ks = 0; ks < 4; ++ks) { const bf16x8_t af = *(const LAS bf16x8_t*)(lds + SB_LB + (16 * sb + fr) * 272 + (32 * ks + 8 * fq) * 2); d = __builtin_amdgcn_mfma_f32_16x16x32_bf16(af, cf[ks], d, 0, 0, 0); }
                        const f32x4 as4 = *(const LAS f32x4*)(lds + SB_LACS + (16 * sb + 4 * fq) * 4), dt4 = *(const LAS f32x4*)(lds + SB_LDT + (16 * sb + 4 * fq) * 4);
                        float v[4];
#pragma unroll
                        for (int r = 0; r < 4; ++r) { const int s = 16 * sb + 4 * fq + r; const float e = __expf(fminf(acs_i - as4[r], 0.f)); v[r] = s <= irow ? d[r] * dt4[r] * e : 0.f; }
                        pw[2 * hf] = pk2(v[0], v[1]); pw[2 * hf + 1] = pk2(v[2], v[3]);
                    } else { pw[2 * hf] = 0u; pw[2 * hf + 1] = 0u; }
                }
                pf[kk] = __builtin_bit_cast(bf16x8_t, (v4u){pw[0], pw[1], pw[2], pw[3]});
            }
            const float ei = __expf(acs_i);
            const int l_row = lbase + 64 * j + irow;
#pragma unroll
            for (int pbi = 0; pbi < 2; ++pbi) { const int pb = 2 * (wave & 1) + pbi;
                f32x4 acc = (f32x4){0.f, 0.f, 0.f, 0.f};
#pragma unroll
                for (int ks = 0; ks < 4; ++ks) { const bf16x8_t af = *(const LAS bf16x8_t*)(lds + SB_LST + (16 * pb + fr) * 272 + (32 * ks + 8 * fq) * 2); acc = __builtin_amdgcn_mfma_f32_16x16x32_bf16(af, cf[ks], acc, 0, 0, 0); }
                acc = acc * ei;
#pragma unroll
                for (int kk = 0; kk < 2; ++kk) if (2 * kk <= ib) {
                    LAS unsigned char* xp = lds + SB_LX + (32 * kk + 4 * fq + q2) * 144 + 32 * pb + 8 * p2;
                    const bf16x8_t xa = cat8(lds_tr16(xp), lds_tr16(xp + 16 * 144));
                    acc = __builtin_amdgcn_mfma_f32_16x16x32_bf16(xa, pf[kk], acc, 0, 0, 0); }
                const v2u xw = *(const LAS v2u*)(lds + SB_LX + irow * 144 + (16 * pb + 4 * fq) * 2);
                const float y0 = acc[0] + dsk * bf_lo(xw.x), y1 = acc[1] + dsk * bf_hi(xw.x), y2 = acc[2] + dsk * bf_lo(xw.y), y3 = acc[3] + dsk * bf_hi(xw.y);
                if (l_row < LTOK) *(v2u*)(xbc_w + (rowb + l_row) * CONVD + h * 64 + 16 * pb + 4 * fq) = (v2u){pk2(y0, y1), pk2(y2, y3)};
            }
        }
        { const float ed = __expf(aend);
#pragma unroll
          for (int pb = 0; pb < 4; ++pb) ast[pb] = ast[pb] * ed;
#pragma unroll
          for (int kk = 0; kk < 2; ++kk) {
              LAS unsigned char* bp = lds + SB_LB + (32 * kk + 8 * fq + q2) * 272 + 32 * wave + 8 * p2;
              const bf16x8_t af = cat8(lds_tr16(bp), lds_tr16(bp + 4 * 272));
#pragma unroll
              for (int pb = 0; pb < 4; ++pb) { LAS unsigned char* xp = lds + SB_LXW + (32 * kk + 8 * fq + q2) * 144 + 32 * pb + 8 * p2;
                  const bf16x8_t bfg = cat8(lds_tr16(xp), lds_tr16(xp + 4 * 144));
                  ast[pb] = __builtin_amdgcn_mfma_f32_16x16x32_bf16(af, bfg, ast[pb], 0, 0, 0); } } }
        __syncthreads();
    }
    if (PASS == 1) {
        bf16* sp = ST + ((size_t)((b * 32 + c) * NHS + h)) * 8192;
#pragma unroll
        for (int pb = 0; pb < 4; ++pb) *(v2u*)(sp + (16 * pb + fr) * 128 + 16 * wave + 4 * fq) = (v2u){pk2(ast[pb][0], ast[pb][1]), pk2(ast[pb][2], ast[pb][3])};
        if (tid == 0) DEC[(b * 32 + c) * NHS + h] = __expf(totlog);
    }
}

constexpr int AT_LK = 0, AT_LV = 9216, AT_FLAG = 18432;
__device__ __forceinline__ void attn_unit(LAS unsigned char* lds, int b, int h, int qb, bf16* Qb, const bf16* Kb, const bf16* Vb, int tid) {
    const int lane = tid & 63, wave = __builtin_amdgcn_readfirstlane(tid >> 6), fr = lane & 15, fq = lane >> 4, q2 = fr >> 2, p2 = lane & 3;
    const int t0 = 128 * qb, tw = t0 + 16 * wave, t = tw + fr;
    const size_t rowb = (size_t)b * BS + OFF;
    const bool tvalid = t < LTOK;
    bf16x8_t qf[2];
    { const bf16* qp = Qb + (rowb + (tvalid ? t : LTOK - 1)) * DM + h * 64 + 8 * fq; qf[0] = *(const bf16x8_t*)qp; qf[1] = *(const bf16x8_t*)(qp + 32); }
    f32x4 oacc[4];
#pragma unroll
    for (int db = 0; db < 4; ++db) oacc[db] = (f32x4){0.f, 0.f, 0.f, 0.f};
    float carry = 0.f;
    bool wdone = !__any(tvalid);
    const int srow = tid >> 3, sch = tid & 7;
    int k0 = t0 + 64; if (k0 >= LTOK) k0 = t0;
    v4u gK, gV;
    { int s = k0 + srow; s = s < LTOK ? s : LTOK - 1; const size_t off = (rowb + s) * DM + h * 64 + sch * 8; gK = *(const v4u*)(Kb + off); gV = *(const v4u*)(Vb + off); }
    for (;;) {
        *(LAS v4u*)(lds + AT_LK + srow * 144 + sch * 16) = gK; *(LAS v4u*)(lds + AT_LV + srow * 144 + sch * 16) = gV;
        __syncthreads();
        if (k0 >= 64) { const size_t off = (rowb + (k0 - 64) + srow) * DM + h * 64 + sch * 8; gK = *(const v4u*)(Kb + off); gV = *(const v4u*)(Vb + off); }
        if (!wdone && k0 <= tw + 14) {
            f32x4 st[4];
#pragma unroll
            for (int sb = 0; sb < 4; ++sb) { f32x4 d = (f32x4){0.f, 0.f, 0.f, 0.f};
#pragma unroll
                for (int ks = 0; ks < 2; ++ks) { const bf16x8_t kf = *(const LAS bf16x8_t*)(lds + AT_LK + (16 * sb + fr) * 144 + (32 * ks + 8 * fq) * 2); d = __builtin_amdgcn_mfma_f32_16x16x32_bf16(kf, qf[ks], d, 0, 0, 0); }
                st[sb] = d; }
            float lsp[4][4], lk[4][4], ps[4];
#pragma unroll
            for (int sb = 0; sb < 4; ++sb) { ps[sb] = 0.f;
#pragma unroll
                for (int r = 0; r < 4; ++r) { const int s = k0 + 16 * sb + 4 * fq + r; const bool vis = tvalid && s < t; const float x = st[sb][r] * 0.125f;
                    const float l1 = fminf(x, 0.f) - __logf(1.0f + __expf(-fabsf(x)));
                    lsp[sb][r] = vis ? l1 : -1e30f; lk[sb][r] = vis ? l1 - x : 0.f; ps[sb] += lk[sb][r]; } }
            float run = carry;
            unsigned pw[8];
#pragma unroll
            for (int sb = 3; sb >= 0; --sb) {
                const float a = ps[sb], bq = __shfl_xor(a, 16), cq = __shfl_xor(a, 32), dq = __shfl_xor(bq, 32);
                const float sfq = ((fq & 1) == 0 ? bq : 0.f) + ((fq & 2) == 0 ? cq + dq : 0.f);
                float lat = run + sfq; float wv[4];
#pragma unroll
                for (int r = 3; r >= 0; --r) { wv[r] = __expf(lsp[sb][r] + lat); lat += lk[sb][r]; }
                pw[2 * sb] = pk2(wv[0], wv[1]); pw[2 * sb + 1] = pk2(wv[2], wv[3]);
                run += (a + bq) + (cq + dq);
            }
            carry = run;
            const bf16x8_t pf0 = __builtin_bit_cast(bf16x8_t, (v4u){pw[0], pw[1], pw[2], pw[3]}), pf1 = __builtin_bit_cast(bf16x8_t, (v4u){pw[4], pw[5], pw[6], pw[7]});
#pragma unroll
            for (int db = 0; db < 4; ++db) {
                LAS unsigned char* vp = lds + AT_LV + (4 * fq + q2) * 144 + 32 * db + 8 * p2;
                const bf16x8_t va0 = cat8(lds_tr16(vp), lds_tr16(vp + 16 * 144)), va1 = cat8(lds_tr16(vp + 32 * 144), lds_tr16(vp + 48 * 144));
                oacc[db] = __builtin_amdgcn_mfma_f32_16x16x32_bf16(va0, pf0, oacc[db], 0, 0, 0);
                oacc[db] = __builtin_amdgcn_mfma_f32_16x16x32_bf16(va1, pf1, oacc[db], 0, 0, 0); }
            wdone = __all(!tvalid || carry < -105.f);
        }
        if (lane == 0) ((LAS int*)(lds + AT_FLAG))[wave] = wdone ? 1 : 0;
        __syncthreads();
        k0 -= 64;
        if (k0 < 0) break;
        { const LAS int* fl = (const LAS int*)(lds + AT_FLAG); const int alld = fl[0] & fl[1] & fl[2] & fl[3] & fl[4] & fl[5] & fl[6] & fl[7]; if (alld) break; }
    }
    if (tvalid) { bf16* op = Qb + (rowb + t) * DM + h * 64 + 4 * fq;
#pragma unroll
        for (int db = 0; db < 4; ++db) *(v2u*)(op + 16 * db) = (v2u){pk2(oacc[db][0], oacc[db][1]), pk2(oacc[db][2], oacc[db][3])}; }
    __syncthreads();
}

constexpr int TAIL0 = 64 * 256, MMAIN = 64 * 256;
template <class F> __device__ __forceinline__ void tail_gemm(LAS unsigned char* lds, const bf16* A, const bf16* Bt, int K, int ncb, int bx, int G, int tid, const F& epi) {
    const int lane = tid & 63, wave = __builtin_amdgcn_readfirstlane(tid >> 6), fr = lane & 15, fq = lane >> 4, kw = K >> 3;
    for (int cb = bx; cb < ncb; cb += G) {
        f32x4 acc[4];
#pragma unroll
        for (int rb = 0; rb < 4; ++rb) acc[rb] = (f32x4){0.f, 0.f, 0.f, 0.f};
        const bf16* bp = Bt + (size_t)(16 * cb + fr) * K + wave * kw + 8 * fq;
        const bf16* ap = A + (size_t)(TAIL0 + fr) * K + wave * kw + 8 * fq;
        for (int k = 0; k < kw; k += 32) {
            const bf16x8_t bfg = *(const bf16x8_t*)(bp + k);
#pragma unroll
            for (int rb = 0; rb < 4; ++rb) { const bf16x8_t afg = *(const bf16x8_t*)(ap + (size_t)rb * 16 * K + k); acc[rb] = __builtin_amdgcn_mfma_f32_16x16x32_bf16(bfg, afg, acc[rb], 0, 0, 0); }
        }
        LAS f32x4* P = (LAS f32x4*)lds;
#pragma unroll
        for (int rb = 0; rb < 4; ++rb) P[(wave * 4 + rb) * 64 + lane] = acc[rb];
        __syncthreads();
        if (wave < 4) { f32x4 s = (f32x4){0.f, 0.f, 0.f, 0.f};
#pragma unroll
            for (int w = 0; w < 8; ++w) s += P[(w * 4 + wave) * 64 + lane];
            epi(s, TAIL0 + 16 * wave + fr, 16 * cb + 4 * fq); }
        __syncthreads();
    }
}
template <int mode> struct TailResid { float* H; const float* x; bf16* XH; float* rsq;
    __device__ __forceinline__ void operator()(f32x4 s, int row, int col0) const {
        float* hp = H + (size_t)row * DM + col0; const int l = row - BS - OFF;
        const float* bp = mode == 0 ? hp : x + ((size_t)SEQ + (l - NMETA)) * DM + col0;
        const f32x4 hv = *(const f32x4*)bp + s; *(f32x4*)hp = hv;
        *(v2u*)(XH + (size_t)row * DM + col0) = (v2u){pk2(hv[0], hv[1]), pk2(hv[2], hv[3])};
        float ss = (hv[0] * hv[0] + hv[1] * hv[1]) + (hv[2] * hv[2] + hv[3] * hv[3]); ss += __shfl_xor(ss, 16); ss += __shfl_xor(ss, 32);
        if ((threadIdx.x & 48) == 0) atomicAdd(rsq + row, ss); } };
struct TailKVQ { bf16* Kb; size_t stride; const float* rsq;
    __device__ __forceinline__ void operator()(f32x4 s, int row, int col0) const {
        s = s * rsqrtf(rsq[row] * (1.0f / DM) + EPS);
        const int t = col0 >> 10; bf16* op = Kb + (size_t)t * stride + (size_t)row * DM + (col0 & 1023);
        *(v2u*)op = (v2u){pk2(s[0], s[1]), pk2(s[2], s[3])}; } };

typedef __attribute__((address_space(1))) unsigned gu32;
#define XB_TMO      128
#define XB_XCNT(j)  (256  + 64 * (j))
#define XB_XSUB(j)  (1280 + 64 * (j))
#define XB_XGEN(j)  (2304 + 64 * (j))
#define XB_TOP      3328
#define XB_TOPGEN   3392
#define XCD_BAR_WORDS 3456
#define XB_SPIN_CAP (1u << 18)

__device__ __forceinline__ unsigned xb_ld(unsigned* p)              { return __hip_atomic_load(p, __ATOMIC_RELAXED, __HIP_MEMORY_SCOPE_AGENT); }
__device__ __forceinline__ unsigned xb_add(unsigned* p, unsigned v) { return __hip_atomic_fetch_add(p, v, __ATOMIC_RELAXED, __HIP_MEMORY_SCOPE_AGENT); }
__device__ __forceinline__ unsigned xb_xcc_id() { return (unsigned)__builtin_amdgcn_s_getreg((3 << 11) | 20) & 0xFu; }
#define XB_SPIN(cond, bar) do { unsigned _sp = 0; while (cond) { __builtin_amdgcn_s_sleep(1); \
    if ((++_sp & 255u) == 0u) { if (xb_ld(&(bar)[XB_TMO])) break; if (_sp > XB_SPIN_CAP) { atomicAdd(&(bar)[XB_TMO], 1u); break; } } } } while (0)

struct XcdBarrier {
    unsigned* bar; unsigned x;
    volatile LAS unsigned* st;
};

__device__ __forceinline__ XcdBarrier xcd_barrier_post(unsigned* bar, volatile LAS unsigned* st) {
    XcdBarrier b; b.bar = bar; b.x = xb_xcc_id(); b.st = st;
    if (threadIdx.x == 0) (void)xb_add(&bar[XB_XCNT(b.x)], 1u);
    return b;
}
__device__ __forceinline__ void xcd_barrier_complete(unsigned* bar, unsigned x, unsigned& nloc, unsigned& nx) {
    const unsigned G = gridDim.x * gridDim.y * gridDim.z;
    unsigned sum, cnt, mine, sp = 0u;
    for (;;) {
        sum = 0u; cnt = 0u; mine = 0u;
#pragma unroll
        for (unsigned j = 0; j < 16; ++j) { const unsigned c = xb_ld(&bar[XB_XCNT(j)]); sum += c; cnt += (c > 0u) ? 1u : 0u; mine = (j == x) ? c : mine; }
        if (sum == G) break;
        __builtin_amdgcn_s_sleep(1);
        if ((++sp & 255u) == 0u) { if (xb_ld(&bar[XB_TMO])) break; if (sp > XB_SPIN_CAP) { atomicAdd(&bar[XB_TMO], 1u); break; } }
    }
    nloc = mine > 0u ? mine : 1u; nx = cnt > 0u ? cnt : 1u;
}

__device__ __forceinline__ void xcd_barrier(const XcdBarrier& b) {
    asm volatile("s_waitcnt vmcnt(0)" ::: "memory");
    __syncthreads();
    if (threadIdx.x == 0) {
        unsigned* bar = b.bar;
        __builtin_amdgcn_s_waitcnt(0);
        unsigned nloc = b.st[0], nx = b.st[1];
        if (nloc == 0u) { xcd_barrier_complete(bar, b.x, nloc, nx); b.st[0] = nloc; b.st[1] = nx; }
        const unsigned old = xb_add(&bar[XB_XSUB(b.x)], 1u);
        const unsigned gen = old / nloc;
        if (old + 1u == (gen + 1u) * nloc) {
            __builtin_amdgcn_fence(__ATOMIC_RELEASE, "agent");
            asm volatile("s_waitcnt vmcnt(0)" ::: "memory");
            const unsigned og = xb_add(&bar[XB_TOP], 1u);
            const unsigned tg = og / nx;
            if (og + 1u == (tg + 1u) * nx) xb_add(&bar[XB_TOPGEN], 1u);
            else XB_SPIN(xb_ld(&bar[XB_TOPGEN]) == tg, bar);
            __builtin_amdgcn_fence(__ATOMIC_ACQUIRE, "agent");
            xb_add(&bar[XB_XGEN(b.x)], 1u);
            asm volatile("s_waitcnt vmcnt(0)" ::: "memory");
        } else {
            XB_SPIN(xb_ld(&bar[XB_XGEN(b.x)]) == gen, bar);
            __builtin_amdgcn_fence(__ATOMIC_ACQUIRE, "agent");
            asm volatile("s_waitcnt vmcnt(0)" ::: "memory");
        }
    }
    __syncthreads();
}

struct Args {
    const float* in[22]; float* outp; unsigned char* wsp; int ph_lo, ph_hi, coop, pad;
};

__device__ __forceinline__ void norm_row(const float* src, bf16* dst, float* rsq_out, int lane) {
    v2u* o8 = (v2u*)dst + lane;
    if (!src) {
#pragma unroll
        for (int j = 0; j < 4; ++j) o8[64 * j] = (v2u){0u, 0u};
        if (lane == 0) *rsq_out = 0.f;
        return; }
    const f32x4* xr = (const f32x4*)src + lane;
    f32x4 v[4]; float s = 0.f;
#pragma unroll
    for (int j = 0; j < 4; ++j) { v[j] = xr[64 * j]; s += (v[j].x * v[j].x + v[j].y * v[j].y) + (v[j].z * v[j].z + v[j].w * v[j].w); }
    s = wave_sum(s); if (lane == 0) *rsq_out = s;
#pragma unroll
    for (int j = 0; j < 4; ++j) o8[64 * j] = (v2u){pk2(v[j].x, v[j].y), pk2(v[j].z, v[j].w)};
}
__device__ __forceinline__ const float* stream_row(int r, int mode, const float* H, const float* x, const float* meta) {
    if (r >= 2 * BS) return nullptr;
    const int b = r >= BS ? 1 : 0, l = r - b * BS - OFF;
    if (l < 0 || l >= LTOK) return nullptr;
    if (mode == 0) return H + (size_t)r * DM;
    return l < NMETA ? meta + (size_t)l * DM : x + ((size_t)b * SEQ + (l - NMETA)) * DM;
}

__device__ __forceinline__ const void* ptab(volatile LAS unsigned* PT, int k) {
    const unsigned lo_ = PT[2 * k], hi_ = PT[2 * k + 1];
    return (const void*)(const __attribute__((address_space(1))) void*)(((unsigned long long)(unsigned)__builtin_amdgcn_readfirstlane((int)hi_) << 32) | (unsigned long long)(unsigned)__builtin_amdgcn_readfirstlane((int)lo_));
}
#define xin ((const float*)ptab(PT, 0))
#define metain ((const float*)ptab(PT, 1))
#define ssd_norm ((const float*)ptab(PT, 2))
#define ssd_w_in ((const float*)ptab(PT, 3))
#define ssd_conv_w ((const float*)ptab(PT, 4))
#define ssd_conv_b ((const float*)ptab(PT, 5))
#define ssd_dt_bias ((const float*)ptab(PT, 6))
#define ssd_a_log ((const float*)ptab(PT, 7))
#define ssd_d_skip ((const float*)ptab(PT, 8))
#define ssd_gate_norm ((const float*)ptab(PT, 9))
#define ssd_w_out ((const float*)ptab(PT, 10))
#define kv_norm ((const float*)ptab(PT, 11))
#define w_kv ((const float*)ptab(PT, 12))
#define sb_norm ((const float*)ptab(PT, 13))
#define sb_w_q ((const float*)ptab(PT, 14))
#define sb_w_o ((const float*)ptab(PT, 15))
#define ffn_norm ((const float*)ptab(PT, 16))
#define ffn_w_up ((const float*)ptab(PT, 17))
#define ffn_conv_w ((const float*)ptab(PT, 18))
#define ffn_conv_b ((const float*)ptab(PT, 19))
#define ffn_w_down ((const float*)ptab(PT, 20))
#define final_norm ((const float*)ptab(PT, 21))
#define ws ((unsigned char*)ptab(PT, 22))
#define Win ((bf16*)(ws + WS_WIN))
#define Wout ((bf16*)(ws + WS_WOUT))
#define Wkvq ((bf16*)(ws + WS_WKVQ))
#define Wo ((bf16*)(ws + WS_WO))
#define Wup0 ((bf16*)(ws + WS_WUP0))
#define Wup1 ((bf16*)(ws + WS_WUP1))
#define Wdn0 ((bf16*)(ws + WS_WDN0))
#define Wdn1 ((bf16*)(ws + WS_WDN1))
#define DT ((float*)(ws + WS_DT))
#define XBC ((bf16*)(ws + WS_XBC))
#define H ((float*)(ws + WS_H))
#define Z ((bf16*)(ws + WS_Z))
#define ACT ((bf16*)(ws + WS_ACT))
#define KB ((bf16*)(ws + WS_K))
#define VB ((bf16*)(ws + WS_V))
#define QB ((bf16*)(ws + WS_Q))
#define RSQ(k) ((float*)(ws + WS_RSQ) + (size_t)(k) * MRX)
#define XN ((bf16*)ptab(PT, 23))
#define OUTP ((float*)ptab(PT, 23))
__global__ void __launch_bounds__(NTHR, 2) mega(const Args args) {
    extern __shared__ __attribute__((aligned(16))) unsigned char lds_raw[];
    LAS unsigned char* lds = (LAS unsigned char*)lds_raw;
    const int tid = threadIdx.x, lane = tid & 63, wave = __builtin_amdgcn_readfirstlane(tid >> 6);
    const int G = gridDim.x, bx = blockIdx.x;
    const int gw = bx * NWAVES + wave, NGW = G * NWAVES;
    volatile LAS unsigned* PT = (volatile LAS unsigned*)(lds + RING_BYTES + XCH_BYTES);
    if (tid >= 64 && tid < 66) ((volatile LAS unsigned*)(lds + RING_BYTES + XCH_BYTES + 512))[tid - 64] = 0u;
    if (tid < 24) { const unsigned long long pv = tid < 22 ? (unsigned long long)args.in[tid] : (tid == 22 ? (unsigned long long)args.wsp : (unsigned long long)args.outp); PT[2 * tid] = (unsigned)pv; PT[2 * tid + 1] = (unsigned)(pv >> 32); }
    __syncthreads();
    volatile unsigned long long* TS = (volatile unsigned long long*)(ws + 65536);
#define STAMP(i) do { if (PROBE_ON && bx == 0 && tid == 0) TS[i] = __builtin_amdgcn_s_memrealtime(); } while (0)
    const int lo = args.ph_lo, hi = args.ph_hi;
#define IN(k) (lo <= (k) && (k) < hi)
    constexpr size_t WS_BAR = 131072;
    XcdBarrier xbar; xbar.bar = (unsigned*)(ws + WS_BAR); xbar.x = 0; xbar.st = (volatile LAS unsigned*)(lds + RING_BYTES + XCH_BYTES + 512);
#define SEAM(k) do { if (args.coop && IN(k) && IN((k) + 1)) { xcd_barrier(xbar); } } while (0)

    STAMP(0); if (IN(0)) {
        LAS float* scr = (LAS float*)(lds + wave * 16640);
        constexpr int I_IN = 16 * (NIN / 64), I_OUT = 32 * 16, I_KVQ = 16 * 48, I_O = 16 * 16, I_UP = 16 * (NUP / 64), I_DN = 44 * 16;
        constexpr int NITEMS = I_IN + I_OUT + I_KVQ + I_O + 2 * I_UP + 2 * I_DN;
        for (int it = gw; it < NITEMS; it += NGW) {
            int r = it;
            if (r < I_IN) { const int nb = r % (NIN / 64), kb = r / (NIN / 64), n0 = nb * 64; transpose_item(ssd_w_in, NIN_REAL, DM, Win, n0, n0, NIN_REAL, kb * 64, ssd_norm, scr, lane); continue; } r -= I_IN;
            if (r < I_OUT) { const int nb = r % 16, kb = r / 16; transpose_item(ssd_w_out, DM, DI, Wout, nb * 64, nb * 64, DM, kb * 64, ssd_gate_norm, scr, lane); continue; } r -= I_OUT;
            if (r < I_KVQ) { const int nb = r % 48, kb = r / 48, n0 = nb * 64;
                if (n0 < 2048) transpose_item(w_kv, 2048, DM, Wkvq, n0, n0, 2048, kb * 64, kv_norm, scr, lane); else transpose_item(sb_w_q, DM, DM, Wkvq, n0, n0 - 2048, DM, kb * 64, sb_norm, scr, lane);
                continue; } r -= I_KVQ;
            if (r < I_O) { const int nb = r % 16, kb = r / 16; transpose_item(sb_w_o, DM, DM, Wo, nb * 64, nb * 64, DM, kb * 64, nullptr, scr, lane); continue; } r -= I_O;
            if (r < 2 * I_UP) { const int ly = r / I_UP; r -= ly * I_UP; const int nb = r % (NUP / 64), kb = r / (NUP / 64), n0 = nb * 64;
                const int src = ((n0 >> 7) & 1) * DFF + (n0 >> 8) * 128 + (n0 & 127);
                transpose_item(ffn_w_up + (size_t)ly * DM * NUP, NUP, DM, ly ? Wup1 : Wup0, n0, src, NUP, kb * 64, ffn_norm + ly * DM, scr, lane); continue; } r -= 2 * I_UP;
            { const int ly = r / I_DN; r -= ly * I_DN; const int nb = r % 16, kb = r / 16;
              transpose_item(ffn_w_down + (size_t)ly * DFF * DM, DM, DFF, ly ? Wdn1 : Wdn0, nb * 64, nb * 64, DM, kb * 64, nullptr, scr, lane); }
        }
        for (int r = gw; r < MRX; r += NGW) norm_row(stream_row(r, 1, H, xin, metain), XN + (size_t)r * DM, RSQ(0) + r, lane);
        for (int i_ = bx * NTHR + tid; i_ < 4 * MRX; i_ += G * NTHR) RSQ(1)[i_] = 0.f;
    }
    if (args.coop) {
        if (bx == 0) { unsigned* bw = (unsigned*)(ws + WS_BAR); for (int i_ = tid; i_ < XCD_BAR_WORDS; i_ += NTHR) bw[i_] = 0u; }
        cg::this_grid().sync();
        xbar = xcd_barrier_post((unsigned*)(ws + WS_BAR), (volatile LAS unsigned*)(lds + RING_BYTES + XCH_BYTES + 512));
    }
    STAMP(1); if (IN(1)) {
        pg8::Gemm g{XN, Win, 2 * TPB * 256, NIN, DM, 3}; pg8::StaticOrder S; S.init(2 * TPB * 256, NIN, G, bx);
        pg8::EpiInProj E{Z, XBC, DT, ssd_conv_w, ssd_conv_b, ssd_dt_bias, RSQ(0)};
        pg8::gemm_phase<pg8::EpiInProj, pg8::StaticOrder, true, true>(lds, g, S, E);
    }
    SEAM(1);
    STAMP(2); if (IN(2)) {
        bf16* xbc = XBC; const float* dtp = DT; bf16* ST = (bf16*)(ws + WS_ST); float* DEC = (float*)(ws + 4096);
        for (int u = bx; u < NBATCH * 32 * NHS; u += G) { const int h = u % NHS, c = (u / NHS) % 32, b = u / (NHS * 32);
            ssd_unit<1>(lds, b, c, h, xbc, xbc, dtp, ST, DEC, -__expf(ssd_a_log[h]), 0.f, tid); }
        if (args.coop) xcd_barrier(xbar);
        STAMP(20);
        { const int gt = bx * NTHR + tid;
          if (gt < NBATCH * NHS * 1024) { const int bh = gt >> 10, e = gt & 1023, b = bh / NHS, h = bh % NHS; float run[8];
#pragma unroll
              for (int k = 0; k < 8; ++k) run[k] = 0.f;
              for (int c = 0; c < 32; ++c) { v4u* sp = (v4u*)(ST + ((size_t)((b * 32 + c) * NHS + h)) * 8192 + e * 8); const v4u w = *sp; const float d = DEC[(b * 32 + c) * NHS + h];
#pragma unroll
                  for (int k = 0; k < 4; ++k) { run[2 * k] = run[2 * k] * d + bf_lo(w[k]); run[2 * k + 1] = run[2 * k + 1] * d + bf_hi(w[k]); }
                  *sp = (v4u){pk2(run[0], run[1]), pk2(run[2], run[3]), pk2(run[4], run[5]), pk2(run[6], run[7])}; } } }
        if (args.coop) xcd_barrier(xbar);
#if REP_SSD1
        for (int u = bx; u < NBATCH * 32 * NHS; u += G) { const int h = u % NHS, c = (u / NHS) % 32, b = u / (NHS * 32);
            ssd_unit<1>(lds, b, c, h, xbc, xbc, dtp, ST, DEC, -__expf(ssd_a_log[h]), 0.f, tid); }
        if (args.coop) xcd_barrier(xbar);
        { const int gt = bx * NTHR + tid;
          if (gt < NBATCH * NHS * 1024) { const int bh = gt >> 10, e = gt & 1023, b = bh / NHS, h = bh % NHS; float run[8];
#pragma unroll
              for (int k = 0; k < 8; ++k) run[k] = 0.f;
              for (int c = 0; c < 32; ++c) { v4u* sp = (v4u*)(ST + ((size_t)((b * 32 + c) * NHS + h)) * 8192 + e * 8); const v4u w = *sp; const float d = DEC[(b * 32 + c) * NHS + h];
#pragma unroll
                  for (int k = 0; k < 4; ++k) { run[2 * k] = run[2 * k] * d + bf_lo(w[k]); run[2 * k + 1] = run[2 * k + 1] * d + bf_hi(w[k]); }
                  *sp = (v4u){pk2(run[0], run[1]), pk2(run[2], run[3]), pk2(run[4], run[5]), pk2(run[6], run[7])}; } } }
        if (args.coop) xcd_barrier(xbar);
#endif
        STAMP(21);
        for (int u = bx; u < NBATCH * 33 * NHS; u += G) { const int h = u % NHS, c = (u / NHS) % 33, b = u / (NHS * 33);
            ssd_unit<2>(lds, b, c, h, xbc, xbc, dtp, ST, DEC, -__expf(ssd_a_log[h]), ssd_d_skip[h], tid); }
    }
    SEAM(2);
    STAMP(3); if (IN(3)) {
        for (int r = gw; r < 2 * BS; r += NGW) {
            const int b = r >= BS ? 1 : 0, l = r - b * BS - OFF; if (l < 0 || l >= LTOK) continue;
#pragma unroll
            for (int g = 0; g < 4; ++g) {
                const v4u yq = *(const v4u*)(XBC + (size_t)r * CONVD + g * 512 + lane * 8); v4u* zp = (v4u*)(Z + (size_t)r * DI + g * 512 + lane * 8); const v4u zq = *zp;
                float hv[8]; float ss = 0.f;
#pragma unroll
                for (int e = 0; e < 4; ++e) { const float y0 = bf_lo(yq[e]), y1 = bf_hi(yq[e]), z0 = bf_lo(zq[e]), z1 = bf_hi(zq[e]);
                    hv[2 * e] = y0 * pg8::silu_f(z0); hv[2 * e + 1] = y1 * pg8::silu_f(z1); ss += hv[2 * e] * hv[2 * e] + hv[2 * e + 1] * hv[2 * e + 1]; }
                const float rs = 1.0f / sqrtf(wave_sum(ss) * (1.f / 512.f) + EPS);
                *zp = (v4u){pk2(hv[0] * rs, hv[1] * rs), pk2(hv[2] * rs, hv[3] * rs), pk2(hv[4] * rs, hv[5] * rs), pk2(hv[6] * rs, hv[7] * rs)};
            }
        }
    }
    SEAM(3);
    STAMP(4); if (IN(4)) {
        { TailResid<1> te{H, xin, XN, RSQ(1)}; tail_gemm(lds, Z, Wout, DI, DM / 16, bx, G, tid, te); }
        pg8::Gemm g{Z, Wout, MMAIN, DM, DI, 0}; pg8::StaticOrder S; S.init(MMAIN, DM, G, bx);
        pg8::EpiResid<1> E{H, xin, metain, XN, RSQ(1)};
        pg8::gemm_phase<pg8::EpiResid<1>, pg8::StaticOrder, true, true>(lds, g, S, E);
    }
    SEAM(4);
    {
        STAMP(6); if (IN(6)) {
            pg8::Gemm g{XN, Wup0, 2 * TPB * 256, NUP, DM, 2}; pg8::StaticOrder S; S.init(2 * TPB * 256, NUP, G, bx);
            pg8::EpiUp E{ACT, ffn_conv_w + (size_t)0 * 3 * NUP, ffn_conv_b + (size_t)0 * NUP, RSQ(1)};
            pg8::gemm_phase<pg8::EpiUp, pg8::StaticOrder, true, true>(lds, g, S, E);
        }
        SEAM(6);
#if REP_UP
        if (IN(6)) {
            pg8::Gemm g{XN, Wup0, 2 * TPB * 256, NUP, DM, 2}; pg8::StaticOrder S; S.init(2 * TPB * 256, NUP, G, bx);
            pg8::EpiUp E{ACT, ffn_conv_w + (size_t)0 * 3 * NUP, ffn_conv_b + (size_t)0 * NUP, RSQ(1)};
            pg8::gemm_phase<pg8::EpiUp, pg8::StaticOrder, true, true>(lds, g, S, E);
        }
        SEAM(6);
#endif
        STAMP(7); if (IN(7)) {
            { TailResid<0> te{H, nullptr, XN, RSQ(2)}; tail_gemm(lds, ACT, Wdn0, DFF, DM / 16, bx, G, tid, te); }
            pg8::Gemm g{ACT, Wdn0, MMAIN, DM, DFF, 0}; pg8::StaticOrder S; S.init(MMAIN, DM, G, bx);
            pg8::EpiResid<0> E{H, nullptr, nullptr, XN, RSQ(2)};
            pg8::gemm_phase<pg8::EpiResid<0>, pg8::StaticOrder, true, true>(lds, g, S, E);
        }
        SEAM(7);
    }
    {
            STAMP(9); if (IN(9)) {
                { TailKVQ te{KB, (size_t)(WS_V - WS_K) / 2, RSQ(2)}; tail_gemm(lds, XN, Wkvq, DM, 3072 / 16, bx, G, tid, te); }
                pg8::Gemm g{XN, Wkvq, MMAIN, 3072, DM, 0}; pg8::StaticOrder S; S.init(MMAIN, 3072, G, bx);
                pg8::EpiBf16 E{KB, DM, DM, (size_t)(WS_V - WS_K) / 2, RSQ(2)};
                pg8::gemm_phase<pg8::EpiBf16, pg8::StaticOrder, true, true>(lds, g, S, E);
            }
            SEAM(9);
            STAMP(10); if (IN(10)) {
                constexpr int NQB = (LTOK + 127) / 128;
                bf16* qb_ = QB; const bf16* kb_ = KB; const bf16* vb_ = VB;
                for (int u = bx; u < NBATCH * 16 * NQB; u += G) { const int hh = u % 16, qi = (u / 16) % NQB, bb = u / (16 * NQB);
                    attn_unit(lds, bb, hh, qi, qb_, kb_, vb_, tid); }
            }
            SEAM(10);
            STAMP(11); if (IN(11)) {
                { TailResid<0> te{H, nullptr, XN, RSQ(3)}; tail_gemm(lds, QB, Wo, DM, DM / 16, bx, G, tid, te); }
                pg8::Gemm g{QB, Wo, MMAIN, DM, DM, 0}; pg8::StaticOrder S; S.init(MMAIN, DM, G, bx);
                pg8::EpiResid<0> E{H, nullptr, nullptr, XN, RSQ(3)};
                pg8::gemm_phase<pg8::EpiResid<0>, pg8::StaticOrder, true, true>(lds, g, S, E);
            }
            SEAM(11);
    }
    {
        STAMP(13); if (IN(13)) {
            pg8::Gemm g{XN, Wup1, 2 * TPB * 256, NUP, DM, 2}; pg8::StaticOrder S; S.init(2 * TPB * 256, NUP, G, bx);
            pg8::EpiUp E{ACT, ffn_conv_w + (size_t)1 * 3 * NUP, ffn_conv_b + (size_t)1 * NUP, RSQ(3)};
            pg8::gemm_phase<pg8::EpiUp, pg8::StaticOrder, true, true>(lds, g, S, E);
        }
        SEAM(13);
        STAMP(14); if (IN(14)) {
            { TailResid<0> te{H, nullptr, XN, RSQ(4)}; tail_gemm(lds, ACT, Wdn1, DFF, DM / 16, bx, G, tid, te); }
            pg8::Gemm g{ACT, Wdn1, MMAIN, DM, DFF, 0}; pg8::StaticOrder S; S.init(MMAIN, DM, G, bx);
            pg8::EpiResid<0> E{H, nullptr, nullptr, XN, RSQ(4)};
            pg8::gemm_phase<pg8::EpiResid<0>, pg8::StaticOrder, true, true>(lds, g, S, E);
        }
        SEAM(14);
    }
#if EXTRA_SYNCS
    if (args.coop) { for (int i_ = 0; i_ < EXTRA_SYNCS; ++i_) xcd_barrier(xbar); }
#endif
    STAMP(15);
    float probe_b = 0.f;
    if (PROBE_ON) {
#define TD(i, j) ((float)(TS[j] - TS[i]) * 0.01f)
        probe_b = (PROBE_EXPR) * (1.0f / 200.0f);
#undef TD
    }
    if (IN(15)) {
        for (int r = gw; r < NBATCH * SEQ; r += NGW) {
            const int b = r / SEQ, t = r % SEQ; const f32x4* xr = (const f32x4*)(H + (size_t)(b * BS + OFF + NMETA + t) * DM) + lane;
            f32x4 v[4]; float s = 0.f;
#pragma unroll
            for (int j = 0; j < 4; ++j) v[j] = xr[64 * j];
            (void)s; const float rstd = rsqrtf(RSQ(4)[b * BS + OFF + NMETA + t] * (1.f / DM) + EPS);
            f32x4* op = (f32x4*)(OUTP + (size_t)r * DM) + lane; const f32x4* gp = (const f32x4*)final_norm + lane;
#pragma unroll
            for (int j = 0; j < 4; ++j) op[64 * j] = PROBE_ON ? (f32x4){probe_b, probe_b, probe_b, probe_b} : v[j] * rstd * gp[64 * j];
        }
    }
#undef IN
#undef SEAM
}

#undef xin
#undef metain
#undef ssd_norm
#undef ssd_w_in
#undef ssd_conv_w
#undef ssd_conv_b
#undef ssd_dt_bias
#undef ssd_a_log
#undef ssd_d_skip
#undef ssd_gate_norm
#undef ssd_w_out
#undef kv_norm
#undef w_kv
#undef sb_norm
#undef sb_w_q
#undef sb_w_o
#undef ffn_norm
#undef ffn_w_up
#undef ffn_conv_w
#undef ffn_conv_b
#undef ffn_w_down
#undef final_norm
#undef ws
#undef Win
#undef Wout
#undef Wkvq
#undef Wo
#undef Wup0
#undef Wup1
#undef Wdn0
#undef Wdn1
#undef DT
#undef XBC
#undef H
#undef Z
#undef ACT
#undef KB
#undef VB
#undef QB
#undef XN
#undef RSQ
#undef OUTP
constexpr int NPHASES = 16;
extern "C" void kernel_launch(void* const* d_in, const int* in_sizes, int n_in, void* d_out, int out_size, void* d_ws, size_t ws_size, hipStream_t stream) {
    static int grid = 0;
    if (grid == 0) {
        if (n_in != 22 || ws_size < WS_END || out_size != NBATCH * SEQ * DM) { fprintf(stderr, "kernel_launch: unexpected shapes (n_in %d ws %zu out %d)\n", n_in, ws_size, out_size); grid = -1; return; }
        int dev = 0, cus = 0, per_cu = 0;
        (void)hipGetDevice(&dev); (void)hipDeviceGetAttribute(&cus, hipDeviceAttributeMultiprocessorCount, dev);
        (void)hipFuncSetAttribute((const void*)mega, hipFuncAttributeMaxDynamicSharedMemorySize, LDS_BYTES);
        (void)hipOccupancyMaxActiveBlocksPerMultiprocessor(&per_cu, (const void*)mega, NTHR, LDS_BYTES);
        (void)hipGetLastError();
        if (per_cu < 1) per_cu = 1;
        grid = cus * 1;
    }
    if (grid < 0) return;
    Args a{};
    for (int i = 0; i < 22; ++i) a.in[i] = (const float*)d_in[i];
    a.outp = (float*)d_out; a.wsp = (unsigned char*)d_ws;
#if MK_COOP
    a.ph_lo = 0; a.ph_hi = NPHASES; a.coop = 1;
    void* kargs[] = {&a};
    hipError_t e = hipLaunchCooperativeKernel((const void*)mega, dim3(grid), dim3(NTHR), kargs, LDS_BYTES, stream);
    if (e != hipSuccess) fprintf(stderr, "cooperative launch failed: %s (grid %d)\n", hipGetErrorString(e), grid);
#else
    for (int p = 0; p < NPHASES; ++p) { a.ph_lo = p; a.ph_hi = p + 1; a.coop = 0; hipLaunchKernelGGL(mega, dim3(grid), dim3(NTHR), LDS_BYTES, stream, a); }
#endif
}
```
